# Optimizing an MI355X kernel written in HIP

```python
import jax
import jax.numpy as jnp
from jax import lax
import numpy as np


D_MODEL = 2048
BATCH = 1
SEQ = 8192
DEPTH = 4

GRID_W = 64
CTX_LEN = 256
EPS = 1e-6

NA_HEADS = 8
NA_HEAD_DIM = 64
NA_WIN_H = 8
NA_WIN_W = 16
GLA_HEADS = 4
GLA_DK = 128
GLA_DV = 256
GLA_GATE_RANK = 16
GLA_GATE_NORM = 16.0
GLA_CHUNK = 64
GQA_HEADS = 8
GQA_KV_HEADS = 2
GQA_HEAD_DIM = 64
GQA_QBLOCK = 128
ROPE_BASE = 10000.0
PEER_HEADS = 8
PEER_NKEYS = 128
PEER_EXPERTS = PEER_NKEYS * PEER_NKEYS
PEER_KEY_DIM = 256
PEER_TOPK = 16
PEER_TOKEN_BLOCK = 128

NA_W = NA_HEADS * NA_HEAD_DIM
GLA_KW = GLA_HEADS * GLA_DK
GLA_VW = GLA_HEADS * GLA_DV
GQA_QW = GQA_HEADS * GQA_HEAD_DIM
GQA_KVW = GQA_KV_HEADS * GQA_HEAD_DIM
MIX_W = NA_W + GLA_VW + GQA_QW
IN_WIDTHS = (NA_W, NA_W, NA_W, GLA_KW, GLA_KW, GLA_VW, GLA_VW, 2 * GLA_GATE_RANK, GQA_QW, GQA_KVW, GQA_KVW)
IN_W = sum(IN_WIDTHS)
IN_OFFSETS = [int(v) for v in np.cumsum(IN_WIDTHS)[:-1]]

DEEPNORM_ALPHA = (2.0 * DEPTH) ** 0.25
DEEPNORM_BETA = (8.0 * DEPTH) ** -0.25

kernel_name = 'hybrid_na_gla_gqa_peer_diffusion_trunk'


def layer_norm(x):
    xf = x.astype(jnp.float32)
    mu = jnp.mean(xf, axis=-1, keepdims=True)
    var = jnp.mean(jnp.square(xf - mu), axis=-1, keepdims=True)
    return ((xf - mu) * lax.rsqrt(var + EPS)).astype(x.dtype)


def post_ln(x, g, b):
    return layer_norm(x) * g + b


def rms_norm(x, w):
    xf = x.astype(jnp.float32)
    y = xf * lax.rsqrt(jnp.mean(xf * xf, axis=-1, keepdims=True) + EPS)
    return (y * w.astype(jnp.float32)).astype(x.dtype)


def axial_rope_tables(n_tokens, head_dim):
    half = head_dim // 2
    inv = ROPE_BASE ** (-jnp.arange(0, half, 2, dtype=jnp.float32) / half)
    t = jnp.arange(n_tokens)
    row = (t // GRID_W).astype(jnp.float32)
    col = (t % GRID_W).astype(jnp.float32)
    ang = jnp.concatenate([row[:, None] * inv, col[:, None] * inv], axis=-1)
    return jnp.cos(ang), jnp.sin(ang)


def apply_axial_rope(x, cos, sin):
    B, T, H, d = x.shape
    xp = x.reshape(B, T, H, d // 2, 2)
    x0, x1 = xp[..., 0], xp[..., 1]
    c = cos[None, :, None, :].astype(x.dtype)
    s = sin[None, :, None, :].astype(x.dtype)
    return jnp.stack([x0 * c - x1 * s, x0 * s + x1 * c], axis=-1).reshape(B, T, H, d)


def mixer_projections(h, w_in, gla_gate_w, gla_gate_b, gqa_q_norm, gqa_k_norm):
    B, T, _ = h.shape
    na_q, na_k, na_v, gq, gk, gv, gg, glr, cq, ck, cv = jnp.split(h @ w_in, IN_OFFSETS, axis=-1)
    heads = lambda a, n: a.reshape(B, T, n, -1)
    to_bhtd = lambda a: heads(a, GLA_HEADS).transpose(0, 2, 1, 3).astype(jnp.float32)
    lr_f, lr_b = jnp.split(glr.astype(jnp.float32), 2, axis=-1)
    log_gate = lambda lr, w, b: jax.nn.log_sigmoid(lr @ w.astype(jnp.float32) + b.astype(jnp.float32)) / GLA_GATE_NORM
    return dict(
        na_q=heads(na_q, NA_HEADS), na_k=heads(na_k, NA_HEADS), na_v=heads(na_v, NA_HEADS),
        gla_q=to_bhtd(gq) * (GLA_DK ** -0.5), gla_k=to_bhtd(gk), gla_v=to_bhtd(gv),
        gla_la_f=to_bhtd(log_gate(lr_f, gla_gate_w[0], gla_gate_b[0])),
        gla_la_b=to_bhtd(log_gate(lr_b, gla_gate_w[1], gla_gate_b[1])),
        gla_gate=gg,
        gqa_q=rms_norm(heads(cq, GQA_HEADS), gqa_q_norm),
        gqa_k=rms_norm(heads(ck, GQA_KV_HEADS), gqa_k_norm),
        gqa_v=heads(cv, GQA_KV_HEADS))


def neighbourhood_attention(q, k, v, k_ctx, v_ctx, rpb, rows):
    B, T, H, d = q.shape
    kh = min(NA_WIN_H, rows)
    kw = NA_WIN_W
    r = jnp.arange(rows)
    row_idx = jnp.clip(r - kh // 2, 0, rows - kh)[:, None] + jnp.arange(kh)
    cq = jnp.arange(GRID_W)
    col_idx = jnp.clip(cq - kw // 2, 0, GRID_W - kw)[:, None] + jnp.arange(kw)
    qg = q.reshape(B, rows, GRID_W, H, d) * (d ** -0.5)
    kg = k.reshape(B, rows, GRID_W, H, d)[:, row_idx]
    vg = v.reshape(B, rows, GRID_W, H, d)[:, row_idx]
    s_band = jnp.einsum('brqhd,briwhd->bhriqw', qg, kg)
    s_win = s_band[..., cq[:, None], col_idx]
    dr = row_idx - r[:, None] + (NA_WIN_H - 1)
    dc = col_idx - cq[:, None] + (NA_WIN_W - 1)
    bias = rpb[:, dr[:, :, None, None], dc[None, None, :, :]]
    s_win = (s_win + bias[None]).transpose(0, 1, 2, 4, 3, 5).reshape(B, H, rows, GRID_W, kh * kw)
    s_ctx = jnp.einsum('brqhd,blhd->bhrql', qg, k_ctx)
    p = jax.nn.softmax(jnp.concatenate([s_win, s_ctx], axis=-1).astype(jnp.float32), axis=-1).astype(v.dtype)
    p_win = p[..., :kh * kw].reshape(B, H, rows, GRID_W, kh, kw).transpose(0, 1, 2, 4, 3, 5)
    p_ctx = p[..., kh * kw:]
    p_band = jnp.zeros((B, H, rows, kh, GRID_W, GRID_W), p.dtype).at[..., cq[:, None], col_idx].set(p_win)
    out = jnp.einsum('bhriqw,briwhd->brqhd', p_band, vg) + jnp.einsum('bhrql,blhd->brqhd', p_ctx, v_ctx)
    return out.reshape(B, T, H * d)


def ctx_attention(q, k, v):
    B, L, H, d = q.shape
    hkv = k.shape[2]
    qg = q.reshape(B, L, hkv, H // hkv, d) * (d ** -0.5)
    s = jnp.einsum('blkgd,bmkd->bkglm', qg, k)
    p = jax.nn.softmax(s.astype(jnp.float32), axis=-1).astype(v.dtype)
    return jnp.einsum('bkglm,bmkd->blkgd', p, v).reshape(B, L, H * d)


def gqa_block_attention(q, k_all, v_all):
    B, T, H, d = q.shape
    hkv = k_all.shape[2]
    nb = T // GQA_QBLOCK
    qb = (q.reshape(B, nb, GQA_QBLOCK, hkv, H // hkv, d) * (d ** -0.5)).transpose(1, 0, 2, 3, 4, 5)

    def one_block(qblk):
        s = jnp.einsum('bqkgd,bmkd->bkgqm', qblk, k_all)
        p = jax.nn.softmax(s.astype(jnp.float32), axis=-1).astype(v_all.dtype)
        return jnp.einsum('bkgqm,bmkd->bqkgd', p, v_all)

    o = lax.map(one_block, qb)
    return o.transpose(1, 0, 2, 3, 4, 5).reshape(B, T, H * d)


def gla_chunked(q, k, v, log_a, s0):
    B, H, T, dk = q.shape
    dv = v.shape[-1]
    n = T // GLA_CHUNK
    chunks = lambda a: a.reshape(B, H, n, GLA_CHUNK, a.shape[-1])
    q, k, v, log_a = chunks(q), chunks(k), chunks(v), chunks(log_a)
    b = jnp.cumsum(log_a, axis=3)
    b_last = b[:, :, :, -1:, :]
    q_t = q * jnp.exp(b)
    k_t = k * jnp.exp(-b)
    k_end = k * jnp.exp(b_last - b)
    mask = jnp.tril(jnp.ones((GLA_CHUNK, GLA_CHUNK), dtype=bool))
    attn = jnp.where(mask, jnp.einsum('bhnid,bhnjd->bhnij', q_t, k_t), 0.0)
    o_intra = jnp.einsum('bhnij,bhnjv->bhniv', attn, v)
    upd = jnp.einsum('bhncd,bhncv->nbhdv', k_end, v)
    decay = jnp.exp(b_last[:, :, :, 0, :]).transpose(2, 0, 1, 3)

    def step(s, inp):
        dec, u = inp
        return dec[..., None] * s + u, s

    s_final, s_prev = lax.scan(step, s0, (decay, upd))
    o_inter = jnp.einsum('bhncd,nbhdv->bhncv', q_t, s_prev)
    return (o_intra + o_inter).reshape(B, H, T, dv), s_final


def gla_bidirectional(q, k, v, la_f, la_b, s0_f, s0_b):
    flip = lambda a: a[:, :, ::-1]
    o_f, s_f = gla_chunked(q, k, v, la_f, s0_f)
    o_b, s_b = gla_chunked(flip(q), flip(k), flip(v), flip(la_b), s0_b)
    return o_f + flip(o_b), s_f, s_b


def gla_output(o, gate, norm_w):
    B, H, T, dv = o.shape
    o = rms_norm(o.transpose(0, 2, 1, 3), norm_w).reshape(B, T, H * dv)
    return (o * jax.nn.silu(gate.astype(jnp.float32))).astype(gate.dtype)


def peer(h, w_q, sub_keys, u_tab, v_tab):
    B, T, D = h.shape
    n_tok = B * T
    hf = h.reshape(n_tok, D)
    q = (hf @ w_q).reshape(n_tok, PEER_HEADS, 2, PEER_KEY_DIM // 2)
    s = jnp.einsum('thpd,hpkd->thpk', q, sub_keys).astype(jnp.float32)
    s1, i1 = lax.top_k(s[:, :, 0], PEER_TOPK)
    s2, i2 = lax.top_k(s[:, :, 1], PEER_TOPK)
    cand = (s1[..., :, None] + s2[..., None, :]).reshape(n_tok, PEER_HEADS, PEER_TOPK * PEER_TOPK)
    cand_idx = (i1[..., :, None] * PEER_NKEYS + i2[..., None, :]).reshape(n_tok, PEER_HEADS, PEER_TOPK * PEER_TOPK)
    top_s, pos = lax.top_k(cand, PEER_TOPK)
    idx = jnp.take_along_axis(cand_idx, pos, axis=-1).reshape(n_tok, PEER_HEADS * PEER_TOPK)
    gate = jax.nn.softmax(top_s, axis=-1).reshape(n_tok, PEER_HEADS * PEER_TOPK).astype(h.dtype)
    nb = n_tok // PEER_TOKEN_BLOCK

    def block(args):
        hb, ib, gb = args
        act = jax.nn.gelu(jnp.einsum('tkd,td->tk', u_tab[ib], hb)) * gb
        return jnp.einsum('tk,tkd->td', act, v_tab[ib])

    out = lax.map(block, (hf.reshape(nb, PEER_TOKEN_BLOCK, D),
                          idx.reshape(nb, PEER_TOKEN_BLOCK, -1),
                          gate.reshape(nb, PEER_TOKEN_BLOCK, -1)))
    return out.reshape(B, T, D)


def trunk_layer(x, xc, mod, modc, w_in, na_rpb, gla_gate_w, gla_gate_b, gla_norm_w, gqa_q_norm, gqa_k_norm,
                w_out, ln1_g, ln1_b, peer_wq, peer_subkeys, peer_u, peer_v, ln2_g, ln2_b,
                rope_cos, rope_sin, rows, update_ctx):
    B = x.shape[0]
    sh1, sc1, g1, sh2, sc2, g2 = [m[:, None, :] for m in jnp.split(mod, 6, axis=-1)]
    csh1, csc1, cg1, csh2, csc2, cg2 = jnp.split(modc, 6, axis=-1)
    h = layer_norm(x) * (1 + sc1) + sh1
    hc = layer_norm(xc) * (1 + csc1) + csh1
    pl = mixer_projections(h, w_in, gla_gate_w, gla_gate_b, gqa_q_norm, gqa_k_norm)
    pc = mixer_projections(hc, w_in, gla_gate_w, gla_gate_b, gqa_q_norm, gqa_k_norm)
    y_na = neighbourhood_attention(pl['na_q'], pl['na_k'], pl['na_v'], pc['na_k'], pc['na_v'], na_rpb, rows)
    s0 = jnp.zeros((B, GLA_HEADS, GLA_DK, GLA_DV), jnp.float32)
    o_gla_c, s_f, s_b = gla_bidirectional(pc['gla_q'], pc['gla_k'], pc['gla_v'], pc['gla_la_f'], pc['gla_la_b'], s0, s0)
    o_gla_l, _, _ = gla_bidirectional(pl['gla_q'], pl['gla_k'], pl['gla_v'], pl['gla_la_f'], pl['gla_la_b'], s_f, s_b)
    y_gla = gla_output(o_gla_l, pl['gla_gate'], gla_norm_w)
    q_l = apply_axial_rope(pl['gqa_q'], rope_cos, rope_sin)
    k_l = apply_axial_rope(pl['gqa_k'], rope_cos, rope_sin)
    k_all = jnp.concatenate([pc['gqa_k'], k_l], axis=1)
    v_all = jnp.concatenate([pc['gqa_v'], pl['gqa_v']], axis=1)
    y_gqa = gqa_block_attention(q_l, k_all, v_all)
    y = jnp.concatenate([y_na, y_gla, y_gqa], axis=-1) @ w_out
    x = post_ln(DEEPNORM_ALPHA * x + g1 * y, ln1_g, ln1_b)
    h2 = layer_norm(x) * (1 + sc2) + sh2
    x = post_ln(DEEPNORM_ALPHA * x + g2 * peer(h2, peer_wq, peer_subkeys, peer_u, peer_v), ln2_g, ln2_b)
    if update_ctx:
        yc = jnp.concatenate([
            ctx_attention(pc['na_q'], pc['na_k'], pc['na_v']),
            gla_output(o_gla_c, pc['gla_gate'], gla_norm_w),
            ctx_attention(pc['gqa_q'], pc['gqa_k'], pc['gqa_v'])], axis=-1) @ w_out
        xc = post_ln(DEEPNORM_ALPHA * xc + cg1 * yc, ln1_g, ln1_b)
        hc2 = layer_norm(xc) * (1 + csc2) + csh2
        xc = post_ln(DEEPNORM_ALPHA * xc + cg2 * peer(hc2, peer_wq, peer_subkeys, peer_u, peer_v), ln2_g, ln2_b)
    return x, xc


def setup_inputs(seed: int = 0) -> dict:
    key = jax.random.key(seed)
    ks = jax.random.split(key, 22)
    nrm = lambda k, shape, s: jax.random.normal(k, shape, jnp.float32) * s
    D = D_MODEL
    return {
        'x': nrm(ks[0], (BATCH, SEQ, D), 1.0),
        'c': nrm(ks[1], (BATCH, D), 1.0),
        'ctx': nrm(ks[2], (BATCH, CTX_LEN, D), 1.0),
        'c_ctx': nrm(ks[3], (D,), 1.0),
        'w_mod': nrm(ks[4], (DEPTH, D, 6 * D), 0.5 * D ** -0.5),
        'b_mod': nrm(ks[5], (DEPTH, 6 * D), 0.01),
        'w_in': nrm(ks[6], (DEPTH, D, IN_W), D ** -0.5),
        'na_rpb': nrm(ks[7], (DEPTH, NA_HEADS, 2 * NA_WIN_H - 1, 2 * NA_WIN_W - 1), 0.02),
        'gla_gate_w': nrm(ks[8], (DEPTH, 2, GLA_GATE_RANK, GLA_KW), GLA_GATE_RANK ** -0.5),
        'gla_gate_b': nrm(ks[9], (DEPTH, 2, GLA_KW), 0.1),
        'gla_norm_w': 1.0 + nrm(ks[10], (DEPTH, GLA_DV), 0.02),
        'gqa_q_norm': 1.0 + nrm(ks[11], (DEPTH, GQA_HEAD_DIM), 0.02),
        'gqa_k_norm': 1.0 + nrm(ks[12], (DEPTH, GQA_HEAD_DIM), 0.02),
        'w_out': nrm(ks[13], (DEPTH, MIX_W, D), DEEPNORM_BETA * MIX_W ** -0.5),
        'ln1_g': 1.0 + nrm(ks[14], (DEPTH, D), 0.02),
        'ln1_b': nrm(ks[15], (DEPTH, D), 0.02),
        'peer_wq': nrm(ks[16], (DEPTH, D, PEER_HEADS * PEER_KEY_DIM), D ** -0.5),
        'peer_subkeys': nrm(ks[17], (DEPTH, PEER_HEADS, 2, PEER_NKEYS, PEER_KEY_DIM // 2), (PEER_KEY_DIM // 2) ** -0.5),
        'peer_u': nrm(ks[18], (DEPTH, PEER_EXPERTS, D), D ** -0.5),
        'peer_v': nrm(ks[19], (DEPTH, PEER_EXPERTS, D), DEEPNORM_BETA),
        'ln2_g': 1.0 + nrm(ks[20], (DEPTH, D), 0.02),
        'ln2_b': nrm(ks[21], (DEPTH, D), 0.02),
    }


def reference(x, c, ctx, c_ctx, w_mod, b_mod, w_in, na_rpb, gla_gate_w, gla_gate_b, gla_norm_w,
              gqa_q_norm, gqa_k_norm, w_out, ln1_g, ln1_b, peer_wq, peer_subkeys, peer_u, peer_v,
              ln2_g, ln2_b):
    T = x.shape[1]
    rows = T // GRID_W
    rope_cos, rope_sin = axial_rope_tables(T, GQA_HEAD_DIM)
    sc = jax.nn.silu(c)
    scc = jax.nn.silu(c_ctx)
    xc = ctx
    for l in range(DEPTH):
        mod = sc @ w_mod[l] + b_mod[l]
        modc = scc @ w_mod[l] + b_mod[l]
        x, xc = trunk_layer(x, xc, mod, modc, w_in[l], na_rpb[l], gla_gate_w[l], gla_gate_b[l], gla_norm_w[l],
                            gqa_q_norm[l], gqa_k_norm[l], w_out[l], ln1_g[l], ln1_b[l], peer_wq[l],
                            peer_subkeys[l], peer_u[l], peer_v[l], ln2_g[l], ln2_b[l],
                            rope_cos, rope_sin, rows, l < DEPTH - 1)
    return x
```

```cpp
#include <hip/hip_runtime.h>
#include <cstdio>
#include <cstdint>
#include <hip/hip_bf16.h>
#define MK_MULTI 0
namespace pg8 {
#define PG8_LAS __attribute__((address_space(3)))
typedef unsigned short bf16_t;
typedef short bf16x8 __attribute__((ext_vector_type(8)));
typedef float f32x4 __attribute__((ext_vector_type(4)));
typedef unsigned u32x4 __attribute__((ext_vector_type(4)));
constexpr int BM = 256, BK = 64, HALF = 128, HTB = HALF * BK * 2  , STAGE_BYTES = 8 * HTB, NXCD = 8, WGM = 8;

__host__ __device__ __forceinline__ int lds_byte(int r, int c) { const int st = (r >> 4) * 2 + (c >> 5), rr = r & 15, cc = c & 31, ob = rr * 64 + cc * 2; return st * 1024 + (ob ^ (((ob >> 9) & 1) << 5)); }
__host__ __device__ __forceinline__ void stage_rc(int b, int& R, int& C) { const int st = b / 1024, sb = b % 1024, swz = sb ^ (((sb >> 9) & 1) << 5); R = (st >> 1) * 16 + swz / 64; C = (st & 1) * 32 + (swz % 64) / 2; }
__host__ __device__ __forceinline__ int perm32(int rho) { const int n = rho >> 4, i = rho & 15; return 8 * (i >> 2) + 4 * n + (i & 3); }

struct Unit { int pm, pn; };
struct Gemm { const bf16_t* A; const bf16_t* Bt; int M, N, K; };

struct StaticOrder {
    int nM, nN, nwg, G, c;
    __host__ __device__ void init(int M, int N, int G_, int c_) { nM = M / BM; nN = N / BM; nwg = nM * nN; G = G_; c = c_; }
    __host__ __device__ bool next(int i, Unit& u) const {
        const long L = (long)i * G + c; if (L >= nwg) return false;
        int wgid = (int)L; { const int q = nwg / NXCD, r = nwg % NXCD, xcd = wgid % NXCD, off = wgid / NXCD; wgid = (xcd < r ? xcd * (q + 1) : r * (q + 1) + (xcd - r) * q) + off; }
        const int nig = WGM * nN, gid = wgid / nig, fm = gid * WGM, gsz = (nM - fm) < WGM ? (nM - fm) : WGM;
        u.pm = fm + ((wgid % nig) % gsz); u.pn = (wgid % nig) / gsz; return true;
    }
    __device__ __forceinline__ void a_ready(const Unit&) const {}
    __device__ __forceinline__ void done(const Unit&) const {}
};
__device__ __forceinline__ unsigned cvt_pk_bf16(float lo, float hi) { unsigned r; asm volatile("v_cvt_pk_bf16_f32 %0, %1, %2" : "=v"(r) : "v"(lo), "v"(hi)); return r; }
typedef float f32x2 __attribute__((ext_vector_type(2)));

struct EpiBf16P {
    static constexpr bool PERM = true, AFTER_DRAIN = false;
    bf16_t* O; int ldc;
    __device__ __forceinline__ void operator()(const f32x4 (&acc)[2][2][4][2], const Unit& u, int wr, int wc, int fr, int fq) const {
        const int row0 = u.pm * BM + wr * 64 + fr, col0 = u.pn * BM + wc * 32 + 8 * fq;
#pragma unroll
        for (int ai = 0; ai < 2; ++ai)
#pragma unroll
            for (int m = 0; m < 4; ++m) { bf16_t* rowp = O + (size_t)(row0 + ai * HALF + m * 16) * ldc + col0;
#pragma unroll
                for (int bj = 0; bj < 2; ++bj) { const f32x4 v0 = acc[ai][bj][m][0], v1 = acc[ai][bj][m][1];
                    u32x4 w; w.x = cvt_pk_bf16(v0[0], v0[1]); w.y = cvt_pk_bf16(v0[2], v0[3]); w.z = cvt_pk_bf16(v1[0], v1[1]); w.w = cvt_pk_bf16(v1[2], v1[3]);
                    *(u32x4*)(rowp + bj * HALF) = w; } }
    }
};
struct EpiResid {
    static constexpr bool PERM = true, AFTER_DRAIN = false;
    const bf16_t* X; bf16_t* Z; const float* g; float alpha;
    __device__ __forceinline__ void operator()(const f32x4 (&acc)[2][2][4][2], const Unit& u, int wr, int wc, int fr, int fq) const {
        const int row0 = u.pm * BM + wr * 64 + fr, col0 = u.pn * BM + wc * 32 + 8 * fq;
        f32x4 gv[2][2];
#pragma unroll
        for (int bj = 0; bj < 2; ++bj)
#pragma unroll
            for (int n = 0; n < 2; ++n) gv[bj][n] = *(const f32x4*)(g + col0 + bj * HALF + 4 * n);
#pragma unroll
        for (int ai = 0; ai < 2; ++ai) {
            u32x4 xv[4][2];
#pragma unroll
            for (int m = 0; m < 4; ++m)
#pragma unroll
                for (int bj = 0; bj < 2; ++bj) xv[m][bj] = *(const u32x4*)(X + (size_t)(row0 + ai * HALF + m * 16) * 2048 + col0 + bj * HALF);
#pragma unroll
            for (int m = 0; m < 4; ++m)
#pragma unroll
                for (int bj = 0; bj < 2; ++bj) { const f32x4 v0 = acc[ai][bj][m][0], v1 = acc[ai][bj][m][1]; const u32x4 x = xv[m][bj]; u32x4 w;
#define XLO_(q) __builtin_bit_cast(float, (q) << 16)
#define XHI_(q) __builtin_bit_cast(float, (q) & 0xffff0000u)
                    w.x = cvt_pk_bf16(XLO_(x.x) * alpha + gv[bj][0][0] * v0[0], XHI_(x.x) * alpha + gv[bj][0][1] * v0[1]);
                    w.y = cvt_pk_bf16(XLO_(x.y) * alpha + gv[bj][0][2] * v0[2], XHI_(x.y) * alpha + gv[bj][0][3] * v0[3]);
                    w.z = cvt_pk_bf16(XLO_(x.z) * alpha + gv[bj][1][0] * v1[0], XHI_(x.z) * alpha + gv[bj][1][1] * v1[1]);
                    w.w = cvt_pk_bf16(XLO_(x.w) * alpha + gv[bj][1][2] * v1[2], XHI_(x.w) * alpha + gv[bj][1][3] * v1[3]);
#undef XLO_
#undef XHI_
                    *(u32x4*)(Z + (size_t)(row0 + ai * HALF + m * 16) * 2048 + col0 + bj * HALF) = w; }
        }
    }
};
struct EpiStoreF32 {
    static constexpr bool PERM = true, AFTER_DRAIN = false;
    float* C; int ldc;
    __device__ __forceinline__ void operator()(const f32x4 (&acc)[2][2][4][2], const Unit& u, int wr, int wc, int fr, int fq) const {
        const int row0 = u.pm * BM + wr * 64 + fr, col0 = u.pn * BM + wc * 32 + 8 * fq;
#pragma unroll
        for (int ai = 0; ai < 2; ++ai)
#pragma unroll
            for (int m = 0; m < 4; ++m) { float* rowp = C + (size_t)(row0 + ai * HALF + m * 16) * ldc + col0;
#pragma unroll
                for (int bj = 0; bj < 2; ++bj) { *(f32x4*)(rowp + bj * HALF) = acc[ai][bj][m][0]; *(f32x4*)(rowp + bj * HALF + 4) = acc[ai][bj][m][1]; } }
    }
};

template <class Epi, class Sched, bool ALIGN_EPI = false, bool SP2 = false>
__device__ __forceinline__ void gemm_phase(PG8_LAS unsigned char* lds, const Gemm g, const Sched& S, const Epi& E) {
    int tid_ = threadIdx.x; asm volatile("" : "+v"(tid_));
    const int tid = tid_, wid = __builtin_amdgcn_readfirstlane(tid >> 6), lane = tid & 63, wr = wid >> 2, wc = wid & 3, fr = lane & 15, fq = lane >> 4;
    const int K = g.K, nt = K / BK;
    unsigned voffA[2], voffB[2];
#pragma unroll
    for (int i = 0; i < 2; ++i) { int R, C; stage_rc(tid * 16 + i * 8192, R, C); const int Rb = Epi::PERM ? ((R & ~31) + perm32(R & 31)) : R;
        voffA[i] = (unsigned)(R * K + C) * 2u; voffB[i] = (unsigned)(Rb * K + C) * 2u; }
    const size_t kstep = (size_t)(BK * 2);
    const size_t hstep = (size_t)HALF * K * 2;
    const size_t tstep = 2 * hstep;
    const unsigned ldsw = (unsigned)wid * 1024u;
    const int aoff = lds_byte(wr * 64 + fr, fq * 8), boff = lds_byte(wc * 32 + fr, fq * 8);
#define PG8_SA(b, h) (((b) * 2 + (h)) * HTB)
#define PG8_SB(b, h) ((4 + (b) * 2 + (h)) * HTB)
#define PG8_STAGE(bufoff, gbase, voff) do { _Pragma("unroll") for (int _i = 0; _i < 2; ++_i) \
        __builtin_amdgcn_global_load_lds((const unsigned*)((const char*)(gbase) + (voff)[_i]), (PG8_LAS unsigned*)(lds + (bufoff) + ldsw + _i * 8192), 16, 0, 0); } while (0)
#define PG8_LDA(dst, b, h) do { _Pragma("unroll") for (int m = 0; m < 4; ++m) _Pragma("unroll") for (int k = 0; k < 2; ++k) dst[m][k] = *(const PG8_LAS bf16x8*)(lds + PG8_SA(b, h) + aoff + m * 2048 + k * 1024); } while (0)
#define PG8_LDB(dst, b, h) do { _Pragma("unroll") for (int n = 0; n < 2; ++n) _Pragma("unroll") for (int k = 0; k < 2; ++k) dst[n][k] = *(const PG8_LAS bf16x8*)(lds + PG8_SB(b, h) + boff + n * 2048 + k * 1024); } while (0)
#define PG8_MMA(ai, bj, At, Bt) do { __builtin_amdgcn_s_setprio(1); _Pragma("unroll") for (int m = 0; m < 4; ++m) _Pragma("unroll") for (int n = 0; n < 2; ++n) _Pragma("unroll") for (int k = 0; k < 2; ++k) \
        acc[ai][bj][m][n] = __builtin_amdgcn_mfma_f32_16x16x32_bf16(Bt[n][k], At[m][k], acc[ai][bj][m][n], 0, 0, 0); __builtin_amdgcn_s_setprio(0); } while (0)
#define PG8_WAIT_V(n) asm volatile("s_waitcnt vmcnt(" #n ")" ::: "memory")
#define PG8_WAIT_L(n) asm volatile("s_waitcnt lgkmcnt(" #n ")" ::: "memory")
#define PG8_BAR __builtin_amdgcn_s_barrier()
#define PG8_SCHED __builtin_amdgcn_sched_barrier(0)
    Unit cur, nxt; int ui = 0;
    if (!S.next(0, cur)) return;
    f32x4 acc[2][2][4][2];
#pragma unroll
    for (int a = 0; a < 2; ++a)
#pragma unroll
        for (int b = 0; b < 2; ++b)
#pragma unroll
            for (int m = 0; m < 4; ++m)
#pragma unroll
                for (int n = 0; n < 2; ++n) acc[a][b][m][n] = (f32x4){0.f, 0.f, 0.f, 0.f};
    bf16x8 At[4][2], B0[2][2], B1[2][2];
    const char* cA = (const char*)g.A + (size_t)cur.pm * tstep; const char* cB = (const char*)g.Bt + (size_t)cur.pn * tstep;
    S.a_ready(cur);
    if constexpr (SP2) {
        PG8_STAGE(PG8_SB(0, 0), cB, voffB); PG8_STAGE(PG8_SB(0, 1), cB + hstep, voffB); PG8_STAGE(PG8_SA(0, 0), cA, voffA); PG8_STAGE(PG8_SA(0, 1), cA + hstep, voffA);
        if (wr == 1) PG8_BAR;
        PG8_WAIT_V(2); PG8_BAR;
        PG8_STAGE(PG8_SB(1, 0), cB + kstep, voffB); PG8_STAGE(PG8_SA(1, 0), cA + kstep, voffA); PG8_STAGE(PG8_SB(1, 1), cB + hstep + kstep, voffB);
        PG8_WAIT_V(6); PG8_BAR;
    } else {
        PG8_STAGE(PG8_SB(0, 0), cB, voffB); PG8_STAGE(PG8_SA(0, 0), cA, voffA); PG8_STAGE(PG8_SB(0, 1), cB + hstep, voffB); PG8_STAGE(PG8_SA(0, 1), cA + hstep, voffA);
        if (wr == 1) PG8_BAR;
        PG8_WAIT_V(4); PG8_BAR;
        PG8_STAGE(PG8_SB(1, 0), cB + kstep, voffB); PG8_STAGE(PG8_SA(1, 0), cA + kstep, voffA); PG8_STAGE(PG8_SB(1, 1), cB + hstep + kstep, voffB);
        PG8_WAIT_V(6); PG8_BAR;
    }
    for (;;) {
        const bool has_next = S.next(ui + 1, nxt);
        const char* nA = has_next ? (const char*)g.A + (size_t)nxt.pm * tstep : cA; const char* nB = has_next ? (const char*)g.Bt + (size_t)nxt.pn * tstep : cB;
        for (int t = 0; t < nt; t += 2) {
            const bool last = (t == nt - 2);
            const char* a1 = cA + (size_t)(t + 1) * kstep;
            const char* a2 = last ? nA : cA + (size_t)(t + 2) * kstep; const char* b2 = last ? nB : cB + (size_t)(t + 2) * kstep;
            const char* a3 = a2 + kstep; const char* b3 = b2 + kstep;
            if (last && has_next) S.a_ready(nxt);
            if constexpr (SP2) {
            PG8_LDB(B0, 0, 0); PG8_LDB(B1, 0, 1); PG8_SCHED; PG8_LDA(At, 0, 0); PG8_STAGE(PG8_SA(1, 1), a1 + hstep, voffA);
            PG8_WAIT_V(8); PG8_WAIT_L(0); PG8_BAR; PG8_MMA(0, 0, At, B0); PG8_MMA(0, 1, At, B1); PG8_BAR; PG8_SCHED;
            PG8_LDA(At, 0, 1); PG8_STAGE(PG8_SB(0, 0), b2, voffB); PG8_STAGE(PG8_SB(0, 1), b2 + hstep, voffB); PG8_STAGE(PG8_SA(0, 0), a2, voffA);
            PG8_WAIT_V(8); PG8_WAIT_L(0); PG8_BAR; PG8_MMA(1, 0, At, B0); PG8_MMA(1, 1, At, B1); PG8_BAR; PG8_SCHED;
            PG8_LDB(B0, 1, 0); PG8_LDB(B1, 1, 1); PG8_SCHED; PG8_LDA(At, 1, 0); PG8_STAGE(PG8_SA(0, 1), a2 + hstep, voffA);
            PG8_WAIT_V(8); PG8_WAIT_L(0); PG8_BAR; PG8_MMA(0, 0, At, B0); PG8_MMA(0, 1, At, B1); PG8_BAR; PG8_SCHED;
            PG8_LDA(At, 1, 1); PG8_STAGE(PG8_SB(1, 0), b3, voffB); PG8_STAGE(PG8_SB(1, 1), b3 + hstep, voffB); PG8_STAGE(PG8_SA(1, 0), a3, voffA);
            PG8_WAIT_V(8); PG8_WAIT_L(0); PG8_BAR; PG8_MMA(1, 0, At, B0); PG8_MMA(1, 1, At, B1); PG8_BAR; PG8_SCHED;
            } else {
            PG8_LDB(B0, 0, 0); PG8_SCHED; PG8_LDA(At, 0, 0); PG8_STAGE(PG8_SA(1, 1), a1 + hstep, voffA);
            PG8_WAIT_L(8); PG8_BAR; PG8_WAIT_L(0); PG8_MMA(0, 0, At, B0); PG8_BAR; PG8_SCHED;
            PG8_LDB(B1, 0, 1); PG8_STAGE(PG8_SB(0, 0), b2, voffB);
            PG8_BAR; PG8_WAIT_L(0); PG8_MMA(0, 1, At, B1); PG8_BAR;
            PG8_LDA(At, 0, 1); PG8_STAGE(PG8_SA(0, 0), a2, voffA);
            PG8_BAR; PG8_WAIT_L(0); PG8_MMA(1, 0, At, B0); PG8_BAR; PG8_SCHED;
            PG8_STAGE(PG8_SB(0, 1), b2 + hstep, voffB);
            PG8_WAIT_V(6); PG8_BAR; PG8_MMA(1, 1, At, B1); PG8_BAR;
            PG8_LDB(B0, 1, 0); PG8_SCHED; PG8_LDA(At, 1, 0); PG8_STAGE(PG8_SA(0, 1), a2 + hstep, voffA);
            PG8_WAIT_L(8); PG8_BAR; PG8_WAIT_L(0); PG8_MMA(0, 0, At, B0); PG8_BAR; PG8_SCHED;
            PG8_LDB(B1, 1, 1); PG8_STAGE(PG8_SB(1, 0), b3, voffB);
            PG8_BAR; PG8_WAIT_L(0); PG8_MMA(0, 1, At, B1); PG8_BAR;
            PG8_LDA(At, 1, 1); PG8_STAGE(PG8_SA(1, 0), a3, voffA);
            PG8_BAR; PG8_WAIT_L(0); PG8_MMA(1, 0, At, B0); PG8_BAR; PG8_SCHED;
            PG8_STAGE(PG8_SB(1, 1), b3 + hstep, voffB);
            PG8_WAIT_V(6); PG8_BAR; PG8_MMA(1, 1, At, B1); PG8_BAR;
            }
        }
        if constexpr (ALIGN_EPI) { if (wr == 0) PG8_BAR; }
        if constexpr (!Epi::AFTER_DRAIN) { E(acc, cur, wr, wc, fr, fq); S.done(cur); }
        if (!has_next) break;
#pragma unroll
        for (int a = 0; a < 2; ++a)
#pragma unroll
            for (int b = 0; b < 2; ++b)
#pragma unroll
                for (int m = 0; m < 4; ++m)
#pragma unroll
                    for (int n = 0; n < 2; ++n) acc[a][b][m][n] = (f32x4){0.f, 0.f, 0.f, 0.f};
        cur = nxt; cA = nA; cB = nB; ++ui;
        if constexpr (ALIGN_EPI) { if (wr == 1) PG8_BAR; }
    }
    PG8_WAIT_V(0);
    if constexpr (!ALIGN_EPI) { if (wr == 0) PG8_BAR; }
    PG8_BAR;
    if constexpr (Epi::AFTER_DRAIN) { E.fused(acc, cur, wr, wc, fr, fq, lds, wid, lane); S.done(cur); }
#undef PG8_SA
#undef PG8_SB
#undef PG8_STAGE
#undef PG8_LDA
#undef PG8_LDB
#undef PG8_MMA
#undef PG8_WAIT_V
#undef PG8_WAIT_L
#undef PG8_BAR
#undef PG8_SCHED
}
}
#include <cmath>
namespace attn_body {
using bf16=__hip_bfloat16;
using bf16x8=__attribute__((ext_vector_type(8)))short;
using s16x4=__attribute__((ext_vector_type(4)))short;
using f32x16=__attribute__((ext_vector_type(16)))float;
using u32x4=__attribute__((ext_vector_type(4)))unsigned;
constexpr int D=64;
constexpr int NW=8,QBLK=32,QB=QBLK*NW,KVBLK=64;
constexpr int ATTN_UNIT_ROWS=QB;
__device__ __forceinline__ int crow(int r,int hi){return (r&3)+8*(r>>2)+4*hi;}
#define SBAR() __builtin_amdgcn_sched_barrier(0)
__device__ __forceinline__ void cmask(f32x16&p0,f32x16&p1,int jb,int qrel,int hi){
  const float NEG=-INFINITY; int kb=64*jb+4*hi;
  #pragma unroll
  for(int r=0;r<16;++r){int kv=kb+(r&3)+8*(r>>2); if(kv>qrel)p0[r]=NEG; if(kv+32>qrel)p1[r]=NEG;}
}

constexpr int NSLOT=3, SLOTB=8192;
constexpr int LDS_K=0, LDS_V=NSLOT*SLOTB, LDS_WS=2*NSLOT*SLOTB, LDS_OST=LDS_WS+NW*64*4, LDS_BYTES=LDS_OST+NW*4096;
constexpr float C2=0.125f*1.4426950408889634f;
__device__ __forceinline__ void glds16(const void*gsrc,unsigned lds_dst){unsigned keep;
  asm volatile("s_mov_b32 %0, m0\n\ts_mov_b32 m0, %2\n\ts_nop 0\n\tglobal_load_lds_dwordx4 %1, off\n\ts_mov_b32 m0, %0":"=&s"(keep):"v"(gsrc),"s"(lds_dst):"memory");}
__device__ __forceinline__ float max3f(float a,float b,float c){float r;asm("v_max3_f32 %0, %1, %2, %3":"=v"(r):"v"(a),"v"(b),"v"(c));return r;}
__device__ __forceinline__ float max2f(float a,float b){float r;asm("v_max_f32_e32 %0, %1, %2":"=v"(r):"v"(a),"v"(b));return r;}
__device__ __forceinline__ float fadd_s(float a,float b){float r;asm("v_add_f32_e32 %0, %1, %2":"=v"(r):"v"(a),"v"(b));return r;}
__device__ __forceinline__ float fsub_s(float a,float b){float r;asm("v_sub_f32_e32 %0, %1, %2":"=v"(r):"v"(a),"v"(b));return r;}
typedef float f32x2_t __attribute__((ext_vector_type(2))); typedef __bf16 bf16x2_t __attribute__((ext_vector_type(2)));
__device__ __forceinline__ unsigned cvtpk_s(float lo,float hi){f32x2_t v={lo,hi};bf16x2_t b=__builtin_convertvector(v,bf16x2_t);return __builtin_bit_cast(unsigned,b);}
#define WAIT_BAR(N) asm volatile("s_waitcnt vmcnt(" #N ") lgkmcnt(0)\n\ts_barrier":::"memory")

__device__ __forceinline__ void qkt(f32x16&p0,f32x16&p1,const char*Kslot,const bf16x8*qr,const f32x16&negm,int r32,int hi){
  const char*kb=Kslot+hi*1024+r32*16;
  #pragma unroll
  for(int d0=0;d0<4;++d0){
    const bf16x8 b0=*reinterpret_cast<const bf16x8*>(kb+d0*2048);
    const bf16x8 b1=*reinterpret_cast<const bf16x8*>(kb+d0*2048+512);
    if(d0==0){p0=__builtin_amdgcn_mfma_f32_32x32x16_bf16(b0,qr[0],negm,0,0,0);p1=__builtin_amdgcn_mfma_f32_32x32x16_bf16(b1,qr[0],negm,0,0,0);}
    else{p0=__builtin_amdgcn_mfma_f32_32x32x16_bf16(b0,qr[d0],p0,0,0,0);p1=__builtin_amdgcn_mfma_f32_32x32x16_bf16(b1,qr[d0],p1,0,0,0);}}
}
typedef __attribute__((address_space(3))) const char* lds_cptr;
typedef short v4i16_t __attribute__((ext_vector_type(4)));
__device__ __forceinline__ void kload8(bf16x8*kf,lds_cptr kp){
  kf[0]=*(const __attribute__((address_space(3))) bf16x8*)(kp);      kf[1]=*(const __attribute__((address_space(3))) bf16x8*)(kp+512);
  kf[2]=*(const __attribute__((address_space(3))) bf16x8*)(kp+2048); kf[3]=*(const __attribute__((address_space(3))) bf16x8*)(kp+2560);
  kf[4]=*(const __attribute__((address_space(3))) bf16x8*)(kp+4096); kf[5]=*(const __attribute__((address_space(3))) bf16x8*)(kp+4608);
  kf[6]=*(const __attribute__((address_space(3))) bf16x8*)(kp+6144); kf[7]=*(const __attribute__((address_space(3))) bf16x8*)(kp+6656);
}
__device__ __forceinline__ void kload2(bf16x8*kf,lds_cptr kp,int j){ kf[2*j]=*(const __attribute__((address_space(3))) bf16x8*)(kp+j*2048); kf[2*j+1]=*(const __attribute__((address_space(3))) bf16x8*)(kp+j*2048+512); }
__device__ __forceinline__ s16x4 vtr(lds_cptr p){ return __builtin_bit_cast(s16x4,__builtin_amdgcn_ds_read_tr16_b64_v4i16((__attribute__((address_space(3))) v4i16_t*)p)); }
__device__ __forceinline__ float rowmax(const f32x16&p0,const f32x16&p1){
  float a=max3f(p0[0],p0[1],p1[0]),b=max3f(p0[2],p0[3],p1[1]);a=max3f(a,p1[2],p1[3]);
  #pragma unroll
  for(int r=4;r<16;r+=4){a=max3f(a,p0[r],p0[r+1]);b=max3f(b,p0[r+2],p0[r+3]);a=max3f(a,p1[r],p1[r+1]);b=max3f(b,p1[r+2],p1[r+3]);}
  const float m=max2f(a,b);
  auto rr=__builtin_amdgcn_permlane32_swap(__float_as_uint(m),__float_as_uint(m),false,false);
  return max2f(__uint_as_float(rr[0]),__uint_as_float(rr[1]));
}
__device__ __forceinline__ void pv(f32x16*o,int vb,bf16x8 pa0,bf16x8 pa1,bf16x8 pa2,bf16x8 pa3){
  #pragma unroll
  for(int d0=0;d0<2;++d0){s16x4 lo[4],hi[4];
    #pragma unroll
    for(int ks=0;ks<4;++ks){
      asm volatile("ds_read_b64_tr_b16 %0,%1 offset:%c2":"=&v"(lo[ks]):"v"(vb),"i"(d0*4096+ks*1024):"memory");
      asm volatile("ds_read_b64_tr_b16 %0,%1 offset:%c2":"=&v"(hi[ks]):"v"(vb),"i"(d0*4096+ks*1024+512):"memory");}
    asm volatile("s_waitcnt lgkmcnt(0)":::"memory");SBAR();
    #define PK(k) (bf16x8){lo[k][0],lo[k][1],lo[k][2],lo[k][3],hi[k][0],hi[k][1],hi[k][2],hi[k][3]}
    o[d0]=__builtin_amdgcn_mfma_f32_32x32x16_bf16(pa0,PK(0),o[d0],0,0,0);
    o[d0]=__builtin_amdgcn_mfma_f32_32x32x16_bf16(pa1,PK(1),o[d0],0,0,0);
    o[d0]=__builtin_amdgcn_mfma_f32_32x32x16_bf16(pa2,PK(2),o[d0],0,0,0);
    o[d0]=__builtin_amdgcn_mfma_f32_32x32x16_bf16(pa3,PK(3),o[d0],0,0,0);
    #undef PK
  }
}

#ifndef ATTN_STORE16
#define ATTN_STORE16(p,v) (*(u32x4*)(p)=(v))
#endif
template<int THRL,int MODE> __device__ __forceinline__ void attn_unit(const bf16*Qu,const int QP,const bf16*__restrict__ Kh,const int KP,const bf16*__restrict__ Vh,const int VP,bf16*Ou,const int OP,const int NT,char*shm,const int img_r0,const __attribute__((address_space(3))) float* rpb_tab){
  int tid_=threadIdx.x; asm volatile("":"+v"(tid_));
  const int tid=tid_,lane=tid&63,r32=lane&31,hi=lane>>5; const int wid=__builtin_amdgcn_readfirstlane(tid>>6);
  const bf16*Qw=Qu+(long)(wid*QBLK)*QP;
  const unsigned lds0=(unsigned)(uintptr_t)shm;
  float*wsf=(float*)(shm+LDS_WS)+wid*64;
  const bf16*ksrc=Kh+(long)lane*KP+wid*8;
  const bf16*vsrc=Vh+(long)(16*(wid&3)+(lane>>2))*VP+(wid>>2)*32+(lane&3)*8;
  const unsigned kdst=lds0+LDS_K+wid*1024, vdst=lds0+LDS_V+wid*1024;
  const int band0=(MODE==1)?min(max(img_r0-4,0),120):0;
  #define TROW(t) ((long)(t)*KVBLK+((MODE==1&&(t)>=4)?(long)band0*64:0l))
  #define DMA_K(t,slot) glds16(ksrc+TROW(t)*KP,(unsigned)__builtin_amdgcn_readfirstlane(kdst+(slot)))
  #define DMA_V(t,slot) glds16(vsrc+TROW(t)*VP,(unsigned)__builtin_amdgcn_readfirstlane(vdst+(slot)))
  const int vb0=(int)(lds0+LDS_V)+((lane>>4)&1)*32+(lane&3)*8+(4*hi+((lane&15)>>2))*64;
  const char*Kbase=shm+LDS_K; bf16x8 kf[8];
  const lds_cptr shm3=(lds_cptr)shm; const lds_cptr kp0=shm3+LDS_K+hi*1024+r32*16; const lds_cptr vp0=shm3+LDS_V+((lane>>4)&1)*32+(lane&3)*8+(4*hi+((lane&15)>>2))*64;
  DMA_K(0,0);DMA_V(0,0);DMA_K(1,SLOTB);
  bf16x8 qr[4];
  #pragma unroll
  for(int d0=0;d0<4;++d0)qr[d0]=*reinterpret_cast<const bf16x8*>(&Qw[(long)r32*QP+d0*16+hi*8]);
  if(MODE!=0){
    #pragma unroll
    for(int d0=0;d0<4;++d0){
      #pragma unroll
      for(int e=0;e<8;e+=2){ const float lo=__uint_as_float(((unsigned)(unsigned short)qr[d0][e])<<16)*C2, hi2=__uint_as_float(((unsigned)(unsigned short)qr[d0][e+1])<<16)*C2;
        const unsigned pk=cvtpk_s(lo,hi2); qr[d0][e]=(short)(pk&0xffffu); qr[d0][e+1]=(short)(pk>>16); } } }
  float mhat=0.f,l_reg=0.f;f32x16 o[2];o[0]=f32x16{};o[1]=f32x16{};f32x16 negm=f32x16{}; if(MODE!=1) asm volatile("":"+v"(negm));
  const int na_qc=32*(wid&1)+r32, na_cs=min(max(na_qc-8,0),48), na_r=img_r0+(wid>>1), na_rs=min(max(na_r-4,0),120);
  #define CMASK(P0,P1,t) do{ if(MODE==1&&(t)>=4){ const int br_=band0+(t)-4; const bool rok_=(br_>=na_rs)&&(br_<na_rs+8); \
      int qcl_=na_qc, csl_=na_cs, hil_=hi; asm volatile("":"+v"(qcl_),"+v"(csl_),"+v"(hil_));     \
      const int brow_=(rok_?(br_-na_r+7):0)*31-qcl_+15; \
      _Pragma("unroll") for(int r_=0;r_<16;++r_){ const int kc_=crow(r_,hil_); \
        const bool ok0_=rok_&&(kc_>=csl_)&&(kc_<csl_+16), ok1_=rok_&&(kc_+32>=csl_)&&(kc_+32<csl_+16); \
        const float b0_=rpb_tab[ok0_?brow_+kc_:0], b1_=rpb_tab[ok1_?brow_+kc_+32:0]; \
        P0[r_]=ok0_?P0[r_]+b0_*1.4426950408889634f:-INFINITY; P1[r_]=ok1_?P1[r_]+b1_*1.4426950408889634f:-INFINITY; } } }while(0)
  #define SUBREF(P0,P1) do{ if(MODE==1){ _Pragma("unroll") for(int r_=0;r_<16;++r_){P0[r_]-=mhat;P1[r_]-=mhat;} } }while(0)
  #define NEGMC ((MODE==1)?f32x16{}:negm)
  bool resc=false;
  #define START(P0,P1) do{ const float rm=rowmax(P0,P1); resc=false; \
    { const float dl=rm; mhat=fadd_s(mhat,dl); \
      _Pragma("unroll") for(int r=0;r<16;++r){P0[r]=fsub_s(P0[r],dl);P1[r]=fsub_s(P1[r],dl);} \
      if(MODE!=1){ _Pragma("unroll") for(int r=0;r<16;++r)negm[r]=-mhat; asm volatile("":"+v"(negm)); } } \
    _Pragma("unroll") for(int r=0;r<16;++r)P0[r]=__builtin_amdgcn_exp2f(P0[r]); }while(0)
  #define RESC() do{ if(resc){ asm volatile("s_waitcnt lgkmcnt(0)":::"memory"); \
      _Pragma("unroll") for(int d_=0;d_<2;++d_) _Pragma("unroll") for(int r=0;r<16;++r)o[d_][r]*=wsf[crow(r,hi)]; } }while(0)
  f32x16 pA0,pA1,pB0,pB1;
  int sl_prev=0,sl_cur=0,sl_next=SLOTB;
  #define ROT() do{sl_prev=sl_cur;sl_cur=sl_next;sl_next=(sl_next==(NSLOT-1)*SLOTB)?0:sl_next+SLOTB;}while(0)
  DMA_K(2,2*SLOTB);
  WAIT_BAR(3);
  qkt(pA0,pA1,Kbase,qr,negm,r32,hi);asm volatile("s_nop 15\n\ts_nop 7":"+v"(pA0),"+v"(pA1));CMASK(pA0,pA1,0);
  START(pA0,pA1);
  _Pragma("unroll") for(int r=0;r<16;++r)pA1[r]=__builtin_amdgcn_exp2f(pA1[r]);
  WAIT_BAR(0);
  DMA_K(3,0);DMA_V(1,SLOTB);
  ROT();
  kload8(kf,kp0+sl_cur);
  WAIT_BAR(2);
  s16x4 vlo[8],vhi[8]; u32x4 pw0,pw1,pw2,pw3;
  #define PKW(P,B) cvtpk_s(P[B],P[B+1])
  #define PAF(k) __builtin_bit_cast(bf16x8,pw##k)
  #define VFR(i) (bf16x8){vlo[i][0],vlo[i][1],vlo[i][2],vlo[i][3],vhi[i][0],vhi[i][1],vhi[i][2],vhi[i][3]}
  #define PIN(x) asm volatile("":"+v"(x))
  #define MX3(a,b,c) __builtin_fmaxf(__builtin_fmaxf((a),(b)),(c))
  #define GAPA(MF,A0,A1,A2,A3,W0,W1,PW) do{ MF; sacc+=A0; sacc+=A1; sacc+=A2; sacc+=A3; PIN(sacc); W0; W1; PIN(PW); SBAR(); }while(0)
  #define EX(v) __builtin_amdgcn_exp2f(v)
  #define GAPB(MF,X,B) do{ MF; X[B]=EX(X[B]); X[B+1]=EX(X[B+1]); X[B+2]=EX(X[B+2]); X[B+3]=EX(X[B+3]); PIN(X); SBAR(); }while(0)
  #define VRD(i) do{ vlo[i]=vtr(vp_+(((i)>>2)*4096+((i)&3)*1024)); vhi[i]=vtr(vp_+(((i)>>2)*4096+((i)&3)*1024+512)); }while(0)
  #define KRD(G,j) do{ if(G){ kload2(kf,kp0+sl_next,j); SBAR(); } }while(0)
  #define STEP(C0,C1,P0,P1,t,GK,GV,GL) do{ SBAR(); \
    const lds_cptr vp_=vp0+sl_prev; \
    VRD(0); SBAR(); float sacc=(P0[0]+P0[1]); \
    GAPA(C0=__builtin_amdgcn_mfma_f32_32x32x16_bf16(kf[0],qr[0],NEGMC,0,0,0), P0[2],P0[3],P0[4],P0[5],     pw0[0]=PKW(P0,0), pw0[1]=PKW(P0,2), pw0); \
    VRD(4); SBAR(); GAPA(C1=__builtin_amdgcn_mfma_f32_32x32x16_bf16(kf[1],qr[0],NEGMC,0,0,0), P0[6],P0[7],P0[8],P0[9],     pw0[2]=PKW(P0,4), pw0[3]=PKW(P0,6), pw0); \
    VRD(1); SBAR(); GAPA(C0=__builtin_amdgcn_mfma_f32_32x32x16_bf16(kf[2],qr[1],C0,0,0,0),   P0[10],P0[11],P0[12],P0[13], pw1[0]=PKW(P0,8), pw1[1]=PKW(P0,10), pw1); \
    VRD(5); SBAR(); GAPA(C1=__builtin_amdgcn_mfma_f32_32x32x16_bf16(kf[3],qr[1],C1,0,0,0),   P0[14],P0[15],P1[0],P1[1],   pw1[2]=PKW(P0,12),pw1[3]=PKW(P0,14), pw1); \
    VRD(2); SBAR(); GAPA(C0=__builtin_amdgcn_mfma_f32_32x32x16_bf16(kf[4],qr[2],C0,0,0,0),   P1[2],P1[3],P1[4],P1[5],     pw2[0]=PKW(P1,0), pw2[1]=PKW(P1,2), pw2); \
    VRD(6); SBAR(); GAPA(C1=__builtin_amdgcn_mfma_f32_32x32x16_bf16(kf[5],qr[2],C1,0,0,0),   P1[6],P1[7],P1[8],P1[9],     pw2[2]=PKW(P1,4), pw2[3]=PKW(P1,6), pw2); \
    VRD(3); SBAR(); GAPA(C0=__builtin_amdgcn_mfma_f32_32x32x16_bf16(kf[6],qr[3],C0,0,0,0),   P1[10],P1[11],P1[12],P1[13], pw3[0]=PKW(P1,8), pw3[1]=PKW(P1,10), pw3); \
    VRD(7); SBAR(); GAPA(C1=__builtin_amdgcn_mfma_f32_32x32x16_bf16(kf[7],qr[3],C1,0,0,0),   P1[14],P1[15],0.f,0.f,       pw3[2]=PKW(P1,12),pw3[3]=PKW(P1,14), pw3); \
    l_reg+=sacc; \
    if(GK){DMA_K((t)+3,sl_cur);} if(GV){DMA_V((t)+1,sl_next);} \
    SUBREF(C0,C1); CMASK(C0,C1,t); \
    { float a=MX3(C0[0],C0[1],C1[0]),b=MX3(C0[2],C0[3],C1[1]); a=MX3(a,C1[2],C1[3]); \
      _Pragma("unroll") for(int r=4;r<16;r+=4){a=MX3(a,C0[r],C0[r+1]);b=MX3(b,C0[r+2],C0[r+3]);a=MX3(a,C1[r],C1[r+1]);b=MX3(b,C1[r+2],C1[r+3]);} \
      float rm=__builtin_fmaxf(a,b); { auto rr=__builtin_amdgcn_permlane32_swap(__float_as_uint(rm),__float_as_uint(rm),false,false); rm=__builtin_fmaxf(__uint_as_float(rr[0]),__uint_as_float(rr[1])); } \
      resc=false; \
      if(__builtin_expect(__any(rm>(float)THRL),0)){ const float dl=__builtin_fmaxf(rm,0.f); mhat+=dl; \
        _Pragma("unroll") for(int r=0;r<16;++r){C0[r]-=dl;C1[r]-=dl;} \
        if(MODE!=1){ _Pragma("unroll") for(int r=0;r<16;++r)negm[r]=-mhat; asm volatile("":"+v"(negm)); } \
        const float f=__builtin_amdgcn_exp2f(-dl); l_reg*=f; if(hi==0)wsf[r32]=f; resc=true; } } \
    SBAR(); \
    GAPB(o[0]=__builtin_amdgcn_mfma_f32_32x32x16_bf16(PAF(0),VFR(0),o[0],0,0,0), C0,0); \
    GAPB(o[1]=__builtin_amdgcn_mfma_f32_32x32x16_bf16(PAF(0),VFR(4),o[1],0,0,0), C0,4); \
    KRD(GL,0); GAPB(o[0]=__builtin_amdgcn_mfma_f32_32x32x16_bf16(PAF(1),VFR(1),o[0],0,0,0), C0,8); \
    KRD(GL,1); GAPB(o[1]=__builtin_amdgcn_mfma_f32_32x32x16_bf16(PAF(1),VFR(5),o[1],0,0,0), C0,12); \
    KRD(GL,2); GAPB(o[0]=__builtin_amdgcn_mfma_f32_32x32x16_bf16(PAF(2),VFR(2),o[0],0,0,0), C1,0); \
    KRD(GL,3); GAPB(o[1]=__builtin_amdgcn_mfma_f32_32x32x16_bf16(PAF(2),VFR(6),o[1],0,0,0), C1,4); \
    GAPB(o[0]=__builtin_amdgcn_mfma_f32_32x32x16_bf16(PAF(3),VFR(3),o[0],0,0,0), C1,8); \
    GAPB(o[1]=__builtin_amdgcn_mfma_f32_32x32x16_bf16(PAF(3),VFR(7),o[1],0,0,0), C1,12); \
    }while(0)
  int t=1;
  for(;t+5<NT;t+=2){
    STEP(pB0,pB1,pA0,pA1,t,true,true,true);     WAIT_BAR(2); RESC(); ROT();
    STEP(pA0,pA1,pB0,pB1,t+1,true,true,true);   WAIT_BAR(2); RESC(); ROT();
  }
  #define ENDW(tt) do{ if((tt)+3<NT){WAIT_BAR(2);} else if((tt)+2<NT){WAIT_BAR(1);} else {WAIT_BAR(0);} }while(0)
  for(;t+1<NT;t+=2){
    STEP(pB0,pB1,pA0,pA1,t,(t+3<NT),(t+1<NT),(t+1<NT));       ENDW(t);   RESC(); ROT();
    STEP(pA0,pA1,pB0,pB1,t+1,(t+4<NT),(t+2<NT),(t+2<NT));     ENDW(t+1); RESC(); ROT();
  }
  STEP(pB0,pB1,pA0,pA1,NT-1,false,false,false); RESC();
  { float sacc=pB0[0]+pB0[1]; _Pragma("unroll") for(int r=2;r<16;++r)sacc+=pB0[r]; _Pragma("unroll") for(int r=0;r<16;++r)sacc+=pB1[r]; l_reg+=sacc;
    pw0=(u32x4){PKW(pB0,0),PKW(pB0,2),PKW(pB0,4),PKW(pB0,6)};pw1=(u32x4){PKW(pB0,8),PKW(pB0,10),PKW(pB0,12),PKW(pB0,14)};pw2=(u32x4){PKW(pB1,0),PKW(pB1,2),PKW(pB1,4),PKW(pB1,6)};pw3=(u32x4){PKW(pB1,8),PKW(pB1,10),PKW(pB1,12),PKW(pB1,14)};
    SBAR(); pv(o,vb0+sl_cur,PAF(0),PAF(1),PAF(2),PAF(3)); }
  #undef PKW
  #undef PAF
  #undef VFR
  #undef PIN
  #undef MX3
  #undef GAPA
  #undef GAPB
  #undef EX
  #undef VRD
  #undef KRD
  #undef STEP
  #undef ENDW
  {auto rr=__builtin_amdgcn_permlane32_swap(__float_as_uint(l_reg),__float_as_uint(l_reg),false,false);l_reg=__uint_as_float(rr[0])+__uint_as_float(rr[1]);}
  if(hi==0)wsf[32+r32]=l_reg;asm volatile("s_waitcnt lgkmcnt(0)":::"memory");
  float rli[16];
  #pragma unroll
  for(int r=0;r<16;++r)rli[r]=__builtin_amdgcn_rcpf(wsf[32+crow(r,hi)]);
  bf16*Ow=Ou+(long)(wid*QBLK)*OP;
  { bf16*stg=(bf16*)(shm+LDS_OST)+wid*2048;
    #pragma unroll
    for(int r=0;r<16;++r){const int orow=crow(r,hi);
      #pragma unroll
      for(int d0=0;d0<2;++d0)stg[orow*64+d0*32+r32]=__float2bfloat16(o[d0][r]*rli[r]);}
    asm volatile("s_waitcnt lgkmcnt(0)":::"memory");
    #pragma unroll
    for(int i=0;i<4;++i){const int row=i*8+(lane>>3),ch=lane&7; const u32x4 v=*(const u32x4*)(stg+row*64+ch*8); ATTN_STORE16(Ow+(long)row*OP+ch*8,v);} }
  asm volatile("s_waitcnt lgkmcnt(0)\n\ts_barrier":::"memory");
  #undef DMA_K
  #undef DMA_V
  #undef TROW
  #undef CMASK
  #undef SUBREF
  #undef NEGMC
  #undef START
  #undef RESC
  #undef ROT
}
constexpr int ATTN_LDS_BYTES=LDS_BYTES;
#undef SBAR
#undef WAIT_BAR
}

constexpr int D = 2048, T = 8192, LC = 256, MT = T + LC, DEPTH = 4;
constexpr int INW = 5408, INWP = 5632;
constexpr int C_NAQ = 0, C_NAK = 512, C_NAV = 1024, C_GQ = 1536, C_GK = 2048, C_GV = 2560, C_GG = 3584, C_GLR = 4608, C_CQ = 4640, C_CK = 5152, C_CV = 5280;
constexpr int NCH = MT / 64;
constexpr float LN_EPS = 1e-6f, ALPHA = 1.681792830507429f;
constexpr int NEXP = 16384;

constexpr size_t MiB = 1u << 20;
constexpr size_t WS_CTL = 0, CTL_ZERO_BYTES = 32 * 1024;
constexpr size_t WS_MOD = 1 * MiB;
constexpr size_t WS_ROPE = WS_MOD + 512 * 1024;
constexpr size_t WS_WIN = 2 * MiB;
constexpr size_t WS_WOUT = WS_WIN + 88 * MiB;
constexpr size_t WS_WP = WS_WOUT + 32 * MiB;
constexpr size_t WS_X = WS_WP + 32 * MiB;
constexpr size_t WS_Z = WS_X + 66 * MiB;
constexpr size_t WS_H = WS_Z + 66 * MiB;
constexpr size_t WS_P = WS_H + 33 * MiB;
constexpr size_t WS_QC = WS_P + 91 * MiB;
constexpr size_t WS_KC = WS_QC + 9 * MiB;
constexpr size_t WS_QTF = WS_KC + 3 * MiB;
constexpr size_t WS_QTB = WS_QTF + 9 * MiB;
constexpr size_t WS_OI = WS_QTB + 9 * MiB;
constexpr size_t WS_UPD = WS_OI + 33 * MiB;
constexpr size_t WS_SPREV = WS_UPD + 132 * MiB;
constexpr size_t WS_DEC = WS_SPREV + 132 * MiB;
constexpr size_t WS_MIX = WS_DEC + 1 * MiB;
constexpr size_t WS_ST = WS_MIX + 33 * MiB;
constexpr size_t WS_IDX = WS_ST + 66 * MiB;
constexpr size_t WS_GATE = WS_IDX + 5 * MiB;
constexpr size_t WS_PU = WS_GATE + 5 * MiB;
constexpr size_t WS_PV = WS_PU + 128 * MiB;
constexpr size_t WS_SCU = WS_PV + 128 * MiB;
constexpr size_t WS_SCV = WS_SCU + 1 * MiB;
constexpr size_t WS_VC = WS_SCV + 1 * MiB;
constexpr size_t WS_ACT = WS_VC + 3 * MiB;
constexpr size_t WS_PART = WS_ACT + 5 * MiB;
constexpr size_t WS_END = WS_PART + 67 * MiB;
constexpr int CW_BAR = 4096;

constexpr int RING_BYTES = 147456;
constexpr int LDSCTL_OFF = RING_BYTES, MISC_OFF = LDSCTL_OFF + 320;
constexpr int LDS_BYTES = 148480;
constexpr int NWAVES = 8, NT = 512;

#ifndef REP_MASK
#define REP_MASK 0
#endif
#define RP(b) ((((REP_MASK) >> (b)) & 1) ? 2 : 1)
#define GAS __attribute__((address_space(1)))
#define LAS __attribute__((address_space(3)))
typedef unsigned short bf16;
typedef unsigned v4u __attribute__((ext_vector_type(4)));
typedef unsigned v2u __attribute__((ext_vector_type(2)));
typedef float f32x4 __attribute__((ext_vector_type(4)));
typedef float f32x2 __attribute__((ext_vector_type(2)));
typedef short bf16x8v __attribute__((ext_vector_type(8)));
typedef float f32x16v __attribute__((ext_vector_type(16)));
#define LDS_WAIT() asm volatile("s_waitcnt lgkmcnt(0)" ::: "memory")
__device__ __forceinline__ unsigned f2bf(float f) { return (unsigned)__builtin_bit_cast(unsigned short, (__bf16)f); }
typedef __bf16 bf16x2_t __attribute__((ext_vector_type(2)));
__device__ __forceinline__ unsigned pk2(float lo, float hi) { const bf16x2_t b = __builtin_convertvector((f32x2){lo, hi}, bf16x2_t); return __builtin_bit_cast(unsigned, b); }
__device__ __forceinline__ float bflo(unsigned w) { return __builtin_bit_cast(float, w << 16); }
__device__ __forceinline__ float bfhi(unsigned w) { return __builtin_bit_cast(float, w & 0xffff0000u); }
__device__ __forceinline__ float bf1(bf16 v) { return __builtin_bit_cast(float, (unsigned)v << 16); }
__device__ __forceinline__ float wave_sum(float v) {
#pragma unroll
    for (int o = 1; o < 64; o <<= 1) v += __shfl_xor(v, o);
    return v;
}
__device__ __forceinline__ float silu_f(float x) { return x / (1.f + __expf(-x)); }
__device__ __forceinline__ float gelu_tanh(float x) { const float u = 0.7978845608028654f * (x + 0.044715f * x * x * x); const float t = 1.f - 2.f / (1.f + __expf(2.f * u)); return 0.5f * x * (1.f + t); }
__device__ __forceinline__ float logsigmoid_f(float z) { return fminf(z, 0.f) - __logf(1.f + __expf(-fabsf(z))); }

#define XB_TMO      128
#define XB_XCNT(j)  (256  + 64 * (j))
#define XB_XSUB(j)  (1280 + 64 * (j))
#define XB_XGEN(j)  (2304 + 64 * (j))
#define XB_TOP      3328
#define XB_TOPGEN   3392
#define XCD_BAR_WORDS 3456
#define XB_SPIN_CAP (1u << 21)
__device__ __forceinline__ unsigned xb_ld(unsigned* p)              { return __hip_atomic_load(p, __ATOMIC_RELAXED, __HIP_MEMORY_SCOPE_AGENT); }
__device__ __forceinline__ unsigned xb_add(unsigned* p, unsigned v) { return __hip_atomic_fetch_add(p, v, __ATOMIC_RELAXED, __HIP_MEMORY_SCOPE_AGENT); }
__device__ __forceinline__ unsigned xb_xcc_id() { return (unsigned)__builtin_amdgcn_s_getreg((3 << 11) | 20) & 0xFu; }
#define XB_SPIN(cond, bar) do { unsigned _sp = 0; while (cond) { __builtin_amdgcn_s_sleep(1); \
    if ((++_sp & 255u) == 0u) { if (xb_ld(&(bar)[XB_TMO])) break; if (_sp > XB_SPIN_CAP) { atomicAdd(&(bar)[XB_TMO], 1u); break; } } } } while (0)
struct XcdBarrier { unsigned* bar; unsigned x; volatile LAS unsigned* st; };
__device__ __forceinline__ XcdBarrier xcd_barrier_post(unsigned* bar, volatile LAS unsigned* st) {
    XcdBarrier b; b.bar = bar; b.x = xb_xcc_id(); b.st = st;
    if (threadIdx.x == 0) (void)xb_add(&bar[XB_XCNT(b.x)], 1u);
    return b;
}
__device__ __forceinline__ void xcd_barrier_complete(unsigned* bar, unsigned x, unsigned& nloc, unsigned& nx) {
    const unsigned G = gridDim.x * gridDim.y * gridDim.z;
    unsigned sum, cnt, mine, sp = 0u;
    for (;;) {
        sum = 0u; cnt = 0u; mine = 0u;
#pragma unroll
        for (unsigned j = 0; j < 16; ++j) { const unsigned c = xb_ld(&bar[XB_XCNT(j)]); sum += c; cnt += (c > 0u) ? 1u : 0u; mine = (j == x) ? c : mine; }
        if (sum == G) break;
        __builtin_amdgcn_s_sleep(1);
        if ((++sp & 255u) == 0u) { if (xb_ld(&bar[XB_TMO])) break; if (sp > XB_SPIN_CAP) { atomicAdd(&bar[XB_TMO], 1u); break; } }
    }
    nloc = mine > 0u ? mine : 1u; nx = cnt > 0u ? cnt : 1u;
}
__device__ __forceinline__ void xcd_barrier(const XcdBarrier& b) {
    asm volatile("s_waitcnt vmcnt(0)" ::: "memory");
    __syncthreads();
    if (threadIdx.x == 0) {
        unsigned* bar = b.bar;
        __builtin_amdgcn_s_waitcnt(0);
        unsigned nloc = b.st[0], nx = b.st[1];
        if (nloc == 0u) { xcd_barrier_complete(bar, b.x, nloc, nx); b.st[0] = nloc; b.st[1] = nx; }
        const unsigned old = xb_add(&bar[XB_XSUB(b.x)], 1u);
        const unsigned gen = old / nloc;
        if (old + 1u == (gen + 1u) * nloc) {
            __builtin_amdgcn_fence(__ATOMIC_RELEASE, "agent");
            asm volatile("s_waitcnt vmcnt(0)" ::: "memory");
            const unsigned og = xb_add(&bar[XB_TOP], 1u);
            const unsigned tg = og / nx;
            if (og + 1u == (tg + 1u) * nx) xb_add(&bar[XB_TOPGEN], 1u);
            else XB_SPIN(xb_ld(&bar[XB_TOPGEN]) == tg, bar);
            __builtin_amdgcn_fence(__ATOMIC_ACQUIRE, "agent");
            xb_add(&bar[XB_XGEN(b.x)], 1u);
            asm volatile("s_waitcnt vmcnt(0)" ::: "memory");
        } else {
            XB_SPIN(xb_ld(&bar[XB_XGEN(b.x)]) == gen, bar);
            __builtin_amdgcn_fence(__ATOMIC_ACQUIRE, "agent");
            asm volatile("s_waitcnt vmcnt(0)" ::: "memory");
        }
    }
    __syncthreads();
}

struct Args { const float* in[22]; float* out; unsigned char* ws; int ph_lo, ph_hi; };
struct Frame {
    LAS unsigned char* lds; char* ldsg;
    int tid, lane, wave, vcu, G;
    const __attribute__((address_space(4))) Args* ap;
};
#define IN_X(F) ((F).ap->in[0])
#define IN_C(F) ((F).ap->in[1])
#define IN_CTX(F) ((F).ap->in[2])
#define IN_CCTX(F) ((F).ap->in[3])
#define IN_WMOD(F) ((F).ap->in[4])
#define IN_BMOD(F) ((F).ap->in[5])
#define IN_WIN(F) ((F).ap->in[6])
#define IN_RPB(F) ((F).ap->in[7])
#define IN_GGW(F) ((F).ap->in[8])
#define IN_GGB(F) ((F).ap->in[9])
#define IN_GNW(F) ((F).ap->in[10])
#define IN_QNW(F) ((F).ap->in[11])
#define IN_KNW(F) ((F).ap->in[12])
#define IN_WOUT(F) ((F).ap->in[13])
#define IN_LN1G(F) ((F).ap->in[14])
#define IN_LN1B(F) ((F).ap->in[15])
#define IN_WQ(F) ((F).ap->in[16])
#define IN_SUBK(F) ((F).ap->in[17])
#define IN_PU(F) ((F).ap->in[18])
#define IN_PV(F) ((F).ap->in[19])
#define IN_LN2G(F) ((F).ap->in[20])
#define IN_LN2B(F) ((F).ap->in[21])
#define WSP(F, T_, off) ((T_*)((F).ap->ws + (off)))
__device__ __forceinline__ void launder(Frame& F) { int t_ = F.tid; asm volatile("" : "+v"(t_)); F.tid = t_; F.lane = t_ & 63; F.wave = __builtin_amdgcn_readfirstlane(t_ >> 6);
    const __attribute__((address_space(4))) Args* a_ = F.ap; asm volatile("" : "+s"(a_)); F.ap = a_; }

__device__ __forceinline__ void row_load_f32(const float* row, int lane, float (&v)[32]) {
#pragma unroll
    for (int j = 0; j < 4; ++j) { const f32x4 a = *(const f32x4*)(row + 8 * lane + 512 * j), b = *(const f32x4*)(row + 8 * lane + 512 * j + 4);
        v[8 * j + 0] = a[0]; v[8 * j + 1] = a[1]; v[8 * j + 2] = a[2]; v[8 * j + 3] = a[3]; v[8 * j + 4] = b[0]; v[8 * j + 5] = b[1]; v[8 * j + 6] = b[2]; v[8 * j + 7] = b[3]; }
}
__device__ __forceinline__ void row_store_f32(float* row, int lane, const float (&v)[32]) {
#pragma unroll
    for (int j = 0; j < 4; ++j) { *(f32x4*)(row + 8 * lane + 512 * j) = (f32x4){v[8 * j], v[8 * j + 1], v[8 * j + 2], v[8 * j + 3]}; *(f32x4*)(row + 8 * lane + 512 * j + 4) = (f32x4){v[8 * j + 4], v[8 * j + 5], v[8 * j + 6], v[8 * j + 7]}; }
}
__device__ __forceinline__ void row_load_bf16(const bf16* row, int lane, float (&v)[32]) {
#pragma unroll
    for (int j = 0; j < 4; ++j) { const v4u w = *(const v4u*)(row + 8 * lane + 512 * j);
        v[8 * j + 0] = bflo(w.x); v[8 * j + 1] = bfhi(w.x); v[8 * j + 2] = bflo(w.y); v[8 * j + 3] = bfhi(w.y); v[8 * j + 4] = bflo(w.z); v[8 * j + 5] = bfhi(w.z); v[8 * j + 6] = bflo(w.w); v[8 * j + 7] = bfhi(w.w); }
}
__device__ __forceinline__ void row_fetch_bf16(const bf16* row, int lane, v4u (&w)[4]) {
#pragma unroll
    for (int j = 0; j < 4; ++j) w[j] = *(const v4u*)(row + 8 * lane + 512 * j);
}
__device__ __forceinline__ void row_expand_bf16(const v4u (&w)[4], float (&v)[32]) {
#pragma unroll
    for (int j = 0; j < 4; ++j) { v[8 * j + 0] = bflo(w[j].x); v[8 * j + 1] = bfhi(w[j].x); v[8 * j + 2] = bflo(w[j].y); v[8 * j + 3] = bfhi(w[j].y); v[8 * j + 4] = bflo(w[j].z); v[8 * j + 5] = bfhi(w[j].z); v[8 * j + 6] = bflo(w[j].w); v[8 * j + 7] = bfhi(w[j].w); }
}
__device__ __forceinline__ void row_store_bf16(bf16* row, int lane, const float (&v)[32]) {
#pragma unroll
    for (int j = 0; j < 4; ++j) { v4u w; w.x = pk2(v[8 * j], v[8 * j + 1]); w.y = pk2(v[8 * j + 2], v[8 * j + 3]); w.z = pk2(v[8 * j + 4], v[8 * j + 5]); w.w = pk2(v[8 * j + 6], v[8 * j + 7]); *(v4u*)(row + 8 * lane + 512 * j) = w; }
}
__device__ __forceinline__ void row_norm(float (&v)[32]) {
    float s = 0.f;
#pragma unroll
    for (int i = 0; i < 32; ++i) s += v[i];
    const float mean = wave_sum(s) * (1.f / D); float q = 0.f;
#pragma unroll
    for (int i = 0; i < 32; ++i) { v[i] -= mean; q += v[i] * v[i]; }
    const float rstd = rsqrtf(wave_sum(q) * (1.f / D) + LN_EPS);
#pragma unroll
    for (int i = 0; i < 32; ++i) v[i] *= rstd;
}
__device__ __forceinline__ void row_affine(float (&v)[32], const float* mul, const float* add, int lane, float one) {
#pragma unroll
    for (int j = 0; j < 4; ++j)
#pragma unroll
        for (int h = 0; h < 2; ++h) { const f32x4 m = *(const f32x4*)(mul + 8 * lane + 512 * j + 4 * h), a = *(const f32x4*)(add + 8 * lane + 512 * j + 4 * h);
#pragma unroll
            for (int c = 0; c < 4; ++c) v[8 * j + 4 * h + c] = v[8 * j + 4 * h + c] * (one + m[c]) + a[c]; }
}

__device__ __forceinline__ void p0_transpose_item(const float* W, int K, int N, bf16* WT, LAS float* scr, int item, int lane) {
    const int nblk = N / 32, kb = item / nblk, nb = item % nblk, k0 = 64 * kb, n0 = 32 * nb;
#pragma unroll 8
    for (int i = 0; i < 32; ++i) { const int kk = 2 * i + (lane >> 5); scr[kk * 33 + (lane & 31)] = W[(size_t)(k0 + kk) * N + n0 + (lane & 31)]; }
    LDS_WAIT(); asm volatile("" ::: "memory");
    const int c = lane & 7;
#pragma unroll
    for (int j = 0; j < 4; ++j) { const int n = (lane >> 3) + 8 * j; const LAS float* s = scr + (8 * c) * 33 + n;
        v4u o; o.x = pk2(s[0 * 33], s[1 * 33]); o.y = pk2(s[2 * 33], s[3 * 33]); o.z = pk2(s[4 * 33], s[5 * 33]); o.w = pk2(s[6 * 33], s[7 * 33]);
        *(v4u*)(WT + (size_t)(n0 + n) * K + k0 + 8 * c) = o; }
    LDS_WAIT(); asm volatile("" ::: "memory");
}

__device__ __forceinline__ void phase_prologue_a(Frame& F) {
    launder(F);
    const int tid = F.tid, lane = F.lane, wave = F.wave;
    for (int rp = 0; rp < RP(16); ++rp) {
        LAS float* sc = (LAS float*)F.lds;
        LAS float* red = sc + 4096;
        for (int i = tid; i < D; i += NT) { sc[i] = silu_f(IN_C(F)[i]); sc[D + i] = silu_f(IN_CCTX(F)[i]); }
        __syncthreads();
        for (int u = F.vcu; u < DEPTH * 96; u += F.G) {
            const int l = u / 96, cg = u % 96;
            const float* W = IN_WMOD(F) + (size_t)l * D * 12288 + cg * 128 + 2 * lane;
            const int k0 = wave * 256; float a0 = 0.f, a1 = 0.f, b0 = 0.f, b1 = 0.f;
#pragma unroll 8
            for (int kk = 0; kk < 256; ++kk) { const f32x2 w = *(const f32x2*)(W + (size_t)(k0 + kk) * 12288); const float s0 = sc[k0 + kk], s1 = sc[D + k0 + kk];
                a0 += s0 * w.x; a1 += s0 * w.y; b0 += s1 * w.x; b1 += s1 * w.y; }
            LAS float* r = red + (wave * 64 + lane) * 4; r[0] = a0; r[1] = a1; r[2] = b0; r[3] = b1;
            __syncthreads();
            if (wave == 0) { float s[4] = {0.f, 0.f, 0.f, 0.f};
#pragma unroll
                for (int w = 0; w < 8; ++w)
#pragma unroll
                    for (int c = 0; c < 4; ++c) s[c] += red[(w * 64 + lane) * 4 + c];
                const int col = cg * 128 + 2 * lane; const float* bm = IN_BMOD(F) + l * 12288 + col; float* mo = WSP(F, float, WS_MOD) + (size_t)l * 2 * 12288 + col;
                mo[0] = s[0] + bm[0]; mo[1] = s[1] + bm[1]; mo[12288] = s[2] + bm[0]; mo[12288 + 1] = s[3] + bm[1]; }
            __syncthreads();
        }
        __syncthreads();
    }
    for (int rp = 0; rp < RP(17); ++rp) {
        LAS float* scr = (LAS float*)(F.lds + wave * 16384);
        const int gw = F.vcu * NWAVES + wave, NGW = F.G * NWAVES;
        constexpr int I_IN = (D / 64) * (INW / 32), I_OUT = (D / 64) * (D / 32), I_L = I_IN + I_OUT;
        for (int it = gw; it < DEPTH * I_L; it += NGW) {
            const int l = it / I_L, r = it % I_L;
            if (r < I_IN) p0_transpose_item(IN_WIN(F) + (size_t)l * D * INW, D, INW, WSP(F, bf16, WS_WIN) + (size_t)l * INWP * D, scr, r, lane);
            else p0_transpose_item(IN_WOUT(F) + (size_t)l * D * D, D, D, WSP(F, bf16, WS_WOUT) + (size_t)l * D * D, scr, r - I_IN, lane);
        }
        const int gt = F.vcu * NT + tid, NGT = F.G * NT;
        for (int i = gt; i < DEPTH * 57344; i += NGT) { const int l = i / 57344, r = i % 57344; *(v4u*)(WSP(F, bf16, WS_WIN) + (size_t)l * INWP * D + (size_t)INW * D + (size_t)r * 8) = (v4u){0u, 0u, 0u, 0u}; }
        for (int i = gt; i < 2048; i += NGT) {
            const int pos = i >> 4, p = i & 15;
            const float invf[16] = {1.0f, 0.5623413324356079f, 0.3162277638912201f, 0.17782793939113617f, 0.10000000149011612f, 0.05623413249850273f, 0.03162277489900589f, 0.017782794311642647f,
                                    0.009999999776482582f, 0.005623413249850273f, 0.003162277629598975f, 0.0017782794311642647f, 0.0010000000474974513f, 0.000562341301701963f, 0.0003162277571391314f, 0.00017782794020604342f};
            float th_f = invf[0];
#pragma unroll
            for (int q = 1; q < 16; ++q) th_f = (p == q) ? invf[q] : th_f;
            const double th = (double)th_f, t2 = th * th;
            double cs = 1.0, sn = th, tc = 1.0, ts = th;
#pragma unroll
            for (int n = 1; n <= 10; ++n) { tc *= -t2 / (double)((2 * n - 1) * (2 * n)); ts *= -t2 / (double)((2 * n) * (2 * n + 1)); cs += tc; sn += ts; }
            double rc = 1.0, rs = 0.0, bc = cs, bs = sn;
#pragma unroll
            for (int b = 0; b < 7; ++b) { if ((pos >> b) & 1) { const double nc = rc * bc - rs * bs, ns = rc * bs + rs * bc; rc = nc; rs = ns; } const double nb = bc * bc - bs * bs, nbs = 2.0 * bc * bs; bc = nb; bs = nbs; }
            WSP(F, float, WS_ROPE)[i] = (float)rc; WSP(F, float, WS_ROPE)[2048 + i] = (float)rs;
        }
        __syncthreads();
    }
    for (int rp = 0; rp < RP(18); ++rp) {
        const int gw = F.vcu * NWAVES + wave, NGW = F.G * NWAVES;
        for (int r = gw; r < 2 * DEPTH * NEXP; r += NGW) {
            const bool isv = r >= DEPTH * NEXP; const int rr = isv ? r - DEPTH * NEXP : r;
            const float* src = (isv ? IN_PV(F) : IN_PU(F)) + (size_t)rr * D;
            float v[32]; row_load_f32(src, lane, v);
            float mx = 0.f;
#pragma unroll
            for (int i = 0; i < 32; ++i) mx = fmaxf(mx, fabsf(v[i]));
#pragma unroll
            for (int o = 1; o < 64; o <<= 1) mx = fmaxf(mx, __shfl_xor(mx, o));
            const float sc = mx > 0.f ? 240.f / mx : 0.f;
            unsigned char* dst = WSP(F, unsigned char, isv ? WS_PV : WS_PU) + (size_t)rr * D + 16 * lane;
#pragma unroll
            for (int hf = 0; hf < 2; ++hf) { v4u o;
#pragma unroll
                for (int w = 0; w < 4; ++w) { const int b = 8 * (2 * hf + (w >> 1)) + 4 * (w & 1); int p = 0;
                    p = __builtin_amdgcn_cvt_pk_fp8_f32(v[b] * sc, v[b + 1] * sc, p, false); p = __builtin_amdgcn_cvt_pk_fp8_f32(v[b + 2] * sc, v[b + 3] * sc, p, true); o[w] = (unsigned)p; }
                *(v4u*)(dst + 1024 * hf) = o; }
            if (lane == 0) WSP(F, float, WS_SCU)[2 * rr + (isv ? 1 : 0)] = mx * (1.f / 240.f);
        }
    }
    for (int rp = 0; rp < RP(19); ++rp) {
        const int gw = F.vcu * NWAVES + wave, NGW = F.G * NWAVES, fr = lane & 15, fq = lane >> 4;
        for (int task = gw; task < DEPTH * 16 * 4 * 32; task += NGW) {
            const int l = task >> 11, hp = (task >> 7) & 15, mt = (task >> 5) & 3, nt = task & 31;
            const float* wq = IN_WQ(F) + (size_t)l * D * D + (size_t)(64 * nt + fr) * D + hp * 128 + 8 * fq;
            const float* sk = IN_SUBK(F) + (((size_t)l * 16 + hp) * 128 + 32 * mt + fr) * 128 + 8 * fq;
            f32x4 acc[4][2];
#pragma unroll
            for (int n = 0; n < 4; ++n)
#pragma unroll
                for (int m = 0; m < 2; ++m) acc[n][m] = (f32x4){0.f, 0.f, 0.f, 0.f};
#pragma unroll 1
            for (int ks = 0; ks < 4; ++ks) {
                f32x4 ar[4][2], br[2][2];
#pragma unroll
                for (int n = 0; n < 4; ++n) { ar[n][0] = *(const f32x4*)(wq + (size_t)(16 * n) * D + 32 * ks); ar[n][1] = *(const f32x4*)(wq + (size_t)(16 * n) * D + 32 * ks + 4); }
#pragma unroll
                for (int m = 0; m < 2; ++m) { br[m][0] = *(const f32x4*)(sk + (16 * m) * 128 + 32 * ks); br[m][1] = *(const f32x4*)(sk + (16 * m) * 128 + 32 * ks + 4); }
                bf16x8v ah[4], al[4], bh[2], bl[2];
#pragma unroll
                for (int n = 0; n < 4; ++n)
#pragma unroll
                    for (int e = 0; e < 8; ++e) { const float x = ar[n][e >> 2][e & 3]; const unsigned hb = f2bf(x); ah[n][e] = (short)hb; al[n][e] = (short)f2bf(x - __builtin_bit_cast(float, hb << 16)); }
#pragma unroll
                for (int m = 0; m < 2; ++m)
#pragma unroll
                    for (int e = 0; e < 8; ++e) { const float x = br[m][e >> 2][e & 3]; const unsigned hb = f2bf(x); bh[m][e] = (short)hb; bl[m][e] = (short)f2bf(x - __builtin_bit_cast(float, hb << 16)); }
#pragma unroll
                for (int n = 0; n < 4; ++n)
#pragma unroll
                    for (int m = 0; m < 2; ++m) { acc[n][m] = __builtin_amdgcn_mfma_f32_16x16x32_bf16(ah[n], bh[m], acc[n][m], 0, 0, 0);
                        acc[n][m] = __builtin_amdgcn_mfma_f32_16x16x32_bf16(ah[n], bl[m], acc[n][m], 0, 0, 0); acc[n][m] = __builtin_amdgcn_mfma_f32_16x16x32_bf16(al[n], bh[m], acc[n][m], 0, 0, 0); }
            }
#pragma unroll
            for (int n = 0; n < 4; ++n)
#pragma unroll
                for (int m = 0; m < 2; ++m) { bf16* dst = WSP(F, bf16, WS_WP) + ((size_t)l * D + hp * 128 + 32 * mt + 16 * m + fr) * D + 64 * nt + 16 * n + 4 * fq;
                    *(v2u*)dst = (v2u){pk2(acc[n][m][0], acc[n][m][1]), pk2(acc[n][m][2], acc[n][m][3])}; }
        }
    }
}

__device__ __forceinline__ void phase_ln0(Frame& F) {
    launder(F);
    const int gw = F.vcu * NWAVES + F.wave, NGW = F.G * NWAVES, lane = F.lane;
    for (int m = gw; m < MT; m += NGW) {
        const float* src = (m < LC) ? IN_CTX(F) + (size_t)m * D : IN_X(F) + (size_t)(m - LC) * D;
        const float* mod = WSP(F, float, WS_MOD) + (m < LC ? 12288 : 0);
        float v[32]; row_load_f32(src, lane, v);
        row_store_bf16(WSP(F, bf16, WS_X) + (size_t)m * D, lane, v);
        row_norm(v); row_affine(v, mod + D, mod, lane, 1.f);
        row_store_bf16(WSP(F, bf16, WS_H) + (size_t)m * D, lane, v);
    }
}

__device__ __forceinline__ void phase_qknorm(Frame& F, int l) {
    launder(F);
    const int heavy = (NCH * 4 > 2 * F.G && NCH * 4 - 2 * F.G < F.G / 2) ? NCH * 4 - 2 * F.G : 0;
    if (F.vcu < heavy) return;
    const int gw = (F.vcu - heavy) * NWAVES + F.wave, NGW = (F.G - heavy) * NWAVES, lane = F.lane, p = lane & 31, hsel = lane >> 5;
    const float* rc = WSP(F, float, WS_ROPE); const float* rsn = rc + 2048;
    const bf16* P = WSP(F, bf16, WS_P);
    for (int m = gw; m < MT; m += NGW) {
#pragma unroll
        for (int it = 0; it < 5; ++it) {
            const int hv = 2 * it + hsel;
            const int col = (hv < 8) ? (C_CQ + hv * 64) : (C_CK + (hv - 8) * 64);
            const unsigned w = *(const unsigned*)(P + (size_t)m * INWP + col + 2 * p);
            float x0 = bflo(w), x1 = bfhi(w);
            float ss = x0 * x0 + x1 * x1;
#pragma unroll
            for (int o = 1; o < 32; o <<= 1) ss += __shfl_xor(ss, o);
            const float rstd = rsqrtf(ss * (1.f / 64.f) + LN_EPS);
            const float* nw = (hv < 8 ? IN_QNW(F) : IN_KNW(F)) + l * 64 + 2 * p;
            x0 = x0 * rstd * nw[0]; x1 = x1 * rstd * nw[1];
            if (m >= LC) { const int t = m - LC, pos = (p < 16) ? (t >> 6) : (t & 63); const float c = rc[pos * 16 + (p & 15)], s = rsn[pos * 16 + (p & 15)];
                const float y0 = x0 * c - x1 * s, y1 = x0 * s + x1 * c; x0 = y0; x1 = y1; }
            if (hv < 8) *(unsigned*)(WSP(F, bf16, WS_QC) + (size_t)m * 512 + hv * 64 + 2 * p) = pk2(x0 * attn_body::C2, x1 * attn_body::C2);
            else *(unsigned*)(WSP(F, bf16, WS_KC) + (size_t)m * 128 + (hv - 8) * 64 + 2 * p) = pk2(x0, x1);
        }
        if (lane < 16) *(v4u*)(WSP(F, bf16, WS_VC) + (size_t)m * 128 + lane * 8) = *(const v4u*)(P + (size_t)m * INWP + C_CV + lane * 8);
    }
}

constexpr int GL_BSTR = 130, GL_QSTR = 136, GL_TSTR = 72;
constexpr int GL_OFF_BB = 33280, GL_OFF_QX = 66560, GL_OFF_KX = 83968, GL_OFF_KET = 101376;
__device__ __forceinline__ int crow32(int r, int hi) { return (r & 3) + 8 * (r >> 2) + 4 * hi; }
__device__ __forceinline__ void phase_gla_chunk(Frame& F, int l) {
    launder(F);
    const int tid = F.tid, lane = F.lane, wave = F.wave;
    LAS float* BF = (LAS float*)F.lds; LAS float* BB = (LAS float*)(F.lds + GL_OFF_BB);
    LAS bf16* VT = (LAS bf16*)F.lds;
    LAS bf16* QX = (LAS bf16*)(F.lds + GL_OFF_QX); LAS bf16* KX = (LAS bf16*)(F.lds + GL_OFF_KX);
    LAS float* LR = (LAS float*)(F.lds + GL_OFF_QX); LAS bf16* AC = (LAS bf16*)(F.lds + GL_OFF_QX);
    LAS bf16* KET = (LAS bf16*)(F.lds + GL_OFF_KET);
    const bf16* P = WSP(F, bf16, WS_P);
    for (int u = F.vcu; u < NCH * 4; u += F.G) {
        const int g = u >> 2, hh = u & 3, r0 = g * 64;
        unsigned short lrw[4];
#pragma unroll
        for (int c = 0; c < 4; ++c) { const int i = tid + c * NT; lrw[c] = P[(size_t)(r0 + (i >> 5)) * INWP + C_GLR + (i & 31)]; }
        const v4u kq0 = *(const v4u*)(P + (size_t)(r0 + lane) * INWP + C_GK + hh * 128 + wave * 16), kq1 = *(const v4u*)(P + (size_t)(r0 + lane) * INWP + C_GK + hh * 128 + wave * 16 + 8);
        unsigned qw8[8], kw8[8];
#pragma unroll
        for (int it = 0; it < 8; ++it) { const int i = it * 8 + wave; qw8[it] = *(const unsigned*)(P + (size_t)(r0 + i) * INWP + C_GQ + hh * 128 + 2 * lane); kw8[it] = *(const unsigned*)(P + (size_t)(r0 + i) * INWP + C_GK + hh * 128 + 2 * lane); }
        v4u vw4[4];
#pragma unroll
        for (int c4 = 0; c4 < 4; ++c4) vw4[c4] = *(const v4u*)(P + (size_t)(r0 + lane) * INWP + C_GV + hh * 256 + wave * 32 + 8 * c4);
#pragma unroll
        for (int c = 0; c < 4; ++c) LR[tid + c * NT] = bf1(lrw[c]);
        __syncthreads();
        { const int d = tid & 127, ig = tid >> 7;
          const float* Wf = IN_GGW(F) + ((size_t)l * 2 + 0) * 16 * 512 + hh * 128 + d; const float* Wb = IN_GGW(F) + ((size_t)l * 2 + 1) * 16 * 512 + hh * 128 + d;
          float wf[16], wb[16];
#pragma unroll
          for (int r = 0; r < 16; ++r) { wf[r] = Wf[r * 512]; wb[r] = Wb[r * 512]; }
          const float bfv = IN_GGB(F)[((size_t)l * 2 + 0) * 512 + hh * 128 + d], bbv = IN_GGB(F)[((size_t)l * 2 + 1) * 512 + hh * 128 + d];
          for (int i = ig * 16; i < ig * 16 + 16; ++i) { float zf = bfv, zb = bbv;
#pragma unroll
              for (int r = 0; r < 16; ++r) { zf += LR[i * 32 + r] * wf[r]; zb += LR[i * 32 + 16 + r] * wb[r]; }
              BF[i * GL_BSTR + d] = logsigmoid_f(zf) * (1.f / 16.f); BB[i * GL_BSTR + d] = logsigmoid_f(zb) * (1.f / 16.f); } }
        __syncthreads();
        if (tid < 128) { float sacc = 0.f;
#pragma unroll 8
            for (int i = 0; i < 64; ++i) { sacc += BF[i * GL_BSTR + tid]; BF[i * GL_BSTR + tid] = sacc; } }
        else if (tid < 256) { const int d = tid - 128; float sacc = 0.f;
#pragma unroll 8
            for (int i = 63; i >= 0; --i) { sacc += BB[i * GL_BSTR + d]; BB[i * GL_BSTR + d] = sacc; } }
        __syncthreads();
        { const int j = lane, d0 = wave * 16;
          const unsigned kw[8] = {kq0.x, kq0.y, kq0.z, kq0.w, kq1.x, kq1.y, kq1.z, kq1.w};
#pragma unroll
          for (int c = 0; c < 16; ++c) { const int d = d0 + c; const float kv = (c & 1) ? bfhi(kw[c >> 1]) : bflo(kw[c >> 1]);
              const float bl = BF[63 * GL_BSTR + d], b0 = BB[d];
              KET[(0 * 128 + d) * GL_TSTR + j] = (bf16)f2bf(kv * __expf(bl - BF[j * GL_BSTR + d]));
              KET[(1 * 128 + d) * GL_TSTR + j] = (bf16)f2bf(kv * __expf(b0 - BB[j * GL_BSTR + d]));
              if (j == 0) { WSP(F, float, WS_DEC)[((size_t)(0 * NCH + g) * 4 + hh) * 128 + d] = __expf(bl); WSP(F, float, WS_DEC)[((size_t)(1 * NCH + g) * 4 + hh) * 128 + d] = __expf(b0); } } }
        const int ti = wave >> 1, tjb = wave & 1, fr = lane & 15, fq = lane >> 4;
        f32x4 asum[2]; asum[0] = (f32x4){0.f, 0.f, 0.f, 0.f}; asum[1] = asum[0];
#pragma unroll 1
        for (int dir = 0; dir < 2; ++dir) {
            LAS float* BX = dir ? BB : BF; bf16* QTg = WSP(F, bf16, dir ? WS_QTB : WS_QTF);
            __syncthreads();
#pragma unroll
            for (int it = 0; it < 8; ++it) { const int i = it * 8 + wave, d = 2 * lane;
                const unsigned qw = qw8[it], kw = kw8[it];
                const f32x2 b = *(LAS f32x2*)(BX + i * GL_BSTR + d);
                const unsigned qt = pk2(bflo(qw) * 0.08838834764831845f * __expf(b.x), bfhi(qw) * 0.08838834764831845f * __expf(b.y)), kt = pk2(bflo(kw) * __expf(-b.x), bfhi(kw) * __expf(-b.y));
                *(LAS unsigned*)(QX + i * GL_QSTR + d) = qt; *(LAS unsigned*)(KX + i * GL_QSTR + d) = kt;
                *(unsigned*)(QTg + ((((size_t)((r0 + i) >> 5) * 4 + hh) * 8 + (lane >> 3)) * 64 + ((r0 + i) & 31) + 32 * ((lane >> 2) & 1)) * 8 + 2 * (lane & 3)) = qt; }
            __syncthreads();
            f32x4 acc[2]; acc[0] = (f32x4){0.f, 0.f, 0.f, 0.f}; acc[1] = acc[0];
#pragma unroll
            for (int ks = 0; ks < 4; ++ks) { const bf16x8v a = *(const LAS bf16x8v*)(QX + (16 * ti + fr) * GL_QSTR + 32 * ks + 8 * fq);
#pragma unroll
                for (int t = 0; t < 2; ++t) { const bf16x8v b = *(const LAS bf16x8v*)(KX + (16 * (2 * tjb + t) + fr) * GL_QSTR + 32 * ks + 8 * fq);
                    acc[t] = __builtin_amdgcn_mfma_f32_16x16x32_bf16(a, b, acc[t], 0, 0, 0); } }
#pragma unroll
            for (int t = 0; t < 2; ++t)
#pragma unroll
                for (int r = 0; r < 4; ++r) { const int i = 16 * ti + 4 * fq + r, j = 16 * (2 * tjb + t) + fr; const bool keep = dir ? (j >= i) : (j <= i); asum[t][r] += keep ? acc[t][r] : 0.f; }
        }
        __syncthreads();
#pragma unroll
        for (int t = 0; t < 2; ++t)
#pragma unroll
            for (int r = 0; r < 4; ++r) AC[(16 * ti + 4 * fq + r) * GL_TSTR + 16 * (2 * tjb + t) + fr] = (bf16)f2bf(asum[t][r]);
        { const int j = lane, v0 = wave * 32;
#pragma unroll
          for (int c4 = 0; c4 < 4; ++c4) { const v4u w = vw4[c4]; const unsigned ww[4] = {w.x, w.y, w.z, w.w};
#pragma unroll
              for (int c = 0; c < 8; ++c) VT[(v0 + 8 * c4 + c) * GL_TSTR + j] = (bf16)((c & 1) ? (ww[c >> 1] >> 16) : (ww[c >> 1] & 0xffffu)); } }
        __syncthreads();
        { const int r32 = lane & 31, hi = lane >> 5; bf16x8v vt[4];
#pragma unroll
          for (int ks = 0; ks < 4; ++ks) vt[ks] = *(const LAS bf16x8v*)(VT + (32 * wave + r32) * GL_TSTR + 16 * ks + 8 * hi);
#pragma unroll
          for (int t = 0; t < 2; ++t) { f32x16v o;
#pragma unroll
              for (int r = 0; r < 16; ++r) o[r] = 0.f;
#pragma unroll
              for (int ks = 0; ks < 4; ++ks) { const bf16x8v a = *(const LAS bf16x8v*)(AC + (32 * t + r32) * GL_TSTR + 16 * ks + 8 * hi); o = __builtin_amdgcn_mfma_f32_32x32x16_bf16(a, vt[ks], o, 0, 0, 0); }
              float* oi = WSP(F, float, WS_OI) + (size_t)(r0 + 32 * t) * 1024 + hh * 256 + 32 * wave + r32;
#pragma unroll
              for (int r = 0; r < 16; ++r) oi[(size_t)crow32(r, hi) * 1024] = o[r]; }
#pragma unroll 1
          for (int dir = 0; dir < 2; ++dir)
#pragma unroll
              for (int td = 0; td < 4; ++td) { f32x16v o;
#pragma unroll
                  for (int r = 0; r < 16; ++r) o[r] = 0.f;
#pragma unroll
                  for (int ks = 0; ks < 4; ++ks) { const bf16x8v b = *(const LAS bf16x8v*)(KET + (dir * 128 + 32 * td + r32) * GL_TSTR + 16 * ks + 8 * hi); o = __builtin_amdgcn_mfma_f32_32x32x16_bf16(b, vt[ks], o, 0, 0, 0); }
                  bf16* up = WSP(F, bf16, WS_UPD) + ((size_t)(dir * NCH + g) * 4 + hh) * 32768 + (size_t)((2 * wave + (r32 >> 4)) * 16 + 4 * td) * 128 + (r32 & 15) * 8 + 4 * hi;
#pragma unroll
                  for (int rq = 0; rq < 4; ++rq) *(v2u*)(up + rq * 128) = (v2u){pk2(o[4 * rq], o[4 * rq + 1]), pk2(o[4 * rq + 2], o[4 * rq + 3])}; } }
        __syncthreads();
    }
}

__device__ __forceinline__ void phase_attn(Frame& F, int l) {
    launder(F);
    const int tid = F.tid;
    for (int rp = 0; rp < RP(5); ++rp) {
        const int gt = F.vcu * NT + tid, NGT = F.G * NT;
        for (int e = gt; e < 2 * 4 * 256 * 64; e += NGT) {
            const int d2 = 8 * ((e >> 6) & 15) + 2 * (e & 3), v = 16 * ((e >> 10) & 15) + ((e >> 2) & 15), hh = (e >> 14) & 3, dir = e >> 16;
            f32x2 S = (f32x2){0.f, 0.f};
            const size_t frag = ((size_t)((v >> 5) * 8 + (d2 >> 4)) * 64 + (v & 31) + 32 * ((d2 >> 3) & 1)) * 8 + (d2 & 7);
#pragma unroll 12
            for (int s = 0; s < NCH; ++s) {
                const int g = dir == 0 ? s : (s < 4 ? 3 - s : NCH + 3 - s);
                const size_t hb = (size_t)(dir * NCH + g) * 4 + hh;
                *(unsigned*)(WSP(F, bf16, WS_SPREV) + hb * 32768 + frag) = pk2(S.x, S.y);
                const f32x2 dc = *(const f32x2*)(WSP(F, float, WS_DEC) + hb * 128 + d2); const unsigned uw = *(const unsigned*)(WSP(F, bf16, WS_UPD) + hb * 32768 + (size_t)((v >> 4) * 16 + (d2 >> 3)) * 128 + (v & 15) * 8 + (d2 & 7)); const f32x2 up = (f32x2){bflo(uw), bfhi(uw)};
                S = S * dc + up;
            }
        }
    }
    typedef attn_body::bf16 abf;
    const bf16* P = WSP(F, bf16, WS_P); bf16* MIX = WSP(F, bf16, WS_MIX);
    for (int rp = 0; rp < RP(12); ++rp) {
        for (int u = F.vcu; u < 256; u += F.G) {
            const int h = u >> 5, qb = u & 31; const size_t r0 = (size_t)LC + (size_t)qb * 256;
            attn_body::attn_unit<8, 0>((const abf*)(WSP(F, bf16, WS_QC) + r0 * 512 + h * 64), 512, (const abf*)(WSP(F, bf16, WS_KC) + (h >> 2) * 64), 128, (const abf*)(WSP(F, bf16, WS_VC) + (h >> 2) * 64), 128,
                                       (abf*)(MIX + r0 * D + 1536 + h * 64), D, NCH, F.ldsg, 0, (const LAS float*)F.lds);
        }
    }
    for (int rp = 0; rp < RP(13); ++rp) {
        for (int u = F.vcu; u < 256; u += F.G) {
            const int h = u >> 5, ir0 = (u & 31) * 4; const size_t r0 = (size_t)LC + (size_t)ir0 * 64;
            { LAS float* tab = (LAS float*)(F.lds + 98304); const float* rpb = IN_RPB(F) + ((size_t)l * 8 + h) * 465; for (int i = F.tid; i < 465; i += NT) tab[i] = rpb[i]; }
            const int band0 = min(max(ir0 - 4, 0), 120), nb = min(max(ir0 - 1, 0), 120) + 8 - band0, ntile = 4 + nb + (nb & 1);
            attn_body::attn_unit<8, 1>((const abf*)(P + r0 * INWP + C_NAQ + h * 64), INWP, (const abf*)(P + C_NAK + h * 64), INWP, (const abf*)(P + C_NAV + h * 64), INWP,
                                       (abf*)(MIX + r0 * D + h * 64), D, ntile, F.ldsg, ir0, (const LAS float*)(F.lds + 98304));
        }
    }
    if (l < DEPTH - 1) for (int rp = 0; rp < RP(14); ++rp) {
        for (int u = F.vcu; u < 16; u += F.G) {
            const int h = u & 7;
            if (u < 8) attn_body::attn_unit<8, 2>((const abf*)(P + C_NAQ + h * 64), INWP, (const abf*)(P + C_NAK + h * 64), INWP, (const abf*)(P + C_NAV + h * 64), INWP, (abf*)(MIX + h * 64), D, 4, F.ldsg, 0, (const LAS float*)F.lds);
            else attn_body::attn_unit<8, 0>((const abf*)(WSP(F, bf16, WS_QC) + h * 64), 512, (const abf*)(WSP(F, bf16, WS_KC) + (h >> 2) * 64), 128, (const abf*)(WSP(F, bf16, WS_VC) + (h >> 2) * 64), 128, (abf*)(MIX + 1536 + h * 64), D, 4, F.ldsg, 0, (const LAS float*)F.lds);
        }
    }
    __syncthreads();
}

__device__ __forceinline__ void phase_gla_out(Frame& F, int l) {
    launder(F);
    const int lane = F.lane, wave = F.wave, r32 = lane & 31, hi = lane >> 5;
    LAS float* PART = (LAS float*)F.lds;
    const int g_lo = (l < DEPTH - 1) ? 0 : 4;
    for (int u = F.vcu + g_lo * 4; u < NCH * 4; u += F.G) {
        const int g = u >> 2, hh = u & 3, r0 = g * 64, v = 32 * wave + r32;
        f32x16v o[2];
#pragma unroll
        for (int t = 0; t < 2; ++t) { const float* oi = WSP(F, float, WS_OI) + (size_t)(r0 + 32 * t) * 1024 + hh * 256 + v;
#pragma unroll
            for (int r = 0; r < 16; ++r) o[t][r] = oi[(size_t)crow32(r, hi) * 1024]; }
        bf16x8v b[2][8], a[2][8];
#pragma unroll
        for (int dir = 0; dir < 2; ++dir) { const bf16* sp = WSP(F, bf16, WS_SPREV) + ((size_t)(dir * NCH + g) * 4 + hh) * 32768 + (size_t)wave * 4096 + lane * 8;
#pragma unroll
            for (int ks = 0; ks < 8; ++ks) b[dir][ks] = *(const bf16x8v*)(sp + 512 * ks); }
#pragma unroll
        for (int dir = 0; dir < 2; ++dir) {
            const bf16* qt = WSP(F, bf16, dir ? WS_QTB : WS_QTF) + ((size_t)(r0 >> 5) * 4 + hh) * 4096 + lane * 8;
#pragma unroll
            for (int t = 0; t < 2; ++t)
#pragma unroll
                for (int ks = 0; ks < 8; ++ks) a[t][ks] = *(const bf16x8v*)(qt + (size_t)t * 16384 + 512 * ks);
#pragma unroll
            for (int t = 0; t < 2; ++t)
#pragma unroll
                for (int ks = 0; ks < 8; ++ks) o[t] = __builtin_amdgcn_mfma_f32_32x32x16_bf16(a[t][ks], b[dir][ks], o[t], 0, 0, 0);
        }
        bf16 gtw[2][16];
#pragma unroll
        for (int t = 0; t < 2; ++t)
#pragma unroll
            for (int r = 0; r < 16; ++r) gtw[t][r] = WSP(F, bf16, WS_P)[(size_t)(r0 + 32 * t + crow32(r, hi)) * INWP + C_GG + hh * 256 + v];
#pragma unroll
        for (int t = 0; t < 2; ++t)
#pragma unroll
            for (int r = 0; r < 16; ++r) { float sq = o[t][r] * o[t][r];
#pragma unroll
                for (int off = 1; off < 32; off <<= 1) sq += __shfl_xor(sq, off);
                if (r32 == 0) PART[(32 * t + crow32(r, hi)) * 8 + wave] = sq; }
        __syncthreads();
        const float nw = IN_GNW(F)[l * 256 + v];
#pragma unroll
        for (int t = 0; t < 2; ++t)
#pragma unroll
            for (int r = 0; r < 16; ++r) { const int row = 32 * t + crow32(r, hi); const f32x4 p0 = *(const LAS f32x4*)(PART + row * 8), p1 = *(const LAS f32x4*)(PART + row * 8 + 4);
                const float ss = (p0[0] + p0[1]) + (p0[2] + p0[3]) + (p1[0] + p1[1]) + (p1[2] + p1[3]);
                const float rstd = rsqrtf(ss * (1.f / 256.f) + LN_EPS); const float gt = bf1(gtw[t][r]);
                WSP(F, bf16, WS_MIX)[(size_t)(r0 + row) * D + 512 + hh * 256 + v] = (bf16)f2bf(o[t][r] * rstd * nw * silu_f(gt)); }
        __syncthreads();
    }
}

__device__ __forceinline__ void phase_ln1(Frame& F, int l) {
    launder(F);
    const int gw = F.vcu * NWAVES + F.wave, NGW = F.G * NWAVES, lane = F.lane;
    const int m_lo = (l < DEPTH - 1) ? 0 : LC;
    v4u nz[4];
    { const int m = (m_lo + gw < MT) ? m_lo + gw : MT - 1; row_fetch_bf16(WSP(F, bf16, WS_Z) + (size_t)m * D, lane, nz); }
    for (int m = m_lo + gw; m < MT; m += NGW) {
        const float* mod = WSP(F, float, WS_MOD) + (size_t)l * 2 * 12288 + (m < LC ? 12288 : 0);
        float v[32]; row_expand_bf16(nz, v);
        { const int mn = (m + NGW < MT) ? m + NGW : m; row_fetch_bf16(WSP(F, bf16, WS_Z) + (size_t)mn * D, lane, nz); }
        row_norm(v); row_affine(v, IN_LN1G(F) + l * D, IN_LN1B(F) + l * D, lane, 0.f);
        row_store_bf16(WSP(F, bf16, WS_X) + (size_t)m * D, lane, v);
        row_norm(v); row_affine(v, mod + 4 * D, mod + 3 * D, lane, 1.f);
        row_store_bf16(WSP(F, bf16, WS_H) + (size_t)m * D, lane, v);
    }
}

__device__ __forceinline__ void tk_merge16(float (&a)[16]) {
#pragma unroll
    for (int j = 8; j > 0; j >>= 1)
#pragma unroll
        for (int i = 0; i < 16; ++i) { const int p = i ^ j; if (p > i) { const float hi = fmaxf(a[i], a[p]), lo = fminf(a[i], a[p]); a[i] = hi; a[p] = lo; } }
}
__device__ __forceinline__ void tk_sort16(float (&a)[16]) {
#pragma unroll
    for (int k = 2; k <= 16; k <<= 1)
#pragma unroll
        for (int j = k >> 1; j > 0; j >>= 1)
#pragma unroll
            for (int i = 0; i < 16; ++i) { const int p = i ^ j; if (p > i) { const float hi = fmaxf(a[i], a[p]), lo = fminf(a[i], a[p]); const bool dsc = ((i & k) == 0); a[i] = dsc ? hi : lo; a[p] = dsc ? lo : hi; } }
}
__device__ __forceinline__ void tk_top16of128(const float* sp, float (&run)[16]) {
    float nx[16];
#pragma unroll
    for (int i = 0; i < 16; ++i) nx[i] = sp[(size_t)i * MT];
#pragma unroll 1
    for (int c = 0; c < 8; ++c) {
        float ch[16];
#pragma unroll
        for (int i = 0; i < 16; ++i) ch[i] = __builtin_bit_cast(float, (__builtin_bit_cast(unsigned, nx[i]) & ~127u) | (unsigned)(c * 16 + i));
        if (c < 7) {
#pragma unroll
            for (int i = 0; i < 16; ++i) nx[i] = sp[(size_t)((c + 1) * 16 + i) * MT]; }
        tk_sort16(ch);
        if (c == 0) {
#pragma unroll
            for (int i = 0; i < 16; ++i) run[i] = ch[i];
        } else {
#pragma unroll
            for (int i = 0; i < 16; ++i) run[i] = fmaxf(run[i], ch[15 - i]);
            tk_merge16(run);
        }
    }
}
__device__ __forceinline__ void phase_topk(Frame& F, int l) {
    launder(F);
    const int lane = F.lane, h = F.wave, tid = F.tid;
    LAS float* TS = (LAS float*)F.lds;
    const int u_lo = (l < DEPTH - 1) ? 0 : 4;
    for (int u = F.vcu + u_lo; u < NCH; u += F.G) {
        const int tok = u * 64 + lane;
        float t1[16], t2[16];
        tk_top16of128(WSP(F, float, WS_ST) + (size_t)((h * 2 + 0) * 128) * MT + tok, t1);
        tk_top16of128(WSP(F, float, WS_ST) + (size_t)((h * 2 + 1) * 128) * MT + tok, t2);
#pragma unroll
        for (int i = 0; i < 16; ++i) { TS[i * NT + tid] = t1[i]; TS[(16 + i) * NT + tid] = t2[i]; }
        float tv[16];
#define TK_CAND(i_, j_) __builtin_bit_cast(float, (__builtin_bit_cast(unsigned, t1[i_] + t2[j_]) & ~255u) | (unsigned)((i_) * 16 + (j_)))
#pragma unroll
        for (int j = 0; j < 16; ++j) tv[j] = TK_CAND(0, j);
#pragma unroll
        for (int i = 1; i < 16; ++i) {
            const int len = 16 / (i + 1);
            if (len >= 3) {
#pragma unroll
                for (int k = 0; k < 16; ++k) if (15 - k < len) tv[k] = fmaxf(tv[k], TK_CAND(i, 15 - k));
                tk_merge16(tv);
            } else {
#pragma unroll
                for (int j = 0; j < len; ++j) { float v = TK_CAND(i, j);
#pragma unroll
                    for (int s2 = 0; s2 < 16; ++s2) { const float hi = fmaxf(tv[s2], v); v = fminf(tv[s2], v); tv[s2] = hi; } }
            }
        }
#undef TK_CAND
        LDS_WAIT();
        float sv[16]; int ti[16];
#pragma unroll
        for (int s2 = 0; s2 < 16; ++s2) { const unsigned code = __builtin_bit_cast(unsigned, tv[s2]) & 255u; const float a = TS[(code >> 4) * NT + tid], b = TS[(16 + (code & 15u)) * NT + tid];
            sv[s2] = a + b; ti[s2] = (int)((__builtin_bit_cast(unsigned, a) & 127u) * 128u + (__builtin_bit_cast(unsigned, b) & 127u)); }
        float mx = sv[0];
#pragma unroll
        for (int s2 = 1; s2 < 16; ++s2) mx = fmaxf(mx, sv[s2]);
        float e[16], sum = 0.f;
#pragma unroll
        for (int s2 = 0; s2 < 16; ++s2) { e[s2] = __expf(sv[s2] - mx); sum += e[s2]; }
        const float inv = 1.f / sum;
        int* ip = WSP(F, int, WS_IDX) + (size_t)tok * 128 + h * 16; float* gp = WSP(F, float, WS_GATE) + (size_t)tok * 128 + h * 16;
#pragma unroll
        for (int s4 = 0; s4 < 4; ++s4) { *(v4u*)(ip + 4 * s4) = (v4u){(unsigned)ti[4 * s4], (unsigned)ti[4 * s4 + 1], (unsigned)ti[4 * s4 + 2], (unsigned)ti[4 * s4 + 3]};
            *(f32x4*)(gp + 4 * s4) = (f32x4){e[4 * s4] * inv, e[4 * s4 + 1] * inv, e[4 * s4 + 2] * inv, e[4 * s4 + 3] * inv}; }
        LDS_WAIT();
    }
}

template <int CTRL> __device__ __forceinline__ float dpp_f(float v) { return __builtin_bit_cast(float, __builtin_amdgcn_update_dpp(0, __builtin_bit_cast(int, v), CTRL, 0xF, 0xF, true)); }
__device__ __forceinline__ void phase_peer(Frame& F, int l) {
    launder(F);
    const int lane = F.lane, r8 = lane >> 3, l8 = lane & 7;
    const int gsz = F.G >> 3, grp = F.vcu / gsz, gwv = (F.vcu % gsz) * NWAVES + F.wave, gnw = gsz * NWAVES;
    const unsigned char* U = WSP(F, unsigned char, WS_PU) + (size_t)l * NEXP * D;
    const int* IDX = WSP(F, int, WS_IDX); const bf16* H = WSP(F, bf16, WS_H);
    LAS int* ET = (LAS int*)(F.lds + F.wave * 1024);
    const int m_lo = (l < DEPTH - 1) ? 0 : LC;
    const int wpos = ((lane & 7) * 16 + (lane >> 3));
#pragma unroll 1
    for (int sub = 0; sub < 2; ++sub) {
        const int s = 8 * sub + grp;
        const unsigned coff = 128u * (unsigned)s + 16u * (unsigned)l8;
        const int o0 = 8 * (8 * (s & 7) + l8) + 1024 * (s >> 3);
        unsigned* part = WSP(F, unsigned, WS_PART) + (size_t)s * MT * 64;
        int m = m_lo + gwv;
        int eL = IDX[(size_t)m * 128 + lane], eH = IDX[(size_t)m * 128 + 64 + lane];
#pragma unroll 1
        for (; m < MT; m += gnw) {
            ET[wpos] = eL; ET[wpos + 8] = eH;
            const v4u hw0 = *(const v4u*)(H + (size_t)m * D + o0), hw1 = *(const v4u*)(H + (size_t)m * D + o0 + 512);
            LDS_WAIT();
            int e16[16];
#pragma unroll
            for (int q = 0; q < 16; ++q) e16[q] = ET[r8 * 16 + q];
            v4u r[16];
#pragma unroll
            for (int j = 0; j < 16; ++j) r[j] = *(const v4u*)(U + ((unsigned)e16[j] * 2048u + coff));
            { const int mn = (m + gnw < MT) ? m + gnw : m; eL = IDX[(size_t)mn * 128 + lane]; eH = IDX[(size_t)mn * 128 + 64 + lane]; }
            f32x2 h[8];
            h[0] = (f32x2){bflo(hw0.x), bfhi(hw0.x)}; h[1] = (f32x2){bflo(hw0.y), bfhi(hw0.y)}; h[2] = (f32x2){bflo(hw0.z), bfhi(hw0.z)}; h[3] = (f32x2){bflo(hw0.w), bfhi(hw0.w)};
            h[4] = (f32x2){bflo(hw1.x), bfhi(hw1.x)}; h[5] = (f32x2){bflo(hw1.y), bfhi(hw1.y)}; h[6] = (f32x2){bflo(hw1.z), bfhi(hw1.z)}; h[7] = (f32x2){bflo(hw1.w), bfhi(hw1.w)};
            float d[16];
#pragma unroll
            for (int j = 0; j < 16; ++j) { f32x2 p = (f32x2){0.f, 0.f};
#pragma unroll
                for (int w = 0; w < 4; ++w) { const f32x2 lo = __builtin_amdgcn_cvt_pk_f32_fp8((int)r[j][w], false), hi = __builtin_amdgcn_cvt_pk_f32_fp8((int)r[j][w], true); p += lo * h[2 * w]; p += hi * h[2 * w + 1]; }
                d[j] = p.x + p.y; }
            const bool c2 = (l8 & 4) != 0, c1 = (l8 & 2) != 0, c0 = (l8 & 1) != 0;
            float e1[8], e2[4];
#pragma unroll
            for (int jj = 0; jj < 8; ++jj) { const int ja = (jj & 3) | ((jj >> 2) << 3); const float kp = c2 ? d[ja | 4] : d[ja], sd = c2 ? d[ja] : d[ja | 4]; e1[jj] = kp + dpp_f<0x141>(sd); }
#pragma unroll
            for (int y = 0; y < 4; ++y) { const int x = (y & 1) | ((y >> 1) << 2); const float kp = c1 ? e1[x | 2] : e1[x], sd = c1 ? e1[x] : e1[x | 2]; e2[y] = kp + dpp_f<0x4E>(sd); }
            const float v0 = (c0 ? e2[1] : e2[0]) + dpp_f<0xB1>(c0 ? e2[0] : e2[1]), v1 = (c0 ? e2[3] : e2[2]) + dpp_f<0xB1>(c0 ? e2[2] : e2[3]);
            part[(size_t)m * 64 + 8 * l8 + r8] = pk2(v0, v1);
            LDS_WAIT();
        }
    }
}

__device__ __forceinline__ void phase_peer_act(Frame& F, int l) {
    launder(F);
    const int gw = F.vcu * NWAVES + F.wave, NGW = F.G * NWAVES, lane = F.lane;
    const f32x2* SUV = WSP(F, f32x2, WS_SCU) + l * NEXP;
    const int m_lo = (l < DEPTH - 1) ? 0 : LC;
    for (int m0 = m_lo + gw; m0 < MT; m0 += 2 * NGW) {
        const int m1 = m0 + NGW; const bool two = m1 < MT; const int mm[2] = {m0, two ? m1 : m0};
        float dsum[2][2]; int e[2][2]; float gt[2][2];
#pragma unroll
        for (int t = 0; t < 2; ++t)
#pragma unroll
            for (int hlf = 0; hlf < 2; ++hlf) { const int k = 64 * hlf + lane; e[t][hlf] = WSP(F, int, WS_IDX)[(size_t)mm[t] * 128 + k]; gt[t][hlf] = WSP(F, float, WS_GATE)[(size_t)mm[t] * 128 + k]; }
#pragma unroll
        for (int t = 0; t < 2; ++t) { float d0 = 0.f, d1 = 0.f;
#pragma unroll
            for (int s = 0; s < 16; ++s) { const unsigned w = WSP(F, unsigned, WS_PART)[((size_t)s * MT + mm[t]) * 64 + lane]; d0 += bflo(w); d1 += bfhi(w); }
            dsum[t][0] = d0; dsum[t][1] = d1; }
#pragma unroll
        for (int t = 0; t < 2; ++t)
#pragma unroll
            for (int hlf = 0; hlf < 2; ++hlf) { const int k = 64 * hlf + lane;
                const f32x2 sc = SUV[e[t][hlf]];
                const float a = gelu_tanh(dsum[t][hlf] * sc.x) * gt[t][hlf] * sc.y;
                if (t == 0 || two) WSP(F, float, WS_ACT)[(size_t)mm[t] * 128 + k] = a; }
    }
}

__device__ __forceinline__ void phase_peer_v(Frame& F, int l) {
    launder(F);
    const int lane = F.lane, r8 = lane >> 3, l8 = lane & 7;
    const int gsz = F.G >> 3, grp = F.vcu / gsz, gwv = (F.vcu % gsz) * NWAVES + F.wave, gnw = gsz * NWAVES;
    const unsigned char* V = WSP(F, unsigned char, WS_PV) + (size_t)l * NEXP * D;
    const int* IDX = WSP(F, int, WS_IDX); const float* ACT = WSP(F, float, WS_ACT);
    LAS int* ET = (LAS int*)(F.lds + F.wave * 1024); LAS float* AT = (LAS float*)(F.lds + F.wave * 1024 + 512);
    const int m_lo = (l < DEPTH - 1) ? 0 : LC;
    const int wpos = ((lane & 7) * 16 + (lane >> 3));
    const bool b5 = (lane & 32) != 0, b4 = (lane & 16) != 0, b3 = (lane & 8) != 0;
#pragma unroll 1
    for (int sub = 0; sub < 2; ++sub) {
        const int s = 8 * sub + grp;
        const unsigned coff = 128u * (unsigned)s + 16u * (unsigned)l8;
        const int o0 = 8 * (8 * (s & 7) + l8) + 1024 * (s >> 3);
        int m = m_lo + gwv;
        int eL = IDX[(size_t)m * 128 + lane], eH = IDX[(size_t)m * 128 + 64 + lane]; float aL = ACT[(size_t)m * 128 + lane], aH = ACT[(size_t)m * 128 + 64 + lane];
#pragma unroll 1
        for (; m < MT; m += gnw) {
            ET[wpos] = eL; ET[wpos + 8] = eH; AT[wpos] = aL; AT[wpos + 8] = aH;
            LDS_WAIT();
            int e16[16]; float a[16];
#pragma unroll
            for (int q = 0; q < 16; ++q) { e16[q] = ET[r8 * 16 + q]; a[q] = AT[r8 * 16 + q]; }
            v4u r[16];
#pragma unroll
            for (int j = 0; j < 16; ++j) r[j] = *(const v4u*)(V + ((unsigned)e16[j] * 2048u + coff));
            { const int mn = (m + gnw < MT) ? m + gnw : m; eL = IDX[(size_t)mn * 128 + lane]; eH = IDX[(size_t)mn * 128 + 64 + lane]; aL = ACT[(size_t)mn * 128 + lane]; aH = ACT[(size_t)mn * 128 + 64 + lane]; }
            f32x2 acc[8];
#pragma unroll
            for (int i = 0; i < 8; ++i) acc[i] = (f32x2){0.f, 0.f};
#pragma unroll
            for (int j = 0; j < 16; ++j)
#pragma unroll
                for (int w = 0; w < 4; ++w) { const f32x2 lo = __builtin_amdgcn_cvt_pk_f32_fp8((int)r[j][w], false), hi = __builtin_amdgcn_cvt_pk_f32_fp8((int)r[j][w], true);
                    acc[2 * w] += lo * a[j]; acc[2 * w + 1] += hi * a[j]; }
            f32x2 g1[4], g2[2];
#pragma unroll
            for (int i = 0; i < 4; ++i) { const f32x2 kp = b5 ? acc[i + 4] : acc[i], sd = b5 ? acc[i] : acc[i + 4]; g1[i] = (f32x2){kp.x + __shfl_xor(sd.x, 32), kp.y + __shfl_xor(sd.y, 32)}; }
#pragma unroll
            for (int i = 0; i < 2; ++i) { const f32x2 kp = b4 ? g1[i + 2] : g1[i], sd = b4 ? g1[i] : g1[i + 2]; g2[i] = (f32x2){kp.x + __shfl_xor(sd.x, 16), kp.y + __shfl_xor(sd.y, 16)}; }
            { const f32x2 kp = b3 ? g2[1] : g2[0], sd = b3 ? g2[0] : g2[1]; const f32x2 res = (f32x2){kp.x + dpp_f<0x128>(sd.x), kp.y + dpp_f<0x128>(sd.y)};
              *(unsigned*)(WSP(F, bf16, WS_Z) + (size_t)m * D + o0 + (r8 < 4 ? 2 * r8 : 512 + 2 * (r8 - 4))) = pk2(res.x, res.y); }
            LDS_WAIT();
        }
    }
}

__device__ __forceinline__ void phase_peer_tail(Frame& F, int l) {
    launder(F);
    const int gw = F.vcu * NWAVES + F.wave, NGW = F.G * NWAVES, lane = F.lane;
    const int m_lo = (l < DEPTH - 1) ? 0 : LC;
    v4u nx[4], no[4];
    { const int m = (m_lo + gw < MT) ? m_lo + gw : MT - 1; row_fetch_bf16(WSP(F, bf16, WS_X) + (size_t)m * D, lane, nx); row_fetch_bf16(WSP(F, bf16, WS_Z) + (size_t)m * D, lane, no); }
    for (int m = m_lo + gw; m < MT; m += NGW) {
        const float* mod = WSP(F, float, WS_MOD) + (size_t)l * 2 * 12288 + (m < LC ? 12288 : 0);
        float x[32], o[32]; row_expand_bf16(nx, x); row_expand_bf16(no, o);
        { const int mn = (m + NGW < MT) ? m + NGW : m; row_fetch_bf16(WSP(F, bf16, WS_X) + (size_t)mn * D, lane, nx); row_fetch_bf16(WSP(F, bf16, WS_Z) + (size_t)mn * D, lane, no); }
#pragma unroll
        for (int j = 0; j < 4; ++j)
#pragma unroll
            for (int hf = 0; hf < 2; ++hf) { const f32x4 gv = *(const f32x4*)(mod + 5 * D + 8 * lane + 512 * j + 4 * hf);
#pragma unroll
                for (int c = 0; c < 4; ++c) x[8 * j + 4 * hf + c] = ALPHA * x[8 * j + 4 * hf + c] + gv[c] * o[8 * j + 4 * hf + c]; }
        row_norm(x); row_affine(x, IN_LN2G(F) + l * D, IN_LN2B(F) + l * D, lane, 0.f);
        if (l < DEPTH - 1) {
            row_store_bf16(WSP(F, bf16, WS_X) + (size_t)m * D, lane, x);
            const float* modn = WSP(F, float, WS_MOD) + (size_t)(l + 1) * 2 * 12288 + (m < LC ? 12288 : 0);
            row_norm(x); row_affine(x, modn + D, modn, lane, 1.f);
            row_store_bf16(WSP(F, bf16, WS_H) + (size_t)m * D, lane, x);
        } else {
            row_store_f32(F.ap->out + (size_t)(m - LC) * D, lane, x);
        }
    }
}

template <int MODE> __device__ __forceinline__ void ctx_gemm(Frame& F, const bf16* A, const bf16* Bt, const bf16* X, bf16* Z, const float* g, float* ST) {
    launder(F);
    const int lane = F.lane, fr = lane & 15, fq = lane >> 4, w = F.wave;
    LAS f32x4* red = (LAS f32x4*)F.lds;
#pragma unroll 1
    for (int wt = F.vcu; wt < 256; wt += F.G) {
        const int rg = wt & 7, cg = wt >> 3;
        const bf16* ap = A + (size_t)(32 * rg + fr) * D + 8 * fq + 256 * w; const bf16* bp = Bt + (size_t)(64 * cg + fr) * D + 8 * fq + 256 * w;
        f32x4 acc[2][4];
#pragma unroll
        for (int m = 0; m < 2; ++m)
#pragma unroll
            for (int n = 0; n < 4; ++n) acc[m][n] = (f32x4){0.f, 0.f, 0.f, 0.f};
#pragma unroll 1
        for (int kb = 0; kb < 8; kb += 4) {
            bf16x8v a[4][2], b[4][4];
#pragma unroll
            for (int i = 0; i < 4; ++i) {
#pragma unroll
                for (int m = 0; m < 2; ++m) a[i][m] = *(const bf16x8v*)(ap + (size_t)(16 * m) * D + 32 * (kb + i));
#pragma unroll
                for (int n = 0; n < 4; ++n) b[i][n] = *(const bf16x8v*)(bp + (size_t)(16 * n) * D + 32 * (kb + i)); }
            __builtin_amdgcn_sched_barrier(0);
#pragma unroll
            for (int i = 0; i < 4; ++i)
#pragma unroll
                for (int m = 0; m < 2; ++m)
#pragma unroll
                    for (int n = 0; n < 4; ++n) acc[m][n] = __builtin_amdgcn_mfma_f32_16x16x32_bf16(a[i][m], b[i][n], acc[m][n], 0, 0, 0);
        }
        asm volatile("s_waitcnt vmcnt(0)" ::: "memory");
        __syncthreads();
#pragma unroll
        for (int m = 0; m < 2; ++m)
#pragma unroll
            for (int n = 0; n < 4; ++n) red[(w * 8 + m * 4 + n) * 64 + lane] = acc[m][n];
        __syncthreads();
        f32x4 sum = red[w * 64 + lane];
#pragma unroll
        for (int ww = 1; ww < 8; ++ww) sum += red[(ww * 8 + w) * 64 + lane];
        { const int m = w >> 2, n = w & 3; const int col = 64 * cg + 16 * n + fr, row0 = 32 * rg + 16 * m + 4 * fq;
          if (MODE == 0) { const float gv = g[col];
#pragma unroll
              for (int r = 0; r < 4; ++r) Z[(size_t)(row0 + r) * D + col] = (bf16)f2bf(ALPHA * bflo((unsigned)X[(size_t)(row0 + r) * D + col]) + gv * sum[r]); }
          else *(f32x4*)(ST + (size_t)col * MT + row0) = sum; }
        __syncthreads();
    }
}

#ifndef MK_MULTI
#define MK_MULTI 0
#endif
constexpr int NPL = 12, NPHASE = 2 + DEPTH * NPL;
__global__ void __launch_bounds__(NT, 2) trunk_fwd(Args args) {
    extern __shared__ __attribute__((aligned(16))) unsigned char lds[];
    Frame F;
    F.lds = (LAS unsigned char*)lds; F.ldsg = (char*)lds;
    F.tid = threadIdx.x; F.lane = F.tid & 63; F.wave = __builtin_amdgcn_readfirstlane(F.tid >> 6);
    F.G = gridDim.x; { const int bx = blockIdx.x; F.vcu = (F.G % 8 == 0) ? (bx % 8) * (F.G / 8) + bx / 8 : bx; }
    F.ap = (const __attribute__((address_space(4))) Args*)__builtin_amdgcn_kernarg_segment_ptr();
    volatile LAS unsigned* MISC = (volatile LAS unsigned*)(F.lds + MISC_OFF);
    for (int u = F.tid; u < (LDS_BYTES - LDSCTL_OFF) / 4; u += NT) ((LAS unsigned*)(F.lds + LDSCTL_OFF))[u] = 0u;
    __syncthreads();
    XcdBarrier bar; bar.bar = WSP(F, unsigned, WS_CTL) + CW_BAR; bar.x = 0; bar.st = nullptr;
    if (!MK_MULTI) bar = xcd_barrier_post(WSP(F, unsigned, WS_CTL) + CW_BAR, MISC + 8);
    const int lo = args.ph_lo, hi = args.ph_hi;
#ifndef PH_MASK
#define PH_MASK 0xFFFFFF
#endif
#define IN(k) (lo <= (k) && (k) < hi)
#define PM(b) ((PH_MASK >> (b)) & 1)
#define SEAM(k) do { if (!MK_MULTI && IN(k) && IN((k) + 1)) xcd_barrier(bar); } while (0)

    if (PM(0) && IN(0)) { for (int rp = 0; rp < RP(0); ++rp) phase_prologue_a(F); } SEAM(0);
    if (PM(1) && IN(1)) { for (int rp = 0; rp < RP(1); ++rp) phase_ln0(F); } SEAM(1);
#pragma unroll 1
    for (int l = 0; l < DEPTH; ++l) {
        const int pb = 2 + l * NPL;
        const bool ctxu = l < DEPTH - 1;
        if (PM(2) && IN(pb + 0)) for (int rp = 0; rp < RP(2); ++rp) {
            pg8::Gemm g{WSP(F, bf16, WS_H), WSP(F, bf16, WS_WIN) + (size_t)l * INWP * D, MT, INWP, D}; pg8::StaticOrder S; S.init(MT, INWP, F.G, (int)blockIdx.x);
            pg8::EpiBf16P E{WSP(F, bf16, WS_P), INWP};
            pg8::gemm_phase<pg8::EpiBf16P, pg8::StaticOrder, true, true>(F.lds, g, S, E);
        }
        SEAM(pb + 0);
        if (IN(pb + 1)) { if (PM(3)) for (int rp = 0; rp < RP(3); ++rp) phase_qknorm(F, l); if (PM(4)) for (int rp = 0; rp < RP(4); ++rp) phase_gla_chunk(F, l); }
        SEAM(pb + 1);
        if (PM(5) && IN(pb + 2)) { phase_attn(F, l); }
        SEAM(pb + 2);
        if (PM(6) && IN(pb + 3)) { for (int rp = 0; rp < RP(6); ++rp) phase_gla_out(F, l); }
        SEAM(pb + 3);
        if (PM(7) && IN(pb + 4)) for (int rp = 0; rp < RP(7); ++rp) {
            const float* modl = WSP(F, float, WS_MOD) + (size_t)l * 2 * 12288;
            pg8::Gemm g{WSP(F, bf16, WS_MIX) + (size_t)LC * D, WSP(F, bf16, WS_WOUT) + (size_t)l * D * D, T, D, D}; pg8::StaticOrder S; S.init(T, D, F.G, (int)blockIdx.x);
            pg8::EpiResid E{WSP(F, bf16, WS_X) + (size_t)LC * D, WSP(F, bf16, WS_Z) + (size_t)LC * D, modl + 2 * D, ALPHA};
            pg8::gemm_phase<pg8::EpiResid, pg8::StaticOrder, true, true>(F.lds, g, S, E);
            if (ctxu) ctx_gemm<0>(F, WSP(F, bf16, WS_MIX), WSP(F, bf16, WS_WOUT) + (size_t)l * D * D, WSP(F, bf16, WS_X), WSP(F, bf16, WS_Z), modl + 12288 + 2 * D, nullptr);
        }
        SEAM(pb + 4);
        if (PM(8) && IN(pb + 5)) { for (int rp = 0; rp < RP(8); ++rp) phase_ln1(F, l); }
        SEAM(pb + 5);
        if (PM(9) && IN(pb + 6)) for (int rp = 0; rp < RP(9); ++rp) {
            pg8::Gemm g{WSP(F, bf16, WS_WP) + (size_t)l * D * D, WSP(F, bf16, WS_H) + (size_t)LC * D, D, T, D}; pg8::StaticOrder S; S.init(D, T, F.G, (int)blockIdx.x);
            pg8::EpiStoreF32 E{WSP(F, float, WS_ST) + LC, MT};
            pg8::gemm_phase<pg8::EpiStoreF32, pg8::StaticOrder, true, true>(F.lds, g, S, E);
            if (ctxu) ctx_gemm<1>(F, WSP(F, bf16, WS_H), WSP(F, bf16, WS_WP) + (size_t)l * D * D, nullptr, nullptr, nullptr, WSP(F, float, WS_ST));
        }
        SEAM(pb + 6);
        if (PM(10) && IN(pb + 7)) { for (int rp = 0; rp < RP(10); ++rp) phase_topk(F, l); }
        SEAM(pb + 7);
        if (PM(11) && IN(pb + 8)) { for (int rp = 0; rp < RP(11); ++rp) phase_peer(F, l); }
        SEAM(pb + 8);
        if (PM(22) && IN(pb + 9)) { for (int rp = 0; rp < RP(22); ++rp) phase_peer_act(F, l); }
        SEAM(pb + 9);
        if (PM(20) && IN(pb + 10)) { for (int rp = 0; rp < RP(20); ++rp) phase_peer_v(F, l); }
        SEAM(pb + 10);
        if (PM(21) && IN(pb + 11)) { phase_peer_tail(F, l); }
        SEAM(pb + 11);
    }
#undef IN
#undef SEAM
}

extern "C" void kernel_launch(void* const* d_in, const int* in_sizes, int n_in, void* d_out, int out_size, void* d_ws, size_t ws_size, hipStream_t stream) {
    static int grid = 0;
    if (grid == 0) {
        if (n_in != 22 || out_size != T * D || ws_size < WS_END) { fprintf(stderr, "kernel_launch: unexpected shapes (n_in %d, out %d, ws %zu); nothing launched\n", n_in, out_size, ws_size); grid = -1; return; }
        int dev = 0, cus = 0, per_cu = 0;
        if (hipGetDevice(&dev) != hipSuccess || hipDeviceGetAttribute(&cus, hipDeviceAttributeMultiprocessorCount, dev) != hipSuccess) { grid = -1; return; }
        if (hipFuncSetAttribute((const void*)trunk_fwd, hipFuncAttributeMaxDynamicSharedMemorySize, LDS_BYTES) != hipSuccess) { fprintf(stderr, "kernel_launch: hipFuncSetAttribute failed\n"); grid = -1; return; }
        if (hipOccupancyMaxActiveBlocksPerMultiprocessor(&per_cu, (const void*)trunk_fwd, NT, LDS_BYTES) != hipSuccess || per_cu < 1)
            fprintf(stderr, "kernel_launch: note: occupancy query reports %d workgroups per CU\n", per_cu);
        (void)hipGetLastError();
        grid = cus;
    }
    if (grid < 0) return;
    if (hipMemsetAsync((char*)d_ws + WS_CTL, 0, CTL_ZERO_BYTES, stream) != hipSuccess) return;
    Args a{};
    for (int i = 0; i < 22; ++i) a.in[i] = (const float*)d_in[i];
    a.out = (float*)d_out; a.ws = (unsigned char*)d_ws;
#if MK_MULTI
    for (int p = 0; p < NPHASE; ++p) { a.ph_lo = p; a.ph_hi = p + 1; hipLaunchKernelGGL(trunk_fwd, dim3(grid), dim3(NT), LDS_BYTES, stream, a); }
#else
    a.ph_lo = 0; a.ph_hi = NPHASE; hipLaunchKernelGGL(trunk_fwd, dim3(grid), dim3(NT), LDS_BYTES, stream, a);
#endif
}
```

```cpp
#include <hip/hip_runtime.h>
#include <cstdio>
#include <cstdint>
#include <hip/hip_bf16.h>
#define MK_MULTI 0
namespace pg8 {
#define PG8_LAS __attribute__((address_space(3)))
typedef unsigned short bf16_t;
typedef short bf16x8 __attribute__((ext_vector_type(8)));
typedef float f32x4 __attribute__((ext_vector_type(4)));
typedef unsigned u32x4 __attribute__((ext_vector_type(4)));
constexpr int BM = 256, BK = 64, HALF = 128, HTB = HALF * BK * 2  , STAGE_BYTES = 8 * HTB, NXCD = 8, WGM = 8;

__host__ __device__ __forceinline__ int lds_byte(int r, int c) { const int st = (r >> 4) * 2 + (c >> 5), rr = r & 15, cc = c & 31, ob = rr * 64 + cc * 2; return st * 1024 + (ob ^ (((ob >> 9) & 1) << 5)); }
__host__ __device__ __forceinline__ void stage_rc(int b, int& R, int& C) { const int st = b / 1024, sb = b % 1024, swz = sb ^ (((sb >> 9) & 1) << 5); R = (st >> 1) * 16 + swz / 64; C = (st & 1) * 32 + (swz % 64) / 2; }
__host__ __device__ __forceinline__ int perm32(int rho) { const int n = rho >> 4, i = rho & 15; return 8 * (i >> 2) + 4 * n + (i & 3); }

struct Unit { int pm, pn; };
struct Gemm { const bf16_t* A; const bf16_t* Bt; int M, N, K; };

struct StaticOrder {
    int nM, nN, nwg, G, c;
    __host__ __device__ void init(int M, int N, int G_, int c_) { nM = M / BM; nN = N / BM; nwg = nM * nN; G = G_; c = c_; }
    __host__ __device__ bool next(int i, Unit& u) const {
        const long L = (long)i * G + c; if (L >= nwg) return false;
        int wgid = (int)L; { const int q = nwg / NXCD, r = nwg % NXCD, xcd = wgid % NXCD, off = wgid / NXCD; wgid = (xcd < r ? xcd * (q + 1) : r * (q + 1) + (xcd - r) * q) + off; }
        const int nig = WGM * nN, gid = wgid / nig, fm = gid * WGM, gsz = (nM - fm) < WGM ? (nM - fm) : WGM;
        u.pm = fm + ((wgid % nig) % gsz); u.pn = (wgid % nig) / gsz; return true;
    }
    __device__ __forceinline__ void a_ready(const Unit&) const {}
    __device__ __forceinline__ void done(const Unit&) const {}
};
__device__ __forceinline__ unsigned cvt_pk_bf16(float lo, float hi) { unsigned r; asm volatile("v_cvt_pk_bf16_f32 %0, %1, %2" : "=v"(r) : "v"(lo), "v"(hi)); return r; }
typedef float f32x2 __attribute__((ext_vector_type(2)));

struct EpiBf16P {
    static constexpr bool PERM = true, AFTER_DRAIN = false;
    bf16_t* O; int ldc;
    __device__ __forceinline__ void operator()(const f32x4 (&acc)[2][2][4][2], const Unit& u, int wr, int wc, int fr, int fq) const {
        const int row0 = u.pm * BM + wr * 64 + fr, col0 = u.pn * BM + wc * 32 + 8 * fq;
#pragma unroll
        for (int ai = 0; ai < 2; ++ai)
#pragma unroll
            for (int m = 0; m < 4; ++m) { bf16_t* rowp = O + (size_t)(row0 + ai * HALF + m * 16) * ldc + col0;
#pragma unroll
                for (int bj = 0; bj < 2; ++bj) { const f32x4 v0 = acc[ai][bj][m][0], v1 = acc[ai][bj][m][1];
                    u32x4 w; w.x = cvt_pk_bf16(v0[0], v0[1]); w.y = cvt_pk_bf16(v0[2], v0[3]); w.z = cvt_pk_bf16(v1[0], v1[1]); w.w = cvt_pk_bf16(v1[2], v1[3]);
                    *(u32x4*)(rowp + bj * HALF) = w; } }
    }
};
struct EpiResid {
    static constexpr bool PERM = true, AFTER_DRAIN = false;
    const bf16_t* X; bf16_t* Z; const float* g; float alpha;
    __device__ __forceinline__ void operator()(const f32x4 (&acc)[2][2][4][2], const Unit& u, int wr, int wc, int fr, int fq) const {
        const int row0 = u.pm * BM + wr * 64 + fr, col0 = u.pn * BM + wc * 32 + 8 * fq;
        f32x4 gv[2][2];
#pragma unroll
        for (int bj = 0; bj < 2; ++bj)
#pragma unroll
            for (int n = 0; n < 2; ++n) gv[bj][n] = *(const f32x4*)(g + col0 + bj * HALF + 4 * n);
#pragma unroll
        for (int ai = 0; ai < 2; ++ai) {
            u32x4 xv[4][2];
#pragma unroll
            for (int m = 0; m < 4; ++m)
#pragma unroll
                for (int bj = 0; bj < 2; ++bj) xv[m][bj] = *(const u32x4*)(X + (size_t)(row0 + ai * HALF + m * 16) * 2048 + col0 + bj * HALF);
#pragma unroll
            for (int m = 0; m < 4; ++m)
#pragma unroll
                for (int bj = 0; bj < 2; ++bj) { const f32x4 v0 = acc[ai][bj][m][0], v1 = acc[ai][bj][m][1]; const u32x4 x = xv[m][bj]; u32x4 w;
#define XLO_(q) __builtin_bit_cast(float, (q) << 16)
#define XHI_(q) __builtin_bit_cast(float, (q) & 0xffff0000u)
                    w.x = cvt_pk_bf16(XLO_(x.x) * alpha + gv[bj][0][0] * v0[0], XHI_(x.x) * alpha + gv[bj][0][1] * v0[1]);
                    w.y = cvt_pk_bf16(XLO_(x.y) * alpha + gv[bj][0][2] * v0[2], XHI_(x.y) * alpha + gv[bj][0][3] * v0[3]);
                    w.z = cvt_pk_bf16(XLO_(x.z) * alpha + gv[bj][1][0] * v1[0], XHI_(x.z) * alpha + gv[bj][1][1] * v1[1]);
                    w.w = cvt_pk_bf16(XLO_(x.w) * alpha + gv[bj][1][2] * v1[2], XHI_(x.w) * alpha + gv[bj][1][3] * v1[3]);
#undef XLO_
#undef XHI_
                    *(u32x4*)(Z + (size_t)(row0 + ai * HALF + m * 16) * 2048 + col0 + bj * HALF) = w; }
        }
    }
};
struct EpiStoreF32 {
    static constexpr bool PERM = true, AFTER_DRAIN = false;
    float* C; int ldc;
    __device__ __forceinline__ void operator()(const f32x4 (&acc)[2][2][4][2], const Unit& u, int wr, int wc, int fr, int fq) const {
        const int row0 = u.pm * BM + wr * 64 + fr, col0 = u.pn * BM + wc * 32 + 8 * fq;
#pragma unroll
        for (int ai = 0; ai < 2; ++ai)
#pragma unroll
            for (int m = 0; m < 4; ++m) { float* rowp = C + (size_t)(row0 + ai * HALF + m * 16) * ldc + col0;
#pragma unroll
                for (int bj = 0; bj < 2; ++bj) { *(f32x4*)(rowp + bj * HALF) = acc[ai][bj][m][0]; *(f32x4*)(rowp + bj * HALF + 4) = acc[ai][bj][m][1]; } }
    }
};

template <class Epi, class Sched, bool ALIGN_EPI = false, bool SP2 = false>
__device__ __forceinline__ void gemm_phase(PG8_LAS unsigned char* lds, const Gemm g, const Sched& S, const Epi& E) {
    int tid_ = threadIdx.x; asm volatile("" : "+v"(tid_));
    const int tid = tid_, wid = __builtin_amdgcn_readfirstlane(tid >> 6), lane = tid & 63, wr = wid >> 2, wc = wid & 3, fr = lane & 15, fq = lane >> 4;
    const int K = g.K, nt = K / BK;
    unsigned voffA[2], voffB[2];
#pragma unroll
    for (int i = 0; i < 2; ++i) { int R, C; stage_rc(tid * 16 + i * 8192, R, C); const int Rb = Epi::PERM ? ((R & ~31) + perm32(R & 31)) : R;
        voffA[i] = (unsigned)(R * K + C) * 2u; voffB[i] = (unsigned)(Rb * K + C) * 2u; }
    const size_t kstep = (size_t)(BK * 2);
    const size_t hstep = (size_t)HALF * K * 2;
    const size_t tstep = 2 * hstep;
    const unsigned ldsw = (unsigned)wid * 1024u;
    const int aoff = lds_byte(wr * 64 + fr, fq * 8), boff = lds_byte(wc * 32 + fr, fq * 8);
#define PG8_SA(b, h) (((b) * 2 + (h)) * HTB)
#define PG8_SB(b, h) ((4 + (b) * 2 + (h)) * HTB)
#define PG8_STAGE(bufoff, gbase, voff) do { _Pragma("unroll") for (int _i = 0; _i < 2; ++_i) \
        __builtin_amdgcn_global_load_lds((const unsigned*)((const char*)(gbase) + (voff)[_i]), (PG8_LAS unsigned*)(lds + (bufoff) + ldsw + _i * 8192), 16, 0, 0); } while (0)
#define PG8_LDA(dst, b, h) do { _Pragma("unroll") for (int m = 0; m < 4; ++m) _Pragma("unroll") for (int k = 0; k < 2; ++k) dst[m][k] = *(const PG8_LAS bf16x8*)(lds + PG8_SA(b, h) + aoff + m * 2048 + k * 1024); } while (0)
#define PG8_LDB(dst, b, h) do { _Pragma("unroll") for (int n = 0; n < 2; ++n) _Pragma("unroll") for (int k = 0; k < 2; ++k) dst[n][k] = *(const PG8_LAS bf16x8*)(lds + PG8_SB(b, h) + boff + n * 2048 + k * 1024); } while (0)
#define PG8_MMA(ai, bj, At, Bt) do { __builtin_amdgcn_s_setprio(1); _Pragma("unroll") for (int m = 0; m < 4; ++m) _Pragma("unroll") for (int n = 0; n < 2; ++n) _Pragma("unroll") for (int k = 0; k < 2; ++k) \
        acc[ai][bj][m][n] = __builtin_amdgcn_mfma_f32_16x16x32_bf16(Bt[n][k], At[m][k], acc[ai][bj][m][n], 0, 0, 0); __builtin_amdgcn_s_setprio(0); } while (0)
#define PG8_WAIT_V(n) asm volatile("s_waitcnt vmcnt(" #n ")" ::: "memory")
#define PG8_WAIT_L(n) asm volatile("s_waitcnt lgkmcnt(" #n ")" ::: "memory")
#define PG8_BAR __builtin_amdgcn_s_barrier()
#define PG8_SCHED __builtin_amdgcn_sched_barrier(0)
    Unit cur, nxt; int ui = 0;
    if (!S.next(0, cur)) return;
    f32x4 acc[2][2][4][2];
#pragma unroll
    for (int a = 0; a < 2; ++a)
#pragma unroll
        for (int b = 0; b < 2; ++b)
#pragma unroll
            for (int m = 0; m < 4; ++m)
#pragma unroll
                for (int n = 0; n < 2; ++n) acc[a][b][m][n] = (f32x4){0.f, 0.f, 0.f, 0.f};
    bf16x8 At[4][2], B0[2][2], B1[2][2];
    const char* cA = (const char*)g.A + (size_t)cur.pm * tstep; const char* cB = (const char*)g.Bt + (size_t)cur.pn * tstep;
    S.a_ready(cur);
    if constexpr (SP2) {
        PG8_STAGE(PG8_SB(0, 0), cB, voffB); PG8_STAGE(PG8_SB(0, 1), cB + hstep, voffB); PG8_STAGE(PG8_SA(0, 0), cA, voffA); PG8_STAGE(PG8_SA(0, 1), cA + hstep, voffA);
        if (wr == 1) PG8_BAR;
        PG8_WAIT_V(2); PG8_BAR;
        PG8_STAGE(PG8_SB(1, 0), cB + kstep, voffB); PG8_STAGE(PG8_SA(1, 0), cA + kstep, voffA); PG8_STAGE(PG8_SB(1, 1), cB + hstep + kstep, voffB);
        PG8_WAIT_V(6); PG8_BAR;
    } else {
        PG8_STAGE(PG8_SB(0, 0), cB, voffB); PG8_STAGE(PG8_SA(0, 0), cA, voffA); PG8_STAGE(PG8_SB(0, 1), cB + hstep, voffB); PG8_STAGE(PG8_SA(0, 1), cA + hstep, voffA);
        if (wr == 1) PG8_BAR;
        PG8_WAIT_V(4); PG8_BAR;
        PG8_STAGE(PG8_SB(1, 0), cB + kstep, voffB); PG8_STAGE(PG8_SA(1, 0), cA + kstep, voffA); PG8_STAGE(PG8_SB(1, 1), cB + hstep + kstep, voffB);
        PG8_WAIT_V(6); PG8_BAR;
    }
    for (;;) {
        const bool has_next = S.next(ui + 1, nxt);
        const char* nA = has_next ? (const char*)g.A + (size_t)nxt.pm * tstep : cA; const char* nB = has_next ? (const char*)g.Bt + (size_t)nxt.pn * tstep : cB;
        for (int t = 0; t < nt; t += 2) {
            const bool last = (t == nt - 2);
            const char* a1 = cA + (size_t)(t + 1) * kstep;
            const char* a2 = last ? nA : cA + (size_t)(t + 2) * kstep; const char* b2 = last ? nB : cB + (size_t)(t + 2) * kstep;
            const char* a3 = a2 + kstep; const char* b3 = b2 + kstep;
            if (last && has_next) S.a_ready(nxt);
            if constexpr (SP2) {
            PG8_LDB(B0, 0, 0); PG8_LDB(B1, 0, 1); PG8_SCHED; PG8_LDA(At, 0, 0); PG8_STAGE(PG8_SA(1, 1), a1 + hstep, voffA);
            PG8_WAIT_V(8); PG8_WAIT_L(0); PG8_BAR; PG8_MMA(0, 0, At, B0); PG8_MMA(0, 1, At, B1); PG8_BAR; PG8_SCHED;
            PG8_LDA(At, 0, 1); PG8_STAGE(PG8_SB(0, 0), b2, voffB); PG8_STAGE(PG8_SB(0, 1), b2 + hstep, voffB); PG8_STAGE(PG8_SA(0, 0), a2, voffA);
            PG8_WAIT_V(8); PG8_WAIT_L(0); PG8_BAR; PG8_MMA(1, 0, At, B0); PG8_MMA(1, 1, At, B1); PG8_BAR; PG8_SCHED;
            PG8_LDB(B0, 1, 0); PG8_LDB(B1, 1, 1); PG8_SCHED; PG8_LDA(At, 1, 0); PG8_STAGE(PG8_SA(0, 1), a2 + hstep, voffA);
            PG8_WAIT_V(8); PG8_WAIT_L(0); PG8_BAR; PG8_MMA(0, 0, At, B0); PG8_MMA(0, 1, At, B1); PG8_BAR; PG8_SCHED;
            PG8_LDA(At, 1, 1); PG8_STAGE(PG8_SB(1, 0), b3, voffB); PG8_STAGE(PG8_SB(1, 1), b3 + hstep, voffB); PG8_STAGE(PG8_SA(1, 0), a3, voffA);
            PG8_WAIT_V(8); PG8_WAIT_L(0); PG8_BAR; PG8_MMA(1, 0, At, B0); PG8_MMA(1, 1, At, B1); PG8_BAR; PG8_SCHED;
            } else {
            PG8_LDB(B0, 0, 0); PG8_SCHED; PG8_LDA(At, 0, 0); PG8_STAGE(PG8_SA(1, 1), a1 + hstep, voffA);
            PG8_WAIT_L(8); PG8_BAR; PG8_WAIT_L(0); PG8_MMA(0, 0, At, B0); PG8_BAR; PG8_SCHED;
            PG8_LDB(B1, 0, 1); PG8_STAGE(PG8_SB(0, 0), b2, voffB);
            PG8_BAR; PG8_WAIT_L(0); PG8_MMA(0, 1, At, B1); PG8_BAR;
            PG8_LDA(At, 0, 1); PG8_STAGE(PG8_SA(0, 0), a2, voffA);
            PG8_BAR; PG8_WAIT_L(0); PG8_MMA(1, 0, At, B0); PG8_BAR; PG8_SCHED;
            PG8_STAGE(PG8_SB(0, 1), b2 + hstep, voffB);
            PG8_WAIT_V(6); PG8_BAR; PG8_MMA(1, 1, At, B1); PG8_BAR;
            PG8_LDB(B0, 1, 0); PG8_SCHED; PG8_LDA(At, 1, 0); PG8_STAGE(PG8_SA(0, 1), a2 + hstep, voffA);
            PG8_WAIT_L(8); PG8_BAR; PG8_WAIT_L(0); PG8_MMA(0, 0, At, B0); PG8_BAR; PG8_SCHED;
            PG8_LDB(B1, 1, 1); PG8_STAGE(PG8_SB(1, 0), b3, voffB);
            PG8_BAR; PG8_WAIT_L(0); PG8_MMA(0, 1, At, B1); PG8_BAR;
            PG8_LDA(At, 1, 1); PG8_STAGE(PG8_SA(1, 0), a3, voffA);
            PG8_BAR; PG8_WAIT_L(0); PG8_MMA(1, 0, At, B0); PG8_BAR; PG8_SCHED;
            PG8_STAGE(PG8_SB(1, 1), b3 + hstep, voffB);
            PG8_WAIT_V(6); PG8_BAR; PG8_MMA(1, 1, At, B1); PG8_BAR;
            }
        }
        if constexpr (ALIGN_EPI) { if (wr == 0) PG8_BAR; }
        if constexpr (!Epi::AFTER_DRAIN) { E(acc, cur, wr, wc, fr, fq); S.done(cur); }
        if (!has_next) break;
#pragma unroll
        for (int a = 0; a < 2; ++a)
#pragma unroll
            for (int b = 0; b < 2; ++b)
#pragma unroll
                for (int m = 0; m < 4; ++m)
#pragma unroll
                    for (int n = 0; n < 2; ++n) acc[a][b][m][n] = (f32x4){0.f, 0.f, 0.f, 0.f};
        cur = nxt; cA = nA; cB = nB; ++ui;
        if constexpr (ALIGN_EPI) { if (wr == 1) PG8_BAR; }
    }
    PG8_WAIT_V(0);
    if constexpr (!ALIGN_EPI) { if (wr == 0) PG8_BAR; }
    PG8_BAR;
    if constexpr (Epi::AFTER_DRAIN) { E.fused(acc, cur, wr, wc, fr, fq, lds, wid, lane); S.done(cur); }
#undef PG8_SA
#undef PG8_SB
#undef PG8_STAGE
#undef PG8_LDA
#undef PG8_LDB
#undef PG8_MMA
#undef PG8_WAIT_V
#undef PG8_WAIT_L
#undef PG8_BAR
#undef PG8_SCHED
}
}
#include <cmath>
namespace attn_body {
using bf16=__hip_bfloat16;
using bf16x8=__attribute__((ext_vector_type(8)))short;
using s16x4=__attribute__((ext_vector_type(4)))short;
using f32x16=__attribute__((ext_vector_type(16)))float;
using u32x4=__attribute__((ext_vector_type(4)))unsigned;
constexpr int D=64;
constexpr int NW=8,QBLK=32,QB=QBLK*NW,KVBLK=64;
constexpr int ATTN_UNIT_ROWS=QB;
__device__ __forceinline__ int crow(int r,int hi){return (r&3)+8*(r>>2)+4*hi;}
#define SBAR() __builtin_amdgcn_sched_barrier(0)
__device__ __forceinline__ void cmask(f32x16&p0,f32x16&p1,int jb,int qrel,int hi){
  const float NEG=-INFINITY; int kb=64*jb+4*hi;
  #pragma unroll
  for(int r=0;r<16;++r){int kv=kb+(r&3)+8*(r>>2); if(kv>qrel)p0[r]=NEG; if(kv+32>qrel)p1[r]=NEG;}
}

constexpr int NSLOT=3, SLOTB=8192;
constexpr int LDS_K=0, LDS_V=NSLOT*SLOTB, LDS_WS=2*NSLOT*SLOTB, LDS_OST=LDS_WS+NW*64*4, LDS_BYTES=LDS_OST+NW*4096;
constexpr float C2=0.125f*1.4426950408889634f;
__device__ __forceinline__ void glds16(const void*gsrc,unsigned lds_dst){unsigned keep;
  asm volatile("s_mov_b32 %0, m0\n\ts_mov_b32 m0, %2\n\ts_nop 0\n\tglobal_load_lds_dwordx4 %1, off\n\ts_mov_b32 m0, %0":"=&s"(keep):"v"(gsrc),"s"(lds_dst):"memory");}
__device__ __forceinline__ float max3f(float a,float b,float c){float r;asm("v_max3_f32 %0, %1, %2, %3":"=v"(r):"v"(a),"v"(b),"v"(c));return r;}
__device__ __forceinline__ float max2f(float a,float b){float r;asm("v_max_f32_e32 %0, %1, %2":"=v"(r):"v"(a),"v"(b));return r;}
__device__ __forceinline__ float fadd_s(float a,float b){float r;asm("v_add_f32_e32 %0, %1, %2":"=v"(r):"v"(a),"v"(b));return r;}
__device__ __forceinline__ float fsub_s(float a,float b){float r;asm("v_sub_f32_e32 %0, %1, %2":"=v"(r):"v"(a),"v"(b));return r;}
typedef float f32x2_t __attribute__((ext_vector_type(2))); typedef __bf16 bf16x2_t __attribute__((ext_vector_type(2)));
__device__ __forceinline__ unsigned cvtpk_s(float lo,float hi){f32x2_t v={lo,hi};bf16x2_t b=__builtin_convertvector(v,bf16x2_t);return __builtin_bit_cast(unsigned,b);}
#define WAIT_BAR(N) asm volatile("s_waitcnt vmcnt(" #N ") lgkmcnt(0)\n\ts_barrier":::"memory")

__device__ __forceinline__ void qkt(f32x16&p0,f32x16&p1,const char*Kslot,const bf16x8*qr,const f32x16&negm,int r32,int hi){
  const char*kb=Kslot+hi*1024+r32*16;
  #pragma unroll
  for(int d0=0;d0<4;++d0){
    const bf16x8 b0=*reinterpret_cast<const bf16x8*>(kb+d0*2048);
    const bf16x8 b1=*reinterpret_cast<const bf16x8*>(kb+d0*2048+512);
    if(d0==0){p0=__builtin_amdgcn_mfma_f32_32x32x16_bf16(b0,qr[0],negm,0,0,0);p1=__builtin_amdgcn_mfma_f32_32x32x16_bf16(b1,qr[0],negm,0,0,0);}
    else{p0=__builtin_amdgcn_mfma_f32_32x32x16_bf16(b0,qr[d0],p0,0,0,0);p1=__builtin_amdgcn_mfma_f32_32x32x16_bf16(b1,qr[d0],p1,0,0,0);}}
}
typedef __attribute__((address_space(3))) const char* lds_cptr;
typedef short v4i16_t __attribute__((ext_vector_type(4)));
__device__ __forceinline__ void kload8(bf16x8*kf,lds_cptr kp){
  kf[0]=*(const __attribute__((address_space(3))) bf16x8*)(kp);      kf[1]=*(const __attribute__((address_space(3))) bf16x8*)(kp+512);
  kf[2]=*(const __attribute__((address_space(3))) bf16x8*)(kp+2048); kf[3]=*(const __attribute__((address_space(3))) bf16x8*)(kp+2560);
  kf[4]=*(const __attribute__((address_space(3))) bf16x8*)(kp+4096); kf[5]=*(const __attribute__((address_space(3))) bf16x8*)(kp+4608);
  kf[6]=*(const __attribute__((address_space(3))) bf16x8*)(kp+6144); kf[7]=*(const __attribute__((address_space(3))) bf16x8*)(kp+6656);
}
__device__ __forceinline__ void kload2(bf16x8*kf,lds_cptr kp,int j){ kf[2*j]=*(const __attribute__((address_space(3))) bf16x8*)(kp+j*2048); kf[2*j+1]=*(const __attribute__((address_space(3))) bf16x8*)(kp+j*2048+512); }
__device__ __forceinline__ s16x4 vtr(lds_cptr p){ return __builtin_bit_cast(s16x4,__builtin_amdgcn_ds_read_tr16_b64_v4i16((__attribute__((address_space(3))) v4i16_t*)p)); }
__device__ __forceinline__ float rowmax(const f32x16&p0,const f32x16&p1){
  float a=max3f(p0[0],p0[1],p1[0]),b=max3f(p0[2],p0[3],p1[1]);a=max3f(a,p1[2],p1[3]);
  #pragma unroll
  for(int r=4;r<16;r+=4){a=max3f(a,p0[r],p0[r+1]);b=max3f(b,p0[r+2],p0[r+3]);a=max3f(a,p1[r],p1[r+1]);b=max3f(b,p1[r+2],p1[r+3]);}
  const float m=max2f(a,b);
  auto rr=__builtin_amdgcn_permlane32_swap(__float_as_uint(m),__float_as_uint(m),false,false);
  return max2f(__uint_as_float(rr[0]),__uint_as_float(rr[1]));
}
__device__ __forceinline__ void pv(f32x16*o,int vb,bf16x8 pa0,bf16x8 pa1,bf16x8 pa2,bf16x8 pa3){
  #pragma unroll
  for(int d0=0;d0<2;++d0){s16x4 lo[4],hi[4];
    #pragma unroll
    for(int ks=0;ks<4;++ks){
      asm volatile("ds_read_b64_tr_b16 %0,%1 offset:%c2":"=&v"(lo[ks]):"v"(vb),"i"(d0*4096+ks*1024):"memory");
      asm volatile("ds_read_b64_tr_b16 %0,%1 offset:%c2":"=&v"(hi[ks]):"v"(vb),"i"(d0*4096+ks*1024+512):"memory");}
    asm volatile("s_waitcnt lgkmcnt(0)":::"memory");SBAR();
    #define PK(k) (bf16x8){lo[k][0],lo[k][1],lo[k][2],lo[k][3],hi[k][0],hi[k][1],hi[k][2],hi[k][3]}
    o[d0]=__builtin_amdgcn_mfma_f32_32x32x16_bf16(pa0,PK(0),o[d0],0,0,0);
    o[d0]=__builtin_amdgcn_mfma_f32_32x32x16_bf16(pa1,PK(1),o[d0],0,0,0);
    o[d0]=__builtin_amdgcn_mfma_f32_32x32x16_bf16(pa2,PK(2),o[d0],0,0,0);
    o[d0]=__builtin_amdgcn_mfma_f32_32x32x16_bf16(pa3,PK(3),o[d0],0,0,0);
    #undef PK
  }
}

#ifndef ATTN_STORE16
#define ATTN_STORE16(p,v) (*(u32x4*)(p)=(v))
#endif
template<int THRL,int MODE> __device__ __forceinline__ void attn_unit(const bf16*Qu,const int QP,const bf16*__restrict__ Kh,const int KP,const bf16*__restrict__ Vh,const int VP,bf16*Ou,const int OP,const int NT,char*shm,const int img_r0,const __attribute__((address_space(3))) float* rpb_tab){
  int tid_=threadIdx.x; asm volatile("":"+v"(tid_));
  const int tid=tid_,lane=tid&63,r32=lane&31,hi=lane>>5; const int wid=__builtin_amdgcn_readfirstlane(tid>>6);
  const bf16*Qw=Qu+(long)(wid*QBLK)*QP;
  const unsigned lds0=(unsigned)(uintptr_t)shm;
  float*wsf=(float*)(shm+LDS_WS)+wid*64;
  const bf16*ksrc=Kh+(long)lane*KP+wid*8;
  const bf16*vsrc=Vh+(long)(16*(wid&3)+(lane>>2))*VP+(wid>>2)*32+(lane&3)*8;
  const unsigned kdst=lds0+LDS_K+wid*1024, vdst=lds0+LDS_V+wid*1024;
  const int band0=(MODE==1)?min(max(img_r0-4,0),120):0;
  #define TROW(t) ((long)(t)*KVBLK+((MODE==1&&(t)>=4)?(long)band0*64:0l))
  #define DMA_K(t,slot) glds16(ksrc+TROW(t)*KP,(unsigned)__builtin_amdgcn_readfirstlane(kdst+(slot)))
  #define DMA_V(t,slot) glds16(vsrc+TROW(t)*VP,(unsigned)__builtin_amdgcn_readfirstlane(vdst+(slot)))
  const int vb0=(int)(lds0+LDS_V)+((lane>>4)&1)*32+(lane&3)*8+(4*hi+((lane&15)>>2))*64;
  const char*Kbase=shm+LDS_K; bf16x8 kf[8];
  const lds_cptr shm3=(lds_cptr)shm; const lds_cptr kp0=shm3+LDS_K+hi*1024+r32*16; const lds_cptr vp0=shm3+LDS_V+((lane>>4)&1)*32+(lane&3)*8+(4*hi+((lane&15)>>2))*64;
  DMA_K(0,0);DMA_V(0,0);DMA_K(1,SLOTB);
  bf16x8 qr[4];
  #pragma unroll
  for(int d0=0;d0<4;++d0)qr[d0]=*reinterpret_cast<const bf16x8*>(&Qw[(long)r32*QP+d0*16+hi*8]);
  if(MODE!=0){
    #pragma unroll
    for(int d0=0;d0<4;++d0){
      #pragma unroll
      for(int e=0;e<8;e+=2){ const float lo=__uint_as_float(((unsigned)(unsigned short)qr[d0][e])<<16)*C2, hi2=__uint_as_float(((unsigned)(unsigned short)qr[d0][e+1])<<16)*C2;
        const unsigned pk=cvtpk_s(lo,hi2); qr[d0][e]=(short)(pk&0xffffu); qr[d0][e+1]=(short)(pk>>16); } } }
  float mhat=0.f,l_reg=0.f;f32x16 o[2];o[0]=f32x16{};o[1]=f32x16{};f32x16 negm=f32x16{}; if(MODE!=1) asm volatile("":"+v"(negm));
  const int na_qc=32*(wid&1)+r32, na_cs=min(max(na_qc-8,0),48), na_r=img_r0+(wid>>1), na_rs=min(max(na_r-4,0),120);
  #define CMASK(P0,P1,t) do{ if(MODE==1&&(t)>=4){ const int br_=band0+(t)-4; const bool rok_=(br_>=na_rs)&&(br_<na_rs+8); \
      int qcl_=na_qc, csl_=na_cs, hil_=hi; asm volatile("":"+v"(qcl_),"+v"(csl_),"+v"(hil_));     \
      const int brow_=(rok_?(br_-na_r+7):0)*31-qcl_+15; \
      _Pragma("unroll") for(int r_=0;r_<16;++r_){ const int kc_=crow(r_,hil_); \
        const bool ok0_=rok_&&(kc_>=csl_)&&(kc_<csl_+16), ok1_=rok_&&(kc_+32>=csl_)&&(kc_+32<csl_+16); \
        const float b0_=rpb_tab[ok0_?brow_+kc_:0], b1_=rpb_tab[ok1_?brow_+kc_+32:0]; \
        P0[r_]=ok0_?P0[r_]+b0_*1.4426950408889634f:-INFINITY; P1[r_]=ok1_?P1[r_]+b1_*1.4426950408889634f:-INFINITY; } } }while(0)
  #define SUBREF(P0,P1) do{ if(MODE==1){ _Pragma("unroll") for(int r_=0;r_<16;++r_){P0[r_]-=mhat;P1[r_]-=mhat;} } }while(0)
  #define NEGMC ((MODE==1)?f32x16{}:negm)
  bool resc=false;
  #define START(P0,P1) do{ const float rm=rowmax(P0,P1); resc=false; \
    { const float dl=rm; mhat=fadd_s(mhat,dl); \
      _Pragma("unroll") for(int r=0;r<16;++r){P0[r]=fsub_s(P0[r],dl);P1[r]=fsub_s(P1[r],dl);} \
      if(MODE!=1){ _Pragma("unroll") for(int r=0;r<16;++r)negm[r]=-mhat; asm volatile("":"+v"(negm)); } } \
    _Pragma("unroll") for(int r=0;r<16;++r)P0[r]=__builtin_amdgcn_exp2f(P0[r]); }while(0)
  #define RESC() do{ if(resc){ asm volatile("s_waitcnt lgkmcnt(0)":::"memory"); \
      _Pragma("unroll") for(int d_=0;d_<2;++d_) _Pragma("unroll") for(int r=0;r<16;++r)o[d_][r]*=wsf[crow(r,hi)]; } }while(0)
  f32x16 pA0,pA1,pB0,pB1;
  int sl_prev=0,sl_cur=0,sl_next=SLOTB;
  #define ROT() do{sl_prev=sl_cur;sl_cur=sl_next;sl_next=(sl_next==(NSLOT-1)*SLOTB)?0:sl_next+SLOTB;}while(0)
  DMA_K(2,2*SLOTB);
  WAIT_BAR(3);
  qkt(pA0,pA1,Kbase,qr,negm,r32,hi);asm volatile("s_nop 15\n\ts_nop 7":"+v"(pA0),"+v"(pA1));CMASK(pA0,pA1,0);
  START(pA0,pA1);
  _Pragma("unroll") for(int r=0;r<16;++r)pA1[r]=__builtin_amdgcn_exp2f(pA1[r]);
  WAIT_BAR(0);
  DMA_K(3,0);DMA_V(1,SLOTB);
  ROT();
  kload8(kf,kp0+sl_cur);
  WAIT_BAR(2);
  s16x4 vlo[8],vhi[8]; u32x4 pw0,pw1,pw2,pw3;
  #define PKW(P,B) cvtpk_s(P[B],P[B+1])
  #define PAF(k) __builtin_bit_cast(bf16x8,pw##k)
  #define VFR(i) (bf16x8){vlo[i][0],vlo[i][1],vlo[i][2],vlo[i][3],vhi[i][0],vhi[i][1],vhi[i][2],vhi[i][3]}
  #define PIN(x) asm volatile("":"+v"(x))
  #define MX3(a,b,c) __builtin_fmaxf(__builtin_fmaxf((a),(b)),(c))
  #define GAPA(MF,A0,A1,A2,A3,W0,W1,PW) do{ MF; sacc+=A0; sacc+=A1; sacc+=A2; sacc+=A3; PIN(sacc); W0; W1; PIN(PW); SBAR(); }while(0)
  #define EX(v) __builtin_amdgcn_exp2f(v)
  #define GAPB(MF,X,B) do{ MF; X[B]=EX(X[B]); X[B+1]=EX(X[B+1]); X[B+2]=EX(X[B+2]); X[B+3]=EX(X[B+3]); PIN(X); SBAR(); }while(0)
  #define VRD(i) do{ vlo[i]=vtr(vp_+(((i)>>2)*4096+((i)&3)*1024)); vhi[i]=vtr(vp_+(((i)>>2)*4096+((i)&3)*1024+512)); }while(0)
  #define KRD(G,j) do{ if(G){ kload2(kf,kp0+sl_next,j); SBAR(); } }while(0)
  #define STEP(C0,C1,P0,P1,t,GK,GV,GL) do{ SBAR(); \
    const lds_cptr vp_=vp0+sl_prev; \
    VRD(0); SBAR(); float sacc=(P0[0]+P0[1]); \
    GAPA(C0=__builtin_amdgcn_mfma_f32_32x32x16_bf16(kf[0],qr[0],NEGMC,0,0,0), P0[2],P0[3],P0[4],P0[5],     pw0[0]=PKW(P0,0), pw0[1]=PKW(P0,2), pw0); \
    VRD(4); SBAR(); GAPA(C1=__builtin_amdgcn_mfma_f32_32x32x16_bf16(kf[1],qr[0],NEGMC,0,0,0), P0[6],P0[7],P0[8],P0[9],     pw0[2]=PKW(P0,4), pw0[3]=PKW(P0,6), pw0); \
    VRD(1); SBAR(); GAPA(C0=__builtin_amdgcn_mfma_f32_32x32x16_bf16(kf[2],qr[1],C0,0,0,0),   P0[10],P0[11],P0[12],P0[13], pw1[0]=PKW(P0,8), pw1[1]=PKW(P0,10), pw1); \
    VRD(5); SBAR(); GAPA(C1=__builtin_amdgcn_mfma_f32_32x32x16_bf16(kf[3],qr[1],C1,0,0,0),   P0[14],P0[15],P1[0],P1[1],   pw1[2]=PKW(P0,12),pw1[3]=PKW(P0,14), pw1); \
    VRD(2); SBAR(); GAPA(C0=__builtin_amdgcn_mfma_f32_32x32x16_bf16(kf[4],qr[2],C0,0,0,0),   P1[2],P1[3],P1[4],P1[5],     pw2[0]=PKW(P1,0), pw2[1]=PKW(P1,2), pw2); \
    VRD(6); SBAR(); GAPA(C1=__builtin_amdgcn_mfma_f32_32x32x16_bf16(kf[5],qr[2],C1,0,0,0),   P1[6],P1[7],P1[8],P1[9],     pw2[2]=PKW(P1,4), pw2[3]=PKW(P1,6), pw2); \
    VRD(3); SBAR(); GAPA(C0=__builtin_amdgcn_mfma_f32_32x32x16_bf16(kf[6],qr[3],C0,0,0,0),   P1[10],P1[11],P1[12],P1[13], pw3[0]=PKW(P1,8), pw3[1]=PKW(P1,10), pw3); \
    VRD(7); SBAR(); GAPA(C1=__builtin_amdgcn_mfma_f32_32x32x16_bf16(kf[7],qr[3],C1,0,0,0),   P1[14],P1[15],0.f,0.f,       pw3[2]=PKW(P1,12),pw3[3]=PKW(P1,14), pw3); \
    l_reg+=sacc; \
    if(GK){DMA_K((t)+3,sl_cur);} if(GV){DMA_V((t)+1,sl_next);} \
    SUBREF(C0,C1); CMASK(C0,C1,t); \
    { float a=MX3(C0[0],C0[1],C1[0]),b=MX3(C0[2],C0[3],C1[1]); a=MX3(a,C1[2],C1[3]); \
      _Pragma("unroll") for(int r=4;r<16;r+=4){a=MX3(a,C0[r],C0[r+1]);b=MX3(b,C0[r+2],C0[r+3]);a=MX3(a,C1[r],C1[r+1]);b=MX3(b,C1[r+2],C1[r+3]);} \
      float rm=__builtin_fmaxf(a,b); { auto rr=__builtin_amdgcn_permlane32_swap(__float_as_uint(rm),__float_as_uint(rm),false,false); rm=__builtin_fmaxf(__uint_as_float(rr[0]),__uint_as_float(rr[1])); } \
      resc=false; \
      if(__builtin_expect(__any(rm>(float)THRL),0)){ const float dl=__builtin_fmaxf(rm,0.f); mhat+=dl; \
        _Pragma("unroll") for(int r=0;r<16;++r){C0[r]-=dl;C1[r]-=dl;} \
        if(MODE!=1){ _Pragma("unroll") for(int r=0;r<16;++r)negm[r]=-mhat; asm volatile("":"+v"(negm)); } \
        const float f=__builtin_amdgcn_exp2f(-dl); l_reg*=f; if(hi==0)wsf[r32]=f; resc=true; } } \
    SBAR(); \
    GAPB(o[0]=__builtin_amdgcn_mfma_f32_32x32x16_bf16(PAF(0),VFR(0),o[0],0,0,0), C0,0); \
    GAPB(o[1]=__builtin_amdgcn_mfma_f32_32x32x16_bf16(PAF(0),VFR(4),o[1],0,0,0), C0,4); \
    KRD(GL,0); GAPB(o[0]=__builtin_amdgcn_mfma_f32_32x32x16_bf16(PAF(1),VFR(1),o[0],0,0,0), C0,8); \
    KRD(GL,1); GAPB(o[1]=__builtin_amdgcn_mfma_f32_32x32x16_bf16(PAF(1),VFR(5),o[1],0,0,0), C0,12); \
    KRD(GL,2); GAPB(o[0]=__builtin_amdgcn_mfma_f32_32x32x16_bf16(PAF(2),VFR(2),o[0],0,0,0), C1,0); \
    KRD(GL,3); GAPB(o[1]=__builtin_amdgcn_mfma_f32_32x32x16_bf16(PAF(2),VFR(6),o[1],0,0,0), C1,4); \
    GAPB(o[0]=__builtin_amdgcn_mfma_f32_32x32x16_bf16(PAF(3),VFR(3),o[0],0,0,0), C1,8); \
    GAPB(o[1]=__builtin_amdgcn_mfma_f32_32x32x16_bf16(PAF(3),VFR(7),o[1],0,0,0), C1,12); \
    }while(0)
  int t=1;
  for(;t+5<NT;t+=2){
    STEP(pB0,pB1,pA0,pA1,t,true,true,true);     WAIT_BAR(2); RESC(); ROT();
    STEP(pA0,pA1,pB0,pB1,t+1,true,true,true);   WAIT_BAR(2); RESC(); ROT();
  }
  #define ENDW(tt) do{ if((tt)+3<NT){WAIT_BAR(2);} else if((tt)+2<NT){WAIT_BAR(1);} else {WAIT_BAR(0);} }while(0)
  for(;t+1<NT;t+=2){
    STEP(pB0,pB1,pA0,pA1,t,(t+3<NT),(t+1<NT),(t+1<NT));       ENDW(t);   RESC(); ROT();
    STEP(pA0,pA1,pB0,pB1,t+1,(t+4<NT),(t+2<NT),(t+2<NT));     ENDW(t+1); RESC(); ROT();
  }
  STEP(pB0,pB1,pA0,pA1,NT-1,false,false,false); RESC();
  { float sacc=pB0[0]+pB0[1]; _Pragma("unroll") for(int r=2;r<16;++r)sacc+=pB0[r]; _Pragma("unroll") for(int r=0;r<16;++r)sacc+=pB1[r]; l_reg+=sacc;
    pw0=(u32x4){PKW(pB0,0),PKW(pB0,2),PKW(pB0,4),PKW(pB0,6)};pw1=(u32x4){PKW(pB0,8),PKW(pB0,10),PKW(pB0,12),PKW(pB0,14)};pw2=(u32x4){PKW(pB1,0),PKW(pB1,2),PKW(pB1,4),PKW(pB1,6)};pw3=(u32x4){PKW(pB1,8),PKW(pB1,10),PKW(pB1,12),PKW(pB1,14)};
    SBAR(); pv(o,vb0+sl_cur,PAF(0),PAF(1),PAF(2),PAF(3)); }
  #undef PKW
  #undef PAF
  #undef VFR
  #undef PIN
  #undef MX3
  #undef GAPA
  #undef GAPB
  #undef EX
  #undef VRD
  #undef KRD
  #undef STEP
  #undef ENDW
  {auto rr=__builtin_amdgcn_permlane32_swap(__float_as_uint(l_reg),__float_as_uint(l_reg),false,false);l_reg=__uint_as_float(rr[0])+__uint_as_float(rr[1]);}
  if(hi==0)wsf[32+r32]=l_reg;asm volatile("s_waitcnt lgkmcnt(0)":::"memory");
  float rli[16];
  #pragma unroll
  for(int r=0;r<16;++r)rli[r]=__builtin_amdgcn_rcpf(wsf[32+crow(r,hi)]);
  bf16*Ow=Ou+(long)(wid*QBLK)*OP;
  { bf16*stg=(bf16*)(shm+LDS_OST)+wid*2048;
    #pragma unroll
    for(int r=0;r<16;++r){const int orow=crow(r,hi);
      #pragma unroll
      for(int d0=0;d0<2;++d0)stg[orow*64+d0*32+r32]=__float2bfloat16(o[d0][r]*rli[r]);}
    asm volatile("s_waitcnt lgkmcnt(0)":::"memory");
    #pragma unroll
    for(int i=0;i<4;++i){const int row=i*8+(lane>>3),ch=lane&7; const u32x4 v=*(const u32x4*)(stg+row*64+ch*8); ATTN_STORE16(Ow+(long)row*OP+ch*8,v);} }
  asm volatile("s_waitcnt lgkmcnt(0)\n\ts_barrier":::"memory");
  #undef DMA_K
  #undef DMA_V
  #undef TROW
  #undef CMASK
  #undef SUBREF
  #undef NEGMC
  #undef START
  #undef RESC
  #undef ROT
}
constexpr int ATTN_LDS_BYTES=LDS_BYTES;
#undef SBAR
#undef WAIT_BAR
}

constexpr int D = 2048, T = 8192, LC = 256, MT = T + LC, DEPTH = 4;
constexpr int INW = 5408, INWP = 5632;
constexpr int C_NAQ = 0, C_NAK = 512, C_NAV = 1024, C_GQ = 1536, C_GK = 2048, C_GV = 2560, C_GG = 3584, C_GLR = 4608, C_CQ = 4640, C_CK = 5152, C_CV = 5280;
constexpr int NCH = MT / 64;
constexpr float LN_EPS = 1e-6f, ALPHA = 1.681792830507429f;
constexpr int NEXP = 16384;

constexpr size_t MiB = 1u << 20;
constexpr size_t WS_CTL = 0, CTL_ZERO_BYTES = 1 * MiB;
constexpr size_t WS_MOD = 1 * MiB;
constexpr size_t WS_ROPE = WS_MOD + 512 * 1024;
constexpr size_t WS_WIN = 2 * MiB;
constexpr size_t WS_WOUT = WS_WIN + 88 * MiB;
constexpr size_t WS_WP = WS_WOUT + 32 * MiB;
constexpr size_t WS_X = WS_WP + 32 * MiB;
constexpr size_t WS_Z = WS_X + 66 * MiB;
constexpr size_t WS_H = WS_Z + 66 * MiB;
constexpr size_t WS_P = WS_H + 33 * MiB;
constexpr size_t WS_QC = WS_P + 91 * MiB;
constexpr size_t WS_KC = WS_QC + 9 * MiB;
constexpr size_t WS_QTF = WS_KC + 3 * MiB;
constexpr size_t WS_QTB = WS_QTF + 9 * MiB;
constexpr size_t WS_OI = WS_QTB + 9 * MiB;
constexpr size_t WS_UPD = WS_OI + 33 * MiB;
constexpr size_t WS_SPREV = WS_UPD + 132 * MiB;
constexpr size_t WS_DEC = WS_SPREV + 132 * MiB;
constexpr size_t WS_MIX = WS_DEC + 1 * MiB;
constexpr size_t WS_ST = WS_MIX + 33 * MiB;
constexpr size_t WS_IDX = WS_ST + 66 * MiB;
constexpr size_t WS_GATE = WS_IDX + 5 * MiB;
constexpr size_t WS_PU = WS_GATE + 5 * MiB;
constexpr size_t WS_PV = WS_PU + 128 * MiB;
constexpr size_t WS_SCU = WS_PV + 128 * MiB;
constexpr size_t WS_SCV = WS_SCU + 1 * MiB;
constexpr size_t WS_VC = WS_SCV + 1 * MiB;
constexpr size_t WS_ACT = WS_VC + 3 * MiB;
constexpr size_t WS_PART = WS_ACT + 5 * MiB;
constexpr size_t WS_END = WS_PART + 67 * MiB;
constexpr int CW_BAR = 4096;

constexpr int RING_BYTES = 147456;
constexpr int LDSCTL_OFF = RING_BYTES, MISC_OFF = LDSCTL_OFF + 320;
constexpr int LDS_BYTES = 148480;
constexpr int NWAVES = 8, NT = 512;

#ifndef REP_MASK
#define REP_MASK 0
#endif
#define RP(b) ((((REP_MASK) >> (b)) & 1) ? 2 : 1)
#define GAS __attribute__((address_space(1)))
#define LAS __attribute__((address_space(3)))
typedef unsigned short bf16;
typedef unsigned v4u __attribute__((ext_vector_type(4)));
typedef unsigned v2u __attribute__((ext_vector_type(2)));
typedef float f32x4 __attribute__((ext_vector_type(4)));
typedef float f32x2 __attribute__((ext_vector_type(2)));
typedef short bf16x8v __attribute__((ext_vector_type(8)));
typedef float f32x16v __attribute__((ext_vector_type(16)));
#define LDS_WAIT() asm volatile("s_waitcnt lgkmcnt(0)" ::: "memory")
__device__ __forceinline__ unsigned f2bf(float f) { return (unsigned)__builtin_bit_cast(unsigned short, (__bf16)f); }
typedef __bf16 bf16x2_t __attribute__((ext_vector_type(2)));
__device__ __forceinline__ unsigned pk2(float lo, float hi) { const bf16x2_t b = __builtin_convertvector((f32x2){lo, hi}, bf16x2_t); return __builtin_bit_cast(unsigned, b); }
__device__ __forceinline__ float bflo(unsigned w) { return __builtin_bit_cast(float, w << 16); }
__device__ __forceinline__ float bfhi(unsigned w) { return __builtin_bit_cast(float, w & 0xffff0000u); }
__device__ __forceinline__ float bf1(bf16 v) { return __builtin_bit_cast(float, (unsigned)v << 16); }
__device__ __forceinline__ float wave_sum(float v) {
#pragma unroll
    for (int o = 1; o < 64; o <<= 1) v += __shfl_xor(v, o);
    return v;
}
__device__ __forceinline__ float silu_f(float x) { return x / (1.f + __expf(-x)); }
__device__ __forceinline__ float gelu_tanh(float x) { const float u = 0.7978845608028654f * (x + 0.044715f * x * x * x); const float t = 1.f - 2.f / (1.f + __expf(2.f * u)); return 0.5f * x * (1.f + t); }
__device__ __forceinline__ float logsigmoid_f(float z) { return fminf(z, 0.f) - __logf(1.f + __expf(-fabsf(z))); }

#define XB_TMO      128
#define XB_XCNT(j)  (256  + 64 * (j))
#define XB_XSUB(j)  (1280 + 64 * (j))
#define XB_XGEN(j)  (2304 + 64 * (j))
#define XB_TOP      3328
#define XB_TOPGEN   3392
#define XCD_BAR_WORDS 3456
#define XB_SPIN_CAP (1u << 21)
__device__ __forceinline__ unsigned xb_ld(unsigned* p)              { return __hip_atomic_load(p, __ATOMIC_RELAXED, __HIP_MEMORY_SCOPE_AGENT); }
__device__ __forceinline__ unsigned xb_add(unsigned* p, unsigned v) { return __hip_atomic_fetch_add(p, v, __ATOMIC_RELAXED, __HIP_MEMORY_SCOPE_AGENT); }
__device__ __forceinline__ unsigned xb_xcc_id() { return (unsigned)__builtin_amdgcn_s_getreg((3 << 11) | 20) & 0xFu; }
#define XB_SPIN(cond, bar) do { unsigned _sp = 0; while (cond) { __builtin_amdgcn_s_sleep(1); \
    if ((++_sp & 255u) == 0u) { if (xb_ld(&(bar)[XB_TMO])) break; if (_sp > XB_SPIN_CAP) { atomicAdd(&(bar)[XB_TMO], 1u); break; } } } } while (0)
struct XcdBarrier { unsigned* bar; unsigned x; volatile LAS unsigned* st; };
__device__ __forceinline__ XcdBarrier xcd_barrier_post(unsigned* bar, volatile LAS unsigned* st) {
    XcdBarrier b; b.bar = bar; b.x = xb_xcc_id(); b.st = st;
    if (threadIdx.x == 0) (void)xb_add(&bar[XB_XCNT(b.x)], 1u);
    return b;
}
__device__ __forceinline__ void xcd_barrier_complete(unsigned* bar, unsigned x, unsigned& nloc, unsigned& nx) {
    const unsigned G = gridDim.x * gridDim.y * gridDim.z;
    unsigned sum, cnt, mine, sp = 0u;
    for (;;) {
        sum = 0u; cnt = 0u; mine = 0u;
#pragma unroll
        for (unsigned j = 0; j < 16; ++j) { const unsigned c = xb_ld(&bar[XB_XCNT(j)]); sum += c; cnt += (c > 0u) ? 1u : 0u; mine = (j == x) ? c : mine; }
        if (sum == G) break;
        __builtin_amdgcn_s_sleep(1);
        if ((++sp & 255u) == 0u) { if (xb_ld(&bar[XB_TMO])) break; if (sp > XB_SPIN_CAP) { atomicAdd(&bar[XB_TMO], 1u); break; } }
    }
    nloc = mine > 0u ? mine : 1u; nx = cnt > 0u ? cnt : 1u;
}
__device__ __forceinline__ void xcd_barrier(const XcdBarrier& b) {
    asm volatile("s_waitcnt vmcnt(0)" ::: "memory");
    __syncthreads();
    if (threadIdx.x == 0) {
        unsigned* bar = b.bar;
        __builtin_amdgcn_s_waitcnt(0);
        unsigned nloc = b.st[0], nx = b.st[1];
        if (nloc == 0u) { xcd_barrier_complete(bar, b.x, nloc, nx); b.st[0] = nloc; b.st[1] = nx; }
        const unsigned old = xb_add(&bar[XB_XSUB(b.x)], 1u);
        const unsigned gen = old / nloc;
        if (old + 1u == (gen + 1u) * nloc) {
            __builtin_amdgcn_fence(__ATOMIC_RELEASE, "agent");
            asm volatile("s_waitcnt vmcnt(0)" ::: "memory");
            const unsigned og = xb_add(&bar[XB_TOP], 1u);
            const unsigned tg = og / nx;
            if (og + 1u == (tg + 1u) * nx) xb_add(&bar[XB_TOPGEN], 1u);
            else XB_SPIN(xb_ld(&bar[XB_TOPGEN]) == tg, bar);
            __builtin_amdgcn_fence(__ATOMIC_ACQUIRE, "agent");
            xb_add(&bar[XB_XGEN(b.x)], 1u);
            asm volatile("s_waitcnt vmcnt(0)" ::: "memory");
        } else {
            XB_SPIN(xb_ld(&bar[XB_XGEN(b.x)]) == gen, bar);
            __builtin_amdgcn_fence(__ATOMIC_ACQUIRE, "agent");
            asm volatile("s_waitcnt vmcnt(0)" ::: "memory");
        }
    }
    __syncthreads();
}

struct Args { const float* in[22]; float* out; unsigned char* ws; int ph_lo, ph_hi; };
struct Frame {
    LAS unsigned char* lds; char* ldsg;
    int tid, lane, wave, vcu, G;
    const __attribute__((address_space(4))) Args* ap;
};
#define IN_X(F) ((F).ap->in[0])
#define IN_C(F) ((F).ap->in[1])
#define IN_CTX(F) ((F).ap->in[2])
#define IN_CCTX(F) ((F).ap->in[3])
#define IN_WMOD(F) ((F).ap->in[4])
#define IN_BMOD(F) ((F).ap->in[5])
#define IN_WIN(F) ((F).ap->in[6])
#define IN_RPB(F) ((F).ap->in[7])
#define IN_GGW(F) ((F).ap->in[8])
#define IN_GGB(F) ((F).ap->in[9])
#define IN_GNW(F) ((F).ap->in[10])
#define IN_QNW(F) ((F).ap->in[11])
#define IN_KNW(F) ((F).ap->in[12])
#define IN_WOUT(F) ((F).ap->in[13])
#define IN_LN1G(F) ((F).ap->in[14])
#define IN_LN1B(F) ((F).ap->in[15])
#define IN_WQ(F) ((F).ap->in[16])
#define IN_SUBK(F) ((F).ap->in[17])
#define IN_PU(F) ((F).ap->in[18])
#define IN_PV(F) ((F).ap->in[19])
#define IN_LN2G(F) ((F).ap->in[20])
#define IN_LN2B(F) ((F).ap->in[21])
#define WSP(F, T_, off) ((T_*)((F).ap->ws + (off)))
__device__ __forceinline__ void launder(Frame& F) { int t_ = F.tid; asm volatile("" : "+v"(t_)); F.tid = t_; F.lane = t_ & 63; F.wave = __builtin_amdgcn_readfirstlane(t_ >> 6);
    const __attribute__((address_space(4))) Args* a_ = F.ap; asm volatile("" : "+s"(a_)); F.ap = a_; }

__device__ __forceinline__ void row_load_f32(const float* row, int lane, float (&v)[32]) {
#pragma unroll
    for (int j = 0; j < 4; ++j) { const f32x4 a = *(const f32x4*)(row + 8 * lane + 512 * j), b = *(const f32x4*)(row + 8 * lane + 512 * j + 4);
        v[8 * j + 0] = a[0]; v[8 * j + 1] = a[1]; v[8 * j + 2] = a[2]; v[8 * j + 3] = a[3]; v[8 * j + 4] = b[0]; v[8 * j + 5] = b[1]; v[8 * j + 6] = b[2]; v[8 * j + 7] = b[3]; }
}
__device__ __forceinline__ void row_store_f32(float* row, int lane, const float (&v)[32]) {
#pragma unroll
    for (int j = 0; j < 4; ++j) { *(f32x4*)(row + 8 * lane + 512 * j) = (f32x4){v[8 * j], v[8 * j + 1], v[8 * j + 2], v[8 * j + 3]}; *(f32x4*)(row + 8 * lane + 512 * j + 4) = (f32x4){v[8 * j + 4], v[8 * j + 5], v[8 * j + 6], v[8 * j + 7]}; }
}
__device__ __forceinline__ void row_load_bf16(const bf16* row, int lane, float (&v)[32]) {
#pragma unroll
    for (int j = 0; j < 4; ++j) { const v4u w = *(const v4u*)(row + 8 * lane + 512 * j);
        v[8 * j + 0] = bflo(w.x); v[8 * j + 1] = bfhi(w.x); v[8 * j + 2] = bflo(w.y); v[8 * j + 3] = bfhi(w.y); v[8 * j + 4] = bflo(w.z); v[8 * j + 5] = bfhi(w.z); v[8 * j + 6] = bflo(w.w); v[8 * j + 7] = bfhi(w.w); }
}
__device__ __forceinline__ void row_fetch_bf16(const bf16* row, int lane, v4u (&w)[4]) {
#pragma unroll
    for (int j = 0; j < 4; ++j) w[j] = *(const v4u*)(row + 8 * lane + 512 * j);
}
__device__ __forceinline__ void row_expand_bf16(const v4u (&w)[4], float (&v)[32]) {
#pragma unroll
    for (int j = 0; j < 4; ++j) { v[8 * j + 0] = bflo(w[j].x); v[8 * j + 1] = bfhi(w[j].x); v[8 * j + 2] = bflo(w[j].y); v[8 * j + 3] = bfhi(w[j].y); v[8 * j + 4] = bflo(w[j].z); v[8 * j + 5] = bfhi(w[j].z); v[8 * j + 6] = bflo(w[j].w); v[8 * j + 7] = bfhi(w[j].w); }
}
__device__ __forceinline__ void row_store_bf16(bf16* row, int lane, const float (&v)[32]) {
#pragma unroll
    for (int j = 0; j < 4; ++j) { v4u w; w.x = pk2(v[8 * j], v[8 * j + 1]); w.y = pk2(v[8 * j + 2], v[8 * j + 3]); w.z = pk2(v[8 * j + 4], v[8 * j + 5]); w.w = pk2(v[8 * j + 6], v[8 * j + 7]); *(v4u*)(row + 8 * lane + 512 * j) = w; }
}
__device__ __forceinline__ void row_norm(float (&v)[32]) {
    float s = 0.f;
#pragma unroll
    for (int i = 0; i < 32; ++i) s += v[i];
    const float mean = wave_sum(s) * (1.f / D); float q = 0.f;
#pragma unroll
    for (int i = 0; i < 32; ++i) { v[i] -= mean; q += v[i] * v[i]; }
    const float rstd = rsqrtf(wave_sum(q) * (1.f / D) + LN_EPS);
#pragma unroll
    for (int i = 0; i < 32; ++i) v[i] *= rstd;
}
__device__ __forceinline__ void row_affine(float (&v)[32], const float* mul, const float* add, int lane, float one) {
#pragma unroll
    for (int j = 0; j < 4; ++j)
#pragma unroll
        for (int h = 0; h < 2; ++h) { const f32x4 m = *(const f32x4*)(mul + 8 * lane + 512 * j + 4 * h), a = *(const f32x4*)(add + 8 * lane + 512 * j + 4 * h);
#pragma unroll
            for (int c = 0; c < 4; ++c) v[8 * j + 4 * h + c] = v[8 * j + 4 * h + c] * (one + m[c]) + a[c]; }
}

__device__ __forceinline__ void p0_transpose_item(const float* W, int K, int N, bf16* WT, LAS float* scr, int item, int lane) {
    const int nblk = N / 32, kb = item / nblk, nb = item % nblk, k0 = 64 * kb, n0 = 32 * nb;
#pragma unroll 8
    for (int i = 0; i < 32; ++i) { const int kk = 2 * i + (lane >> 5); scr[kk * 33 + (lane & 31)] = W[(size_t)(k0 + kk) * N + n0 + (lane & 31)]; }
    LDS_WAIT(); asm volatile("" ::: "memory");
    const int c = lane & 7;
#pragma unroll
    for (int j = 0; j < 4; ++j) { const int n = (lane >> 3) + 8 * j; const LAS float* s = scr + (8 * c) * 33 + n;
        v4u o; o.x = pk2(s[0 * 33], s[1 * 33]); o.y = pk2(s[2 * 33], s[3 * 33]); o.z = pk2(s[4 * 33], s[5 * 33]); o.w = pk2(s[6 * 33], s[7 * 33]);
        *(v4u*)(WT + (size_t)(n0 + n) * K + k0 + 8 * c) = o; }
    LDS_WAIT(); asm volatile("" ::: "memory");
}

__device__ __forceinline__ void phase_prologue_a(Frame& F) {
    launder(F);
    const int tid = F.tid, lane = F.lane, wave = F.wave;
    for (int rp = 0; rp < RP(16); ++rp) {
        LAS float* sc = (LAS float*)F.lds;
        LAS float* red = sc + 4096;
        for (int i = tid; i < D; i += NT) { sc[i] = silu_f(IN_C(F)[i]); sc[D + i] = silu_f(IN_CCTX(F)[i]); }
        __syncthreads();
        for (int u = F.vcu; u < DEPTH * 96; u += F.G) {
            const int l = u / 96, cg = u % 96;
            const float* W = IN_WMOD(F) + (size_t)l * D * 12288 + cg * 128 + 2 * lane;
            const int k0 = wave * 256; float a0 = 0.f, a1 = 0.f, b0 = 0.f, b1 = 0.f;
#pragma unroll 8
            for (int kk = 0; kk < 256; ++kk) { const f32x2 w = *(const f32x2*)(W + (size_t)(k0 + kk) * 12288); const float s0 = sc[k0 + kk], s1 = sc[D + k0 + kk];
                a0 += s0 * w.x; a1 += s0 * w.y; b0 += s1 * w.x; b1 += s1 * w.y; }
            LAS float* r = red + (wave * 64 + lane) * 4; r[0] = a0; r[1] = a1; r[2] = b0; r[3] = b1;
            __syncthreads();
            if (wave == 0) { float s[4] = {0.f, 0.f, 0.f, 0.f};
#pragma unroll
                for (int w = 0; w < 8; ++w)
#pragma unroll
                    for (int c = 0; c < 4; ++c) s[c] += red[(w * 64 + lane) * 4 + c];
                const int col = cg * 128 + 2 * lane; const float* bm = IN_BMOD(F) + l * 12288 + col; float* mo = WSP(F, float, WS_MOD) + (size_t)l * 2 * 12288 + col;
                mo[0] = s[0] + bm[0]; mo[1] = s[1] + bm[1]; mo[12288] = s[2] + bm[0]; mo[12288 + 1] = s[3] + bm[1]; }
            __syncthreads();
        }
        __syncthreads();
    }
    for (int rp = 0; rp < RP(17); ++rp) {
        LAS float* scr = (LAS float*)(F.lds + wave * 16384);
        const int gw = F.vcu * NWAVES + wave, NGW = F.G * NWAVES;
        constexpr int I_IN = (D / 64) * (INW / 32), I_OUT = (D / 64) * (D / 32), I_L = I_IN + I_OUT;
        for (int it = gw; it < DEPTH * I_L; it += NGW) {
            const int l = it / I_L, r = it % I_L;
            if (r < I_IN) p0_transpose_item(IN_WIN(F) + (size_t)l * D * INW, D, INW, WSP(F, bf16, WS_WIN) + (size_t)l * INWP * D, scr, r, lane);
            else p0_transpose_item(IN_WOUT(F) + (size_t)l * D * D, D, D, WSP(F, bf16, WS_WOUT) + (size_t)l * D * D, scr, r - I_IN, lane);
        }
        const int gt = F.vcu * NT + tid, NGT = F.G * NT;
        for (int i = gt; i < DEPTH * 57344; i += NGT) { const int l = i / 57344, r = i % 57344; *(v4u*)(WSP(F, bf16, WS_WIN) + (size_t)l * INWP * D + (size_t)INW * D + (size_t)r * 8) = (v4u){0u, 0u, 0u, 0u}; }
        for (int i = gt; i < 2048; i += NGT) {
            const int pos = i >> 4, p = i & 15;
            const float invf[16] = {1.0f, 0.5623413324356079f, 0.3162277638912201f, 0.17782793939113617f, 0.10000000149011612f, 0.05623413249850273f, 0.03162277489900589f, 0.017782794311642647f,
                                    0.009999999776482582f, 0.005623413249850273f, 0.003162277629598975f, 0.0017782794311642647f, 0.0010000000474974513f, 0.000562341301701963f, 0.0003162277571391314f, 0.00017782794020604342f};
            float th_f = invf[0];
#pragma unroll
            for (int q = 1; q < 16; ++q) th_f = (p == q) ? invf[q] : th_f;
            const double th = (double)th_f, t2 = th * th;
            double cs = 1.0, sn = th, tc = 1.0, ts = th;
#pragma unroll
            for (int n = 1; n <= 10; ++n) { tc *= -t2 / (double)((2 * n - 1) * (2 * n)); ts *= -t2 / (double)((2 * n) * (2 * n + 1)); cs += tc; sn += ts; }
            double rc = 1.0, rs = 0.0, bc = cs, bs = sn;
#pragma unroll
            for (int b = 0; b < 7; ++b) { if ((pos >> b) & 1) { const double nc = rc * bc - rs * bs, ns = rc * bs + rs * bc; rc = nc; rs = ns; } const double nb = bc * bc - bs * bs, nbs = 2.0 * bc * bs; bc = nb; bs = nbs; }
            WSP(F, float, WS_ROPE)[i] = (float)rc; WSP(F, float, WS_ROPE)[2048 + i] = (float)rs;
        }
        __syncthreads();
    }
    for (int rp = 0; rp < RP(18); ++rp) {
        const int gw = F.vcu * NWAVES + wave, NGW = F.G * NWAVES;
        for (int r = gw; r < 2 * DEPTH * NEXP; r += NGW) {
            const bool isv = r >= DEPTH * NEXP; const int rr = isv ? r - DEPTH * NEXP : r;
            const float* src = (isv ? IN_PV(F) : IN_PU(F)) + (size_t)rr * D;
            float v[32]; row_load_f32(src, lane, v);
            float mx = 0.f;
#pragma unroll
            for (int i = 0; i < 32; ++i) mx = fmaxf(mx, fabsf(v[i]));
#pragma unroll
            for (int o = 1; o < 64; o <<= 1) mx = fmaxf(mx, __shfl_xor(mx, o));
            const float sc = mx > 0.f ? 240.f / mx : 0.f;
            unsigned char* dst = WSP(F, unsigned char, isv ? WS_PV : WS_PU) + (size_t)rr * D + 16 * lane;
#pragma unroll
            for (int hf = 0; hf < 2; ++hf) { v4u o;
#pragma unroll
                for (int w = 0; w < 4; ++w) { const int b = 8 * (2 * hf + (w >> 1)) + 4 * (w & 1); int p = 0;
                    p = __builtin_amdgcn_cvt_pk_fp8_f32(v[b] * sc, v[b + 1] * sc, p, false); p = __builtin_amdgcn_cvt_pk_fp8_f32(v[b + 2] * sc, v[b + 3] * sc, p, true); o[w] = (unsigned)p; }
                *(v4u*)(dst + 1024 * hf) = o; }
            if (lane == 0) WSP(F, float, WS_SCU)[2 * rr + (isv ? 1 : 0)] = mx * (1.f / 240.f);
        }
    }
    for (int rp = 0; rp < RP(19); ++rp) {
        const int gw = F.vcu * NWAVES + wave, NGW = F.G * NWAVES, fr = lane & 15, fq = lane >> 4;
        for (int task = gw; task < DEPTH * 16 * 4 * 32; task += NGW) {
            const int l = task >> 11, hp = (task >> 7) & 15, mt = (task >> 5) & 3, nt = task & 31;
            const float* wq = IN_WQ(F) + (size_t)l * D * D + (size_t)(64 * nt + fr) * D + hp * 128 + 8 * fq;
            const float* sk = IN_SUBK(F) + (((size_t)l * 16 + hp) * 128 + 32 * mt + fr) * 128 + 8 * fq;
            f32x4 acc[4][2];
#pragma unroll
            for (int n = 0; n < 4; ++n)
#pragma unroll
                for (int m = 0; m < 2; ++m) acc[n][m] = (f32x4){0.f, 0.f, 0.f, 0.f};
#pragma unroll 1
            for (int ks = 0; ks < 4; ++ks) {
                f32x4 ar[4][2], br[2][2];
#pragma unroll
                for (int n = 0; n < 4; ++n) { ar[n][0] = *(const f32x4*)(wq + (size_t)(16 * n) * D + 32 * ks); ar[n][1] = *(const f32x4*)(wq + (size_t)(16 * n) * D + 32 * ks + 4); }
#pragma unroll
                for (int m = 0; m < 2; ++m) { br[m][0] = *(const f32x4*)(sk + (16 * m) * 128 + 32 * ks); br[m][1] = *(const f32x4*)(sk + (16 * m) * 128 + 32 * ks + 4); }
                bf16x8v ah[4], al[4], bh[2], bl[2];
#pragma unroll
                for (int n = 0; n < 4; ++n)
#pragma unroll
                    for (int e = 0; e < 8; ++e) { const float x = ar[n][e >> 2][e & 3]; const unsigned hb = f2bf(x); ah[n][e] = (short)hb; al[n][e] = (short)f2bf(x - __builtin_bit_cast(float, hb << 16)); }
#pragma unroll
                for (int m = 0; m < 2; ++m)
#pragma unroll
                    for (int e = 0; e < 8; ++e) { const float x = br[m][e >> 2][e & 3]; const unsigned hb = f2bf(x); bh[m][e] = (short)hb; bl[m][e] = (short)f2bf(x - __builtin_bit_cast(float, hb << 16)); }
#pragma unroll
                for (int n = 0; n < 4; ++n)
#pragma unroll
                    for (int m = 0; m < 2; ++m) { acc[n][m] = __builtin_amdgcn_mfma_f32_16x16x32_bf16(ah[n], bh[m], acc[n][m], 0, 0, 0);
                        acc[n][m] = __builtin_amdgcn_mfma_f32_16x16x32_bf16(ah[n], bl[m], acc[n][m], 0, 0, 0); acc[n][m] = __builtin_amdgcn_mfma_f32_16x16x32_bf16(al[n], bh[m], acc[n][m], 0, 0, 0); }
            }
#pragma unroll
            for (int n = 0; n < 4; ++n)
#pragma unroll
                for (int m = 0; m < 2; ++m) { bf16* dst = WSP(F, bf16, WS_WP) + ((size_t)l * D + hp * 128 + 32 * mt + 16 * m + fr) * D + 64 * nt + 16 * n + 4 * fq;
                    *(v2u*)dst = (v2u){pk2(acc[n][m][0], acc[n][m][1]), pk2(acc[n][m][2], acc[n][m][3])}; }
        }
    }
}

__device__ __forceinline__ void phase_ln0(Frame& F) {
    launder(F);
    const int gw = F.vcu * NWAVES + F.wave, NGW = F.G * NWAVES, lane = F.lane;
    for (int m = gw; m < MT; m += NGW) {
        const float* src = (m < LC) ? IN_CTX(F) + (size_t)m * D : IN_X(F) + (size_t)(m - LC) * D;
        const float* mod = WSP(F, float, WS_MOD) + (m < LC ? 12288 : 0);
        float v[32]; row_load_f32(src, lane, v);
        row_store_bf16(WSP(F, bf16, WS_X) + (size_t)m * D, lane, v);
        row_norm(v); row_affine(v, mod + D, mod, lane, 1.f);
        row_store_bf16(WSP(F, bf16, WS_H) + (size_t)m * D, lane, v);
    }
}

__device__ __forceinline__ void phase_qknorm(Frame& F, int l) {
    launder(F);
    const int heavy = (NCH * 4 > 2 * F.G && NCH * 4 - 2 * F.G < F.G / 2) ? NCH * 4 - 2 * F.G : 0;
    if (F.vcu < heavy) return;
    const int gw = (F.vcu - heavy) * NWAVES + F.wave, NGW = (F.G - heavy) * NWAVES, lane = F.lane, p = lane & 31, hsel = lane >> 5;
    const float* rc = WSP(F, float, WS_ROPE); const float* rsn = rc + 2048;
    const bf16* P = WSP(F, bf16, WS_P);
    for (int m = gw; m < MT; m += NGW) {
#pragma unroll
        for (int it = 0; it < 5; ++it) {
            const int hv = 2 * it + hsel;
            const int col = (hv < 8) ? (C_CQ + hv * 64) : (C_CK + (hv - 8) * 64);
            const unsigned w = *(const unsigned*)(P + (size_t)m * INWP + col + 2 * p);
            float x0 = bflo(w), x1 = bfhi(w);
            float ss = x0 * x0 + x1 * x1;
#pragma unroll
            for (int o = 1; o < 32; o <<= 1) ss += __shfl_xor(ss, o);
            const float rstd = rsqrtf(ss * (1.f / 64.f) + LN_EPS);
            const float* nw = (hv < 8 ? IN_QNW(F) : IN_KNW(F)) + l * 64 + 2 * p;
            x0 = x0 * rstd * nw[0]; x1 = x1 * rstd * nw[1];
            if (m >= LC) { const int t = m - LC, pos = (p < 16) ? (t >> 6) : (t & 63); const float c = rc[pos * 16 + (p & 15)], s = rsn[pos * 16 + (p & 15)];
                const float y0 = x0 * c - x1 * s, y1 = x0 * s + x1 * c; x0 = y0; x1 = y1; }
            if (hv < 8) *(unsigned*)(WSP(F, bf16, WS_QC) + (size_t)m * 512 + hv * 64 + 2 * p) = pk2(x0 * attn_body::C2, x1 * attn_body::C2);
            else *(unsigned*)(WSP(F, bf16, WS_KC) + (size_t)m * 128 + (hv - 8) * 64 + 2 * p) = pk2(x0, x1);
        }
        if (lane < 16) *(v4u*)(WSP(F, bf16, WS_VC) + (size_t)m * 128 + lane * 8) = *(const v4u*)(P + (size_t)m * INWP + C_CV + lane * 8);
    }
}

constexpr int GL_BSTR = 130, GL_QSTR = 136, GL_TSTR = 72;
constexpr int GL_OFF_BB = 33280, GL_OFF_QX = 66560, GL_OFF_KX = 83968, GL_OFF_KET = 101376;
__device__ __forceinline__ int crow32(int r, int hi) { return (r & 3) + 8 * (r >> 2) + 4 * hi; }
__device__ __forceinline__ void phase_gla_chunk(Frame& F, int l) {
    launder(F);
    const int tid = F.tid, lane = F.lane, wave = F.wave;
    LAS float* BF = (LAS float*)F.lds; LAS float* BB = (LAS float*)(F.lds + GL_OFF_BB);
    LAS bf16* VT = (LAS bf16*)F.lds;
    LAS bf16* QX = (LAS bf16*)(F.lds + GL_OFF_QX); LAS bf16* KX = (LAS bf16*)(F.lds + GL_OFF_KX);
    LAS float* LR = (LAS float*)(F.lds + GL_OFF_QX); LAS bf16* AC = (LAS bf16*)(F.lds + GL_OFF_QX);
    LAS bf16* KET = (LAS bf16*)(F.lds + GL_OFF_KET);
    const bf16* P = WSP(F, bf16, WS_P);
    for (int u = F.vcu; u < NCH * 4; u += F.G) {
        const int g = u >> 2, hh = u & 3, r0 = g * 64;
        unsigned short lrw[4];
#pragma unroll
        for (int c = 0; c < 4; ++c) { const int i = tid + c * NT; lrw[c] = P[(size_t)(r0 + (i >> 5)) * INWP + C_GLR + (i & 31)]; }
        const v4u kq0 = *(const v4u*)(P + (size_t)(r0 + lane) * INWP + C_GK + hh * 128 + wave * 16), kq1 = *(const v4u*)(P + (size_t)(r0 + lane) * INWP + C_GK + hh * 128 + wave * 16 + 8);
        unsigned qw8[8], kw8[8];
#pragma unroll
        for (int it = 0; it < 8; ++it) { const int i = it * 8 + wave; qw8[it] = *(const unsigned*)(P + (size_t)(r0 + i) * INWP + C_GQ + hh * 128 + 2 * lane); kw8[it] = *(const unsigned*)(P + (size_t)(r0 + i) * INWP + C_GK + hh * 128 + 2 * lane); }
        v4u vw4[4];
#pragma unroll
        for (int c4 = 0; c4 < 4; ++c4) vw4[c4] = *(const v4u*)(P + (size_t)(r0 + lane) * INWP + C_GV + hh * 256 + wave * 32 + 8 * c4);
#pragma unroll
        for (int c = 0; c < 4; ++c) LR[tid + c * NT] = bf1(lrw[c]);
        __syncthreads();
        { const int d = tid & 127, ig = tid >> 7;
          const float* Wf = IN_GGW(F) + ((size_t)l * 2 + 0) * 16 * 512 + hh * 128 + d; const float* Wb = IN_GGW(F) + ((size_t)l * 2 + 1) * 16 * 512 + hh * 128 + d;
          float wf[16], wb[16];
#pragma unroll
          for (int r = 0; r < 16; ++r) { wf[r] = Wf[r * 512]; wb[r] = Wb[r * 512]; }
          const float bfv = IN_GGB(F)[((size_t)l * 2 + 0) * 512 + hh * 128 + d], bbv = IN_GGB(F)[((size_t)l * 2 + 1) * 512 + hh * 128 + d];
          for (int i = ig * 16; i < ig * 16 + 16; ++i) { float zf = bfv, zb = bbv;
#pragma unroll
              for (int r = 0; r < 16; ++r) { zf += LR[i * 32 + r] * wf[r]; zb += LR[i * 32 + 16 + r] * wb[r]; }
              BF[i * GL_BSTR + d] = logsigmoid_f(zf) * (1.f / 16.f); BB[i * GL_BSTR + d] = logsigmoid_f(zb) * (1.f / 16.f); } }
        __syncthreads();
        if (tid < 128) { float sacc = 0.f;
#pragma unroll 8
            for (int i = 0; i < 64; ++i) { sacc += BF[i * GL_BSTR + tid]; BF[i * GL_BSTR + tid] = sacc; } }
        else if (tid < 256) { const int d = tid - 128; float sacc = 0.f;
#pragma unroll 8
            for (int i = 63; i >= 0; --i) { sacc += BB[i * GL_BSTR + d]; BB[i * GL_BSTR + d] = sacc; } }
        __syncthreads();
        { const int j = lane, d0 = wave * 16;
          const unsigned kw[8] = {kq0.x, kq0.y, kq0.z, kq0.w, kq1.x, kq1.y, kq1.z, kq1.w};
#pragma unroll
          for (int c = 0; c < 16; ++c) { const int d = d0 + c; const float kv = (c & 1) ? bfhi(kw[c >> 1]) : bflo(kw[c >> 1]);
              const float bl = BF[63 * GL_BSTR + d], b0 = BB[d];
              KET[(0 * 128 + d) * GL_TSTR + j] = (bf16)f2bf(kv * __expf(bl - BF[j * GL_BSTR + d]));
              KET[(1 * 128 + d) * GL_TSTR + j] = (bf16)f2bf(kv * __expf(b0 - BB[j * GL_BSTR + d]));
              if (j == 0) { WSP(F, float, WS_DEC)[((size_t)(0 * NCH + g) * 4 + hh) * 128 + d] = __expf(bl); WSP(F, float, WS_DEC)[((size_t)(1 * NCH + g) * 4 + hh) * 128 + d] = __expf(b0); } } }
        const int ti = wave >> 1, tjb = wave & 1, fr = lane & 15, fq = lane >> 4;
        f32x4 asum[2]; asum[0] = (f32x4){0.f, 0.f, 0.f, 0.f}; asum[1] = asum[0];
#pragma unroll 1
        for (int dir = 0; dir < 2; ++dir) {
            LAS float* BX = dir ? BB : BF; bf16* QTg = WSP(F, bf16, dir ? WS_QTB : WS_QTF);
            __syncthreads();
#pragma unroll
            for (int it = 0; it < 8; ++it) { const int i = it * 8 + wave, d = 2 * lane;
                const unsigned qw = qw8[it], kw = kw8[it];
                const f32x2 b = *(LAS f32x2*)(BX + i * GL_BSTR + d);
                const unsigned qt = pk2(bflo(qw) * 0.08838834764831845f * __expf(b.x), bfhi(qw) * 0.08838834764831845f * __expf(b.y)), kt = pk2(bflo(kw) * __expf(-b.x), bfhi(kw) * __expf(-b.y));
                *(LAS unsigned*)(QX + i * GL_QSTR + d) = qt; *(LAS unsigned*)(KX + i * GL_QSTR + d) = kt;
                *(unsigned*)(QTg + ((((size_t)((r0 + i) >> 5) * 4 + hh) * 8 + (lane >> 3)) * 64 + ((r0 + i) & 31) + 32 * ((lane >> 2) & 1)) * 8 + 2 * (lane & 3)) = qt; }
            __syncthreads();
            f32x4 acc[2]; acc[0] = (f32x4){0.f, 0.f, 0.f, 0.f}; acc[1] = acc[0];
#pragma unroll
            for (int ks = 0; ks < 4; ++ks) { const bf16x8v a = *(const LAS bf16x8v*)(QX + (16 * ti + fr) * GL_QSTR + 32 * ks + 8 * fq);
#pragma unroll
                for (int t = 0; t < 2; ++t) { const bf16x8v b = *(const LAS bf16x8v*)(KX + (16 * (2 * tjb + t) + fr) * GL_QSTR + 32 * ks + 8 * fq);
                    acc[t] = __builtin_amdgcn_mfma_f32_16x16x32_bf16(a, b, acc[t], 0, 0, 0); } }
#pragma unroll
            for (int t = 0; t < 2; ++t)
#pragma unroll
                for (int r = 0; r < 4; ++r) { const int i = 16 * ti + 4 * fq + r, j = 16 * (2 * tjb + t) + fr; const bool keep = dir ? (j >= i) : (j <= i); asum[t][r] += keep ? acc[t][r] : 0.f; }
        }
        __syncthreads();
#pragma unroll
        for (int t = 0; t < 2; ++t)
#pragma unroll
            for (int r = 0; r < 4; ++r) AC[(16 * ti + 4 * fq + r) * GL_TSTR + 16 * (2 * tjb + t) + fr] = (bf16)f2bf(asum[t][r]);
        { const int j = lane, v0 = wave * 32;
#pragma unroll
          for (int c4 = 0; c4 < 4; ++c4) { const v4u w = vw4[c4]; const unsigned ww[4] = {w.x, w.y, w.z, w.w};
#pragma unroll
              for (int c = 0; c < 8; ++c) VT[(v0 + 8 * c4 + c) * GL_TSTR + j] = (bf16)((c & 1) ? (ww[c >> 1] >> 16) : (ww[c >> 1] & 0xffffu)); } }
        __syncthreads();
        { const int r32 = lane & 31, hi = lane >> 5; bf16x8v vt[4];
#pragma unroll
          for (int ks = 0; ks < 4; ++ks) vt[ks] = *(const LAS bf16x8v*)(VT + (32 * wave + r32) * GL_TSTR + 16 * ks + 8 * hi);
#pragma unroll
          for (int t = 0; t < 2; ++t) { f32x16v o;
#pragma unroll
              for (int r = 0; r < 16; ++r) o[r] = 0.f;
#pragma unroll
              for (int ks = 0; ks < 4; ++ks) { const bf16x8v a = *(const LAS bf16x8v*)(AC + (32 * t + r32) * GL_TSTR + 16 * ks + 8 * hi); o = __builtin_amdgcn_mfma_f32_32x32x16_bf16(a, vt[ks], o, 0, 0, 0); }
              unsigned* oi = WSP(F, unsigned, WS_OI) + ((((size_t)(g * 4 + hh) * 2 + t) * 8 + wave) * 8) * 64 + lane;
#pragma unroll
              for (int i = 0; i < 8; ++i) oi[i * 64] = pk2(o[2 * i], o[2 * i + 1]); }
#pragma unroll 1
          for (int dir = 0; dir < 2; ++dir)
#pragma unroll
              for (int td = 0; td < 4; ++td) { f32x16v o;
#pragma unroll
                  for (int r = 0; r < 16; ++r) o[r] = 0.f;
#pragma unroll
                  for (int ks = 0; ks < 4; ++ks) { const bf16x8v b = *(const LAS bf16x8v*)(KET + (dir * 128 + 32 * td + r32) * GL_TSTR + 16 * ks + 8 * hi); o = __builtin_amdgcn_mfma_f32_32x32x16_bf16(b, vt[ks], o, 0, 0, 0); }
                  bf16* up = WSP(F, bf16, WS_UPD) + ((size_t)(dir * NCH + g) * 4 + hh) * 32768 + (size_t)((2 * wave + (r32 >> 4)) * 16 + 4 * td) * 128 + (r32 & 15) * 8 + 4 * hi;
#pragma unroll
                  for (int rq = 0; rq < 4; ++rq) *(v2u*)(up + rq * 128) = (v2u){pk2(o[4 * rq], o[4 * rq + 1]), pk2(o[4 * rq + 2], o[4 * rq + 3])}; } }
        __syncthreads();
    }
}

__device__ __forceinline__ void phase_attn(Frame& F, int l) {
    launder(F);
    const int tid = F.tid;
    for (int rp = 0; rp < RP(5); ++rp) {
        const int gt = F.vcu * NT + tid, NGT = F.G * NT;
        for (int e = gt; e < 2 * 4 * 256 * 64; e += NGT) {
            const int d2 = 8 * ((e >> 6) & 15) + 2 * (e & 3), v = 16 * ((e >> 10) & 15) + ((e >> 2) & 15), hh = (e >> 14) & 3, dir = e >> 16;
            f32x2 S = (f32x2){0.f, 0.f};
            const size_t frag = ((size_t)((v >> 5) * 8 + (d2 >> 4)) * 64 + (v & 31) + 32 * ((d2 >> 3) & 1)) * 8 + (d2 & 7);
#pragma unroll 12
            for (int s = 0; s < NCH; ++s) {
                const int g = dir == 0 ? s : (s < 4 ? 3 - s : NCH + 3 - s);
                const size_t hb = (size_t)(dir * NCH + g) * 4 + hh;
                *(unsigned*)(WSP(F, bf16, WS_SPREV) + hb * 32768 + frag) = pk2(S.x, S.y);
                const f32x2 dc = *(const f32x2*)(WSP(F, float, WS_DEC) + hb * 128 + d2); const unsigned uw = *(const unsigned*)(WSP(F, bf16, WS_UPD) + hb * 32768 + (size_t)((v >> 4) * 16 + (d2 >> 3)) * 128 + (v & 15) * 8 + (d2 & 7)); const f32x2 up = (f32x2){bflo(uw), bfhi(uw)};
                S = S * dc + up;
            }
        }
    }
    typedef attn_body::bf16 abf;
    const bf16* P = WSP(F, bf16, WS_P); bf16* MIX = WSP(F, bf16, WS_MIX);
    for (int rp = 0; rp < RP(12); ++rp) {
        for (int u = F.vcu; u < 256; u += F.G) {
            const int h = u >> 5, qb = u & 31; const size_t r0 = (size_t)LC + (size_t)qb * 256;
            attn_body::attn_unit<8, 0>((const abf*)(WSP(F, bf16, WS_QC) + r0 * 512 + h * 64), 512, (const abf*)(WSP(F, bf16, WS_KC) + (h >> 2) * 64), 128, (const abf*)(WSP(F, bf16, WS_VC) + (h >> 2) * 64), 128,
                                       (abf*)(MIX + r0 * D + 1536 + h * 64), D, NCH, F.ldsg, 0, (const LAS float*)F.lds);
        }
    }
    for (int rp = 0; rp < RP(13); ++rp) {
        for (int u = F.vcu; u < 256; u += F.G) {
            const int h = u >> 5, ir0 = (u & 31) * 4; const size_t r0 = (size_t)LC + (size_t)ir0 * 64;
            { LAS float* tab = (LAS float*)(F.lds + 98304); const float* rpb = IN_RPB(F) + ((size_t)l * 8 + h) * 465; for (int i = F.tid; i < 465; i += NT) tab[i] = rpb[i]; }
            const int band0 = min(max(ir0 - 4, 0), 120), nb = min(max(ir0 - 1, 0), 120) + 8 - band0, ntile = 4 + nb + (nb & 1);
            attn_body::attn_unit<8, 1>((const abf*)(P + r0 * INWP + C_NAQ + h * 64), INWP, (const abf*)(P + C_NAK + h * 64), INWP, (const abf*)(P + C_NAV + h * 64), INWP,
                                       (abf*)(MIX + r0 * D + h * 64), D, ntile, F.ldsg, ir0, (const LAS float*)(F.lds + 98304));
        }
    }
    if (l < DEPTH - 1) for (int rp = 0; rp < RP(14); ++rp) {
        for (int u = F.vcu; u < 16; u += F.G) {
            const int h = u & 7;
            if (u < 8) attn_body::attn_unit<8, 2>((const abf*)(P + C_NAQ + h * 64), INWP, (const abf*)(P + C_NAK + h * 64), INWP, (const abf*)(P + C_NAV + h * 64), INWP, (abf*)(MIX + h * 64), D, 4, F.ldsg, 0, (const LAS float*)F.lds);
            else attn_body::attn_unit<8, 0>((const abf*)(WSP(F, bf16, WS_QC) + h * 64), 512, (const abf*)(WSP(F, bf16, WS_KC) + (h >> 2) * 64), 128, (const abf*)(WSP(F, bf16, WS_VC) + (h >> 2) * 64), 128, (abf*)(MIX + 1536 + h * 64), D, 4, F.ldsg, 0, (const LAS float*)F.lds);
        }
    }
    __syncthreads();
}

__device__ __forceinline__ void phase_gla_out(Frame& F, int l) {
    launder(F);
    const int lane = F.lane, wave = F.wave, r32 = lane & 31, hi = lane >> 5;
    LAS float* PART = (LAS float*)F.lds;
    const int g_lo = (l < DEPTH - 1) ? 0 : 4;
    for (int u = F.vcu + g_lo * 4; u < NCH * 4; u += F.G) {
        const int g = u >> 2, hh = u & 3, r0 = g * 64, v = 32 * wave + r32;
        f32x16v o[2];
#pragma unroll
        for (int t = 0; t < 2; ++t) { const unsigned* oi = WSP(F, unsigned, WS_OI) + ((((size_t)(g * 4 + hh) * 2 + t) * 8 + wave) * 8) * 64 + lane;
#pragma unroll
            for (int i = 0; i < 8; ++i) { const unsigned w = oi[i * 64]; o[t][2 * i] = bflo(w); o[t][2 * i + 1] = bfhi(w); } }
        bf16x8v b[2][8], a[2][8];
#pragma unroll
        for (int dir = 0; dir < 2; ++dir) { const bf16* sp = WSP(F, bf16, WS_SPREV) + ((size_t)(dir * NCH + g) * 4 + hh) * 32768 + (size_t)wave * 4096 + lane * 8;
#pragma unroll
            for (int ks = 0; ks < 8; ++ks) b[dir][ks] = *(const bf16x8v*)(sp + 512 * ks); }
#pragma unroll
        for (int dir = 0; dir < 2; ++dir) {
            const bf16* qt = WSP(F, bf16, dir ? WS_QTB : WS_QTF) + ((size_t)(r0 >> 5) * 4 + hh) * 4096 + lane * 8;
#pragma unroll
            for (int t = 0; t < 2; ++t)
#pragma unroll
                for (int ks = 0; ks < 8; ++ks) a[t][ks] = *(const bf16x8v*)(qt + (size_t)t * 16384 + 512 * ks);
#pragma unroll
            for (int t = 0; t < 2; ++t)
#pragma unroll
                for (int ks = 0; ks < 8; ++ks) o[t] = __builtin_amdgcn_mfma_f32_32x32x16_bf16(a[t][ks], b[dir][ks], o[t], 0, 0, 0);
        }
        bf16 gtw[2][16];
#pragma unroll
        for (int t = 0; t < 2; ++t)
#pragma unroll
            for (int r = 0; r < 16; ++r) gtw[t][r] = WSP(F, bf16, WS_P)[(size_t)(r0 + 32 * t + crow32(r, hi)) * INWP + C_GG + hh * 256 + v];
#pragma unroll
        for (int t = 0; t < 2; ++t)
#pragma unroll
            for (int r = 0; r < 16; ++r) { float sq = o[t][r] * o[t][r];
#pragma unroll
                for (int off = 1; off < 32; off <<= 1) sq += __shfl_xor(sq, off);
                if (r32 == 0) PART[(32 * t + crow32(r, hi)) * 8 + wave] = sq; }
        __syncthreads();
        const float nw = IN_GNW(F)[l * 256 + v];
#pragma unroll
        for (int t = 0; t < 2; ++t)
#pragma unroll
            for (int r = 0; r < 16; ++r) { const int row = 32 * t + crow32(r, hi); const f32x4 p0 = *(const LAS f32x4*)(PART + row * 8), p1 = *(const LAS f32x4*)(PART + row * 8 + 4);
                const float ss = (p0[0] + p0[1]) + (p0[2] + p0[3]) + (p1[0] + p1[1]) + (p1[2] + p1[3]);
                const float rstd = rsqrtf(ss * (1.f / 256.f) + LN_EPS); const float gt = bf1(gtw[t][r]);
                WSP(F, bf16, WS_MIX)[(size_t)(r0 + row) * D + 512 + hh * 256 + v] = (bf16)f2bf(o[t][r] * rstd * nw * silu_f(gt)); }
        __syncthreads();
    }
}

__device__ __forceinline__ void phase_ln1(Frame& F, int l) {
    launder(F);
    const int gw = F.vcu * NWAVES + F.wave, NGW = F.G * NWAVES, lane = F.lane;
    const int m_lo = (l < DEPTH - 1) ? 0 : LC;
    v4u nz[4];
    { const int m = (m_lo + gw < MT) ? m_lo + gw : MT - 1; row_fetch_bf16(WSP(F, bf16, WS_Z) + (size_t)m * D, lane, nz); }
    for (int m = m_lo + gw; m < MT; m += NGW) {
        const float* mod = WSP(F, float, WS_MOD) + (size_t)l * 2 * 12288 + (m < LC ? 12288 : 0);
        float v[32]; row_expand_bf16(nz, v);
        { const int mn = (m + NGW < MT) ? m + NGW : m; row_fetch_bf16(WSP(F, bf16, WS_Z) + (size_t)mn * D, lane, nz); }
        row_norm(v); row_affine(v, IN_LN1G(F) + l * D, IN_LN1B(F) + l * D, lane, 0.f);
        row_store_bf16(WSP(F, bf16, WS_X) + (size_t)m * D, lane, v);
        row_norm(v); row_affine(v, mod + 4 * D, mod + 3 * D, lane, 1.f);
        row_store_bf16(WSP(F, bf16, WS_H) + (size_t)m * D, lane, v);
    }
}

__device__ __forceinline__ void tk_merge16(float (&a)[16]) {
#pragma unroll
    for (int j = 8; j > 0; j >>= 1)
#pragma unroll
        for (int i = 0; i < 16; ++i) { const int p = i ^ j; if (p > i) { const float hi = fmaxf(a[i], a[p]), lo = fminf(a[i], a[p]); a[i] = hi; a[p] = lo; } }
}
__device__ __forceinline__ void tk_sort16(float (&a)[16]) {
#pragma unroll
    for (int k = 2; k <= 16; k <<= 1)
#pragma unroll
        for (int j = k >> 1; j > 0; j >>= 1)
#pragma unroll
            for (int i = 0; i < 16; ++i) { const int p = i ^ j; if (p > i) { const float hi = fmaxf(a[i], a[p]), lo = fminf(a[i], a[p]); const bool dsc = ((i & k) == 0); a[i] = dsc ? hi : lo; a[p] = dsc ? lo : hi; } }
}
__device__ __forceinline__ void tk_top16of128(const float* sp, float (&run)[16]) {
    float nx[16];
#pragma unroll
    for (int i = 0; i < 16; ++i) nx[i] = sp[(size_t)i * MT];
#pragma unroll 1
    for (int c = 0; c < 8; ++c) {
        float ch[16];
#pragma unroll
        for (int i = 0; i < 16; ++i) ch[i] = __builtin_bit_cast(float, (__builtin_bit_cast(unsigned, nx[i]) & ~127u) | (unsigned)(c * 16 + i));
        if (c < 7) {
#pragma unroll
            for (int i = 0; i < 16; ++i) nx[i] = sp[(size_t)((c + 1) * 16 + i) * MT]; }
        tk_sort16(ch);
        if (c == 0) {
#pragma unroll
            for (int i = 0; i < 16; ++i) run[i] = ch[i];
        } else {
#pragma unroll
            for (int i = 0; i < 16; ++i) run[i] = fmaxf(run[i], ch[15 - i]);
            tk_merge16(run);
        }
    }
}
__device__ __forceinline__ void phase_topk(Frame& F, int l) {
    launder(F);
    const int lane = F.lane, h = F.wave, tid = F.tid;
    LAS float* TS = (LAS float*)F.lds;
    const int u_lo = (l < DEPTH - 1) ? 0 : 4;
    for (int u = F.vcu + u_lo; u < NCH; u += F.G) {
        const int tok = u * 64 + lane;
        float t1[16], t2[16];
        tk_top16of128(WSP(F, float, WS_ST) + (size_t)((h * 2 + 0) * 128) * MT + tok, t1);
        tk_top16of128(WSP(F, float, WS_ST) + (size_t)((h * 2 + 1) * 128) * MT + tok, t2);
#pragma unroll
        for (int i = 0; i < 16; ++i) { TS[i * NT + tid] = t1[i]; TS[(16 + i) * NT + tid] = t2[i]; }
        float tv[16];
#define TK_CAND(i_, j_) __builtin_bit_cast(float, (__builtin_bit_cast(unsigned, t1[i_] + t2[j_]) & ~255u) | (unsigned)((i_) * 16 + (j_)))
#pragma unroll
        for (int j = 0; j < 16; ++j) tv[j] = TK_CAND(0, j);
#pragma unroll
        for (int i = 1; i < 16; ++i) {
            const int len = 16 / (i + 1);
            if (len >= 3) {
#pragma unroll
                for (int k = 0; k < 16; ++k) if (15 - k < len) tv[k] = fmaxf(tv[k], TK_CAND(i, 15 - k));
                tk_merge16(tv);
            } else {
#pragma unroll
                for (int j = 0; j < len; ++j) { float v = TK_CAND(i, j);
#pragma unroll
                    for (int s2 = 0; s2 < 16; ++s2) { const float hi = fmaxf(tv[s2], v); v = fminf(tv[s2], v); tv[s2] = hi; } }
            }
        }
#undef TK_CAND
        LDS_WAIT();
        float sv[16]; int ti[16];
#pragma unroll
        for (int s2 = 0; s2 < 16; ++s2) { const unsigned code = __builtin_bit_cast(unsigned, tv[s2]) & 255u; const float a = TS[(code >> 4) * NT + tid], b = TS[(16 + (code & 15u)) * NT + tid];
            sv[s2] = a + b; ti[s2] = (int)((__builtin_bit_cast(unsigned, a) & 127u) * 128u + (__builtin_bit_cast(unsigned, b) & 127u)); }
        float mx = sv[0];
#pragma unroll
        for (int s2 = 1; s2 < 16; ++s2) mx = fmaxf(mx, sv[s2]);
        float e[16], sum = 0.f;
#pragma unroll
        for (int s2 = 0; s2 < 16; ++s2) { e[s2] = __expf(sv[s2] - mx); sum += e[s2]; }
        const float inv = 1.f / sum;
        int* ip = WSP(F, int, WS_IDX) + (size_t)tok * 128 + h * 16; float* gp = WSP(F, float, WS_GATE) + (size_t)tok * 128 + h * 16;
#pragma unroll
        for (int s4 = 0; s4 < 4; ++s4) { *(v4u*)(ip + 4 * s4) = (v4u){(unsigned)ti[4 * s4], (unsigned)ti[4 * s4 + 1], (unsigned)ti[4 * s4 + 2], (unsigned)ti[4 * s4 + 3]};
            *(f32x4*)(gp + 4 * s4) = (f32x4){e[4 * s4] * inv, e[4 * s4 + 1] * inv, e[4 * s4 + 2] * inv, e[4 * s4 + 3] * inv}; }
        LDS_WAIT();
    }
}

template <int CTRL> __device__ __forceinline__ float dpp_f(float v) { return __builtin_bit_cast(float, __builtin_amdgcn_update_dpp(0, __builtin_bit_cast(int, v), CTRL, 0xF, 0xF, true)); }
__device__ __forceinline__ void phase_peer(Frame& F, int l) {
    launder(F);
    const int lane = F.lane, r8 = lane >> 3, l8 = lane & 7;
    const int gsz = F.G >> 3, grp = F.vcu / gsz, gwv = (F.vcu % gsz) * NWAVES + F.wave, gnw = gsz * NWAVES;
    const unsigned char* U = WSP(F, unsigned char, WS_PU) + (size_t)l * NEXP * D;
    const int* IDX = WSP(F, int, WS_IDX); const bf16* H = WSP(F, bf16, WS_H);
    LAS int* ET = (LAS int*)(F.lds + F.wave * 1024);
    const int m_lo = (l < DEPTH - 1) ? 0 : LC;
    const int wpos = ((lane & 7) * 16 + (lane >> 3));
#pragma unroll 1
    for (int sub = 0; sub < 2; ++sub) {
        const int s = 8 * sub + grp;
        const unsigned coff = 128u * (unsigned)s + 16u * (unsigned)l8;
        const int o0 = 8 * (8 * (s & 7) + l8) + 1024 * (s >> 3);
        unsigned* part = WSP(F, unsigned, WS_PART) + (size_t)s * MT * 64;
        int m = m_lo + gwv;
        int eL = IDX[(size_t)m * 128 + lane], eH = IDX[(size_t)m * 128 + 64 + lane];
#pragma unroll 1
        for (; m < MT; m += gnw) {
            ET[wpos] = eL; ET[wpos + 8] = eH;
            const v4u hw0 = *(const v4u*)(H + (size_t)m * D + o0), hw1 = *(const v4u*)(H + (size_t)m * D + o0 + 512);
            LDS_WAIT();
            int e16[16];
#pragma unroll
            for (int q = 0; q < 16; ++q) e16[q] = ET[r8 * 16 + q];
            v4u r[16];
#pragma unroll
            for (int j = 0; j < 16; ++j) r[j] = *(const v4u*)(U + ((unsigned)e16[j] * 2048u + coff));
            { const int mn = (m + gnw < MT) ? m + gnw : m; eL = IDX[(size_t)mn * 128 + lane]; eH = IDX[(size_t)mn * 128 + 64 + lane]; }
            f32x2 h[8];
            h[0] = (f32x2){bflo(hw0.x), bfhi(hw0.x)}; h[1] = (f32x2){bflo(hw0.y), bfhi(hw0.y)}; h[2] = (f32x2){bflo(hw0.z), bfhi(hw0.z)}; h[3] = (f32x2){bflo(hw0.w), bfhi(hw0.w)};
            h[4] = (f32x2){bflo(hw1.x), bfhi(hw1.x)}; h[5] = (f32x2){bflo(hw1.y), bfhi(hw1.y)}; h[6] = (f32x2){bflo(hw1.z), bfhi(hw1.z)}; h[7] = (f32x2){bflo(hw1.w), bfhi(hw1.w)};
            float d[16];
#pragma unroll
            for (int j = 0; j < 16; ++j) { f32x2 p = (f32x2){0.f, 0.f};
#pragma unroll
                for (int w = 0; w < 4; ++w) { const f32x2 lo = __builtin_amdgcn_cvt_pk_f32_fp8((int)r[j][w], false), hi = __builtin_amdgcn_cvt_pk_f32_fp8((int)r[j][w], true); p += lo * h[2 * w]; p += hi * h[2 * w + 1]; }
                d[j] = p.x + p.y; }
            const bool c2 = (l8 & 4) != 0, c1 = (l8 & 2) != 0, c0 = (l8 & 1) != 0;
            float e1[8], e2[4];
#pragma unroll
            for (int jj = 0; jj < 8; ++jj) { const int ja = (jj & 3) | ((jj >> 2) << 3); const float kp = c2 ? d[ja | 4] : d[ja], sd = c2 ? d[ja] : d[ja | 4]; e1[jj] = kp + dpp_f<0x141>(sd); }
#pragma unroll
            for (int y = 0; y < 4; ++y) { const int x = (y & 1) | ((y >> 1) << 2); const float kp = c1 ? e1[x | 2] : e1[x], sd = c1 ? e1[x] : e1[x | 2]; e2[y] = kp + dpp_f<0x4E>(sd); }
            const float v0 = (c0 ? e2[1] : e2[0]) + dpp_f<0xB1>(c0 ? e2[0] : e2[1]), v1 = (c0 ? e2[3] : e2[2]) + dpp_f<0xB1>(c0 ? e2[2] : e2[3]);
            part[(size_t)m * 64 + 8 * l8 + r8] = pk2(v0, v1);
            LDS_WAIT();
        }
    }
}

__device__ __forceinline__ void phase_peer_act(Frame& F, int l) {
    launder(F);
    const int gw = F.vcu * NWAVES + F.wave, NGW = F.G * NWAVES, lane = F.lane;
    const f32x2* SUV = WSP(F, f32x2, WS_SCU) + l * NEXP;
    const int m_lo = (l < DEPTH - 1) ? 0 : LC;
    for (int m0 = m_lo + gw; m0 < MT; m0 += 2 * NGW) {
        const int m1 = m0 + NGW; const bool two = m1 < MT; const int mm[2] = {m0, two ? m1 : m0};
        float dsum[2][2]; int e[2][2]; float gt[2][2];
#pragma unroll
        for (int t = 0; t < 2; ++t)
#pragma unroll
            for (int hlf = 0; hlf < 2; ++hlf) { const int k = 64 * hlf + lane; e[t][hlf] = WSP(F, int, WS_IDX)[(size_t)mm[t] * 128 + k]; gt[t][hlf] = WSP(F, float, WS_GATE)[(size_t)mm[t] * 128 + k]; }
#pragma unroll
        for (int t = 0; t < 2; ++t) { float d0 = 0.f, d1 = 0.f;
#pragma unroll
            for (int s = 0; s < 16; ++s) { const unsigned w = WSP(F, unsigned, WS_PART)[((size_t)s * MT + mm[t]) * 64 + lane]; d0 += bflo(w); d1 += bfhi(w); }
            dsum[t][0] = d0; dsum[t][1] = d1; }
#pragma unroll
        for (int t = 0; t < 2; ++t)
#pragma unroll
            for (int hlf = 0; hlf < 2; ++hlf) { const int k = 64 * hlf + lane;
                const f32x2 sc = SUV[e[t][hlf]];
                const float a = gelu_tanh(dsum[t][hlf] * sc.x) * gt[t][hlf] * sc.y;
                if (t == 0 || two) WSP(F, float, WS_ACT)[(size_t)mm[t] * 128 + k] = a; }
    }
}

__device__ __forceinline__ void phase_peer_v(Frame& F, int l) {
    launder(F);
    const int lane = F.lane, r8 = lane >> 3, l8 = lane & 7;
    const int gsz = F.G >> 3, grp = F.vcu / gsz, gwv = (F.vcu % gsz) * NWAVES + F.wave, gnw = gsz * NWAVES;
    const unsigned char* V = WSP(F, unsigned char, WS_PV) + (size_t)l * NEXP * D;
    const int* IDX = WSP(F, int, WS_IDX); const float* ACT = WSP(F, float, WS_ACT);
    LAS int* ET = (LAS int*)(F.lds + F.wave * 1024); LAS float* AT = (LAS float*)(F.lds + F.wave * 1024 + 512);
    const int m_lo = (l < DEPTH - 1) ? 0 : LC;
    const int wpos = ((lane & 7) * 16 + (lane >> 3));
    const bool b5 = (lane & 32) != 0, b4 = (lane & 16) != 0, b3 = (lane & 8) != 0;
#pragma unroll 1
    for (int sub = 0; sub < 2; ++sub) {
        const int s = 8 * sub + grp;
        const unsigned coff = 128u * (unsigned)s + 16u * (unsigned)l8;
        const int o0 = 8 * (8 * (s & 7) + l8) + 1024 * (s >> 3);
        int m = m_lo + gwv;
        int eL = IDX[(size_t)m * 128 + lane], eH = IDX[(size_t)m * 128 + 64 + lane]; float aL = ACT[(size_t)m * 128 + lane], aH = ACT[(size_t)m * 128 + 64 + lane];
#pragma unroll 1
        for (; m < MT; m += gnw) {
            ET[wpos] = eL; ET[wpos + 8] = eH; AT[wpos] = aL; AT[wpos + 8] = aH;
            LDS_WAIT();
            int e16[16]; float a[16];
#pragma unroll
            for (int q = 0; q < 16; ++q) { e16[q] = ET[r8 * 16 + q]; a[q] = AT[r8 * 16 + q]; }
            v4u r[16];
#pragma unroll
            for (int j = 0; j < 16; ++j) r[j] = *(const v4u*)(V + ((unsigned)e16[j] * 2048u + coff));
            { const int mn = (m + gnw < MT) ? m + gnw : m; eL = IDX[(size_t)mn * 128 + lane]; eH = IDX[(size_t)mn * 128 + 64 + lane]; aL = ACT[(size_t)mn * 128 + lane]; aH = ACT[(size_t)mn * 128 + 64 + lane]; }
            f32x2 acc[8];
#pragma unroll
            for (int i = 0; i < 8; ++i) acc[i] = (f32x2){0.f, 0.f};
#pragma unroll
            for (int j = 0; j < 16; ++j)
#pragma unroll
                for (int w = 0; w < 4; ++w) { const f32x2 lo = __builtin_amdgcn_cvt_pk_f32_fp8((int)r[j][w], false), hi = __builtin_amdgcn_cvt_pk_f32_fp8((int)r[j][w], true);
                    acc[2 * w] += lo * a[j]; acc[2 * w + 1] += hi * a[j]; }
            f32x2 g1[4], g2[2];
#pragma unroll
            for (int i = 0; i < 4; ++i) { const f32x2 kp = b5 ? acc[i + 4] : acc[i], sd = b5 ? acc[i] : acc[i + 4]; g1[i] = (f32x2){kp.x + __shfl_xor(sd.x, 32), kp.y + __shfl_xor(sd.y, 32)}; }
#pragma unroll
            for (int i = 0; i < 2; ++i) { const f32x2 kp = b4 ? g1[i + 2] : g1[i], sd = b4 ? g1[i] : g1[i + 2]; g2[i] = (f32x2){kp.x + __shfl_xor(sd.x, 16), kp.y + __shfl_xor(sd.y, 16)}; }
            { const f32x2 kp = b3 ? g2[1] : g2[0], sd = b3 ? g2[0] : g2[1]; const f32x2 res = (f32x2){kp.x + dpp_f<0x128>(sd.x), kp.y + dpp_f<0x128>(sd.y)};
              *(unsigned*)(WSP(F, bf16, WS_Z) + (size_t)m * D + o0 + (r8 < 4 ? 2 * r8 : 512 + 2 * (r8 - 4))) = pk2(res.x, res.y); }
            LDS_WAIT();
        }
    }
}

__device__ __forceinline__ void phase_peer_tail(Frame& F, int l) {
    launder(F);
    const int gw = F.vcu * NWAVES + F.wave, NGW = F.G * NWAVES, lane = F.lane;
    const int m_lo = (l < DEPTH - 1) ? 0 : LC;
    v4u nx[4], no[4];
    { const int m = (m_lo + gw < MT) ? m_lo + gw : MT - 1; row_fetch_bf16(WSP(F, bf16, WS_X) + (size_t)m * D, lane, nx); row_fetch_bf16(WSP(F, bf16, WS_Z) + (size_t)m * D, lane, no); }
    for (int m = m_lo + gw; m < MT; m += NGW) {
        const float* mod = WSP(F, float, WS_MOD) + (size_t)l * 2 * 12288 + (m < LC ? 12288 : 0);
        float x[32], o[32]; row_expand_bf16(nx, x); row_expand_bf16(no, o);
        { const int mn = (m + NGW < MT) ? m + NGW : m; row_fetch_bf16(WSP(F, bf16, WS_X) + (size_t)mn * D, lane, nx); row_fetch_bf16(WSP(F, bf16, WS_Z) + (size_t)mn * D, lane, no); }
#pragma unroll
        for (int j = 0; j < 4; ++j)
#pragma unroll
            for (int hf = 0; hf < 2; ++hf) { const f32x4 gv = *(const f32x4*)(mod + 5 * D + 8 * lane + 512 * j + 4 * hf);
#pragma unroll
                for (int c = 0; c < 4; ++c) x[8 * j + 4 * hf + c] = ALPHA * x[8 * j + 4 * hf + c] + gv[c] * o[8 * j + 4 * hf + c]; }
        row_norm(x); row_affine(x, IN_LN2G(F) + l * D, IN_LN2B(F) + l * D, lane, 0.f);
        if (l < DEPTH - 1) {
            row_store_bf16(WSP(F, bf16, WS_X) + (size_t)m * D, lane, x);
            const float* modn = WSP(F, float, WS_MOD) + (size_t)(l + 1) * 2 * 12288 + (m < LC ? 12288 : 0);
            row_norm(x); row_affine(x, modn + D, modn, lane, 1.f);
            row_store_bf16(WSP(F, bf16, WS_H) + (size_t)m * D, lane, x);
        } else {
            row_store_f32(F.ap->out + (size_t)(m - LC) * D, lane, x);
        }
    }
}

template <int MODE> __device__ __forceinline__ void ctx_gemm(Frame& F, const bf16* A, const bf16* Bt, const bf16* X, bf16* Z, const float* g, float* ST) {
    launder(F);
    const int lane = F.lane, fr = lane & 15, fq = lane >> 4, w = F.wave;
    LAS f32x4* red = (LAS f32x4*)F.lds;
#pragma unroll 1
    for (int wt = F.vcu; wt < 256; wt += F.G) {
        const int rg = wt & 7, cg = wt >> 3;
        const bf16* ap = A + (size_t)(32 * rg + fr) * D + 8 * fq + 256 * w; const bf16* bp = Bt + (size_t)(64 * cg + fr) * D + 8 * fq + 256 * w;
        f32x4 acc[2][4];
#pragma unroll
        for (int m = 0; m < 2; ++m)
#pragma unroll
            for (int n = 0; n < 4; ++n) acc[m][n] = (f32x4){0.f, 0.f, 0.f, 0.f};
#pragma unroll 1
        for (int kb = 0; kb < 8; kb += 4) {
            bf16x8v a[4][2], b[4][4];
#pragma unroll
            for (int i = 0; i < 4; ++i) {
#pragma unroll
                for (int m = 0; m < 2; ++m) a[i][m] = *(const bf16x8v*)(ap + (size_t)(16 * m) * D + 32 * (kb + i));
#pragma unroll
                for (int n = 0; n < 4; ++n) b[i][n] = *(const bf16x8v*)(bp + (size_t)(16 * n) * D + 32 * (kb + i)); }
            __builtin_amdgcn_sched_barrier(0);
#pragma unroll
            for (int i = 0; i < 4; ++i)
#pragma unroll
                for (int m = 0; m < 2; ++m)
#pragma unroll
                    for (int n = 0; n < 4; ++n) acc[m][n] = __builtin_amdgcn_mfma_f32_16x16x32_bf16(a[i][m], b[i][n], acc[m][n], 0, 0, 0);
        }
        asm volatile("s_waitcnt vmcnt(0)" ::: "memory");
        __syncthreads();
#pragma unroll
        for (int m = 0; m < 2; ++m)
#pragma unroll
            for (int n = 0; n < 4; ++n) red[(w * 8 + m * 4 + n) * 64 + lane] = acc[m][n];
        __syncthreads();
        f32x4 sum = red[w * 64 + lane];
#pragma unroll
        for (int ww = 1; ww < 8; ++ww) sum += red[(ww * 8 + w) * 64 + lane];
        { const int m = w >> 2, n = w & 3; const int col = 64 * cg + 16 * n + fr, row0 = 32 * rg + 16 * m + 4 * fq;
          if (MODE == 0) { const float gv = g[col];
#pragma unroll
              for (int r = 0; r < 4; ++r) Z[(size_t)(row0 + r) * D + col] = (bf16)f2bf(ALPHA * bflo((unsigned)X[(size_t)(row0 + r) * D + col]) + gv * sum[r]); }
          else *(f32x4*)(ST + (size_t)col * MT + row0) = sum; }
        __syncthreads();
    }
}

#ifndef MK_MULTI
#define MK_MULTI 0
#endif
constexpr int NPL = 12, NPHASE = 2 + DEPTH * NPL;
__global__ void __launch_bounds__(NT, 2) trunk_fwd(Args args) {
    extern __shared__ __attribute__((aligned(16))) unsigned char lds[];
    Frame F;
    F.lds = (LAS unsigned char*)lds; F.ldsg = (char*)lds;
    F.tid = threadIdx.x; F.lane = F.tid & 63; F.wave = __builtin_amdgcn_readfirstlane(F.tid >> 6);
    F.G = gridDim.x; { const int bx = blockIdx.x; F.vcu = (F.G % 8 == 0) ? (bx % 8) * (F.G / 8) + bx / 8 : bx; }
    F.ap = (const __attribute__((address_space(4))) Args*)__builtin_amdgcn_kernarg_segment_ptr();
    volatile LAS unsigned* MISC = (volatile LAS unsigned*)(F.lds + MISC_OFF);
    for (int u = F.tid; u < (LDS_BYTES - LDSCTL_OFF) / 4; u += NT) ((LAS unsigned*)(F.lds + LDSCTL_OFF))[u] = 0u;
    __syncthreads();
    XcdBarrier bar; bar.bar = WSP(F, unsigned, WS_CTL) + CW_BAR; bar.x = 0; bar.st = nullptr;
    if (!MK_MULTI) bar = xcd_barrier_post(WSP(F, unsigned, WS_CTL) + CW_BAR, MISC + 8);
    const int lo = args.ph_lo, hi = args.ph_hi;
#ifndef PH_MASK
#define PH_MASK 0xFFFFFF
#endif
#define IN(k) (lo <= (k) && (k) < hi)
#define PM(b) ((PH_MASK >> (b)) & 1)
#define SEAM(k) do { if (!MK_MULTI && IN(k) && IN((k) + 1)) xcd_barrier(bar); } while (0)

    if (PM(0) && IN(0)) { for (int rp = 0; rp < RP(0); ++rp) phase_prologue_a(F); } SEAM(0);
    if (PM(1) && IN(1)) { for (int rp = 0; rp < RP(1); ++rp) phase_ln0(F); } SEAM(1);
#pragma unroll 1
    for (int l = 0; l < DEPTH; ++l) {
        const int pb = 2 + l * NPL;
        const bool ctxu = l < DEPTH - 1;
        if (PM(2) && IN(pb + 0)) for (int rp = 0; rp < RP(2); ++rp) {
            pg8::Gemm g{WSP(F, bf16, WS_H), WSP(F, bf16, WS_WIN) + (size_t)l * INWP * D, MT, INWP, D}; pg8::StaticOrder S; S.init(MT, INWP, F.G, (int)blockIdx.x);
            pg8::EpiBf16P E{WSP(F, bf16, WS_P), INWP};
            pg8::gemm_phase<pg8::EpiBf16P, pg8::StaticOrder, true, true>(F.lds, g, S, E);
        }
        SEAM(pb + 0);
        if (IN(pb + 1)) { if (PM(3)) for (int rp = 0; rp < RP(3); ++rp) phase_qknorm(F, l); if (PM(4)) for (int rp = 0; rp < RP(4); ++rp) phase_gla_chunk(F, l); }
        SEAM(pb + 1);
        if (PM(5) && IN(pb + 2)) { phase_attn(F, l); }
        SEAM(pb + 2);
        if (PM(6) && IN(pb + 3)) { for (int rp = 0; rp < RP(6); ++rp) phase_gla_out(F, l); }
        SEAM(pb + 3);
        if (PM(7) && IN(pb + 4)) for (int rp = 0; rp < RP(7); ++rp) {
            const float* modl = WSP(F, float, WS_MOD) + (size_t)l * 2 * 12288;
            pg8::Gemm g{WSP(F, bf16, WS_MIX) + (size_t)LC * D, WSP(F, bf16, WS_WOUT) + (size_t)l * D * D, T, D, D}; pg8::StaticOrder S; S.init(T, D, F.G, (int)blockIdx.x);
            pg8::EpiResid E{WSP(F, bf16, WS_X) + (size_t)LC * D, WSP(F, bf16, WS_Z) + (size_t)LC * D, modl + 2 * D, ALPHA};
            pg8::gemm_phase<pg8::EpiResid, pg8::StaticOrder, true, true>(F.lds, g, S, E);
            if (ctxu) ctx_gemm<0>(F, WSP(F, bf16, WS_MIX), WSP(F, bf16, WS_WOUT) + (size_t)l * D * D, WSP(F, bf16, WS_X), WSP(F, bf16, WS_Z), modl + 12288 + 2 * D, nullptr);
        }
        SEAM(pb + 4);
        if (PM(8) && IN(pb + 5)) { for (int rp = 0; rp < RP(8); ++rp) phase_ln1(F, l); }
        SEAM(pb + 5);
        if (PM(9) && IN(pb + 6)) for (int rp = 0; rp < RP(9); ++rp) {
            pg8::Gemm g{WSP(F, bf16, WS_WP) + (size_t)l * D * D, WSP(F, bf16, WS_H) + (size_t)LC * D, D, T, D}; pg8::StaticOrder S; S.init(D, T, F.G, (int)blockIdx.x);
            pg8::EpiStoreF32 E{WSP(F, float, WS_ST) + LC, MT};
            pg8::gemm_phase<pg8::EpiStoreF32, pg8::StaticOrder, true, true>(F.lds, g, S, E);
            if (ctxu) ctx_gemm<1>(F, WSP(F, bf16, WS_H), WSP(F, bf16, WS_WP) + (size_t)l * D * D, nullptr, nullptr, nullptr, WSP(F, float, WS_ST));
        }
        SEAM(pb + 6);
        if (PM(10) && IN(pb + 7)) { for (int rp = 0; rp < RP(10); ++rp) phase_topk(F, l); }
        SEAM(pb + 7);
        if (PM(11) && IN(pb + 8)) { for (int rp = 0; rp < RP(11); ++rp) phase_peer(F, l); }
        SEAM(pb + 8);
        if (PM(22) && IN(pb + 9)) { for (int rp = 0; rp < RP(22); ++rp) phase_peer_act(F, l); }
        SEAM(pb + 9);
        if (PM(20) && IN(pb + 10)) { for (int rp = 0; rp < RP(20); ++rp) phase_peer_v(F, l); }
        SEAM(pb + 10);
        if (PM(21) && IN(pb + 11)) { phase_peer_tail(F, l); }
        SEAM(pb + 11);
    }
#undef IN
#undef SEAM
}

extern "C" void kernel_launch(void* const* d_in, const int* in_sizes, int n_in, void* d_out, int out_size, void* d_ws, size_t ws_size, hipStream_t stream) {
    static int grid = 0;
    if (grid == 0) {
        if (n_in != 22 || out_size != T * D || ws_size < WS_END) { fprintf(stderr, "kernel_launch: unexpected shapes (n_in %d, out %d, ws %zu); nothing launched\n", n_in, out_size, ws_size); grid = -1; return; }
        int dev = 0, cus = 0, per_cu = 0;
        if (hipGetDevice(&dev) != hipSuccess || hipDeviceGetAttribute(&cus, hipDeviceAttributeMultiprocessorCount, dev) != hipSuccess) { grid = -1; return; }
        if (hipFuncSetAttribute((const void*)trunk_fwd, hipFuncAttributeMaxDynamicSharedMemorySize, LDS_BYTES) != hipSuccess) { fprintf(stderr, "kernel_launch: hipFuncSetAttribute failed\n"); grid = -1; return; }
        if (hipOccupancyMaxActiveBlocksPerMultiprocessor(&per_cu, (const void*)trunk_fwd, NT, LDS_BYTES) != hipSuccess || per_cu < 1)
            fprintf(stderr, "kernel_launch: note: occupancy query reports %d workgroups per CU\n", per_cu);
        (void)hipGetLastError();
        grid = cus;
    }
    if (grid < 0) return;
    if (hipMemsetAsync((char*)d_ws + WS_CTL, 0, CTL_ZERO_BYTES, stream) != hipSuccess) return;
    Args a{};
    for (int i = 0; i < 22; ++i) a.in[i] = (const float*)d_in[i];
    a.out = (float*)d_out; a.ws = (unsigned char*)d_ws;
#if MK_MULTI
    for (int p = 0; p < NPHASE; ++p) { a.ph_lo = p; a.ph_hi = p + 1; hipLaunchKernelGGL(trunk_fwd, dim3(grid), dim3(NT), LDS_BYTES, stream, a); }
#else
    a.ph_lo = 0; a.ph_hi = NPHASE; hipLaunchKernelGGL(trunk_fwd, dim3(grid), dim3(NT), LDS_BYTES, stream, a);
#endif
}
```

```cpp
#include <hip/hip_runtime.h>
#include <cstdio>
#include <cstdint>
#include <hip/hip_bf16.h>
#define MK_MULTI 0
namespace pg8 {
#define PG8_LAS __attribute__((address_space(3)))
typedef unsigned short bf16_t;
typedef short bf16x8 __attribute__((ext_vector_type(8)));
typedef float f32x4 __attribute__((ext_vector_type(4)));
typedef unsigned u32x4 __attribute__((ext_vector_type(4)));
constexpr int BM = 256, BK = 64, HALF = 128, HTB = HALF * BK * 2  , STAGE_BYTES = 8 * HTB, NXCD = 8, WGM = 8;

__host__ __device__ __forceinline__ int lds_byte(int r, int c) { const int st = (r >> 4) * 2 + (c >> 5), rr = r & 15, cc = c & 31, ob = rr * 64 + cc * 2; return st * 1024 + (ob ^ (((ob >> 9) & 1) << 5)); }
__host__ __device__ __forceinline__ void stage_rc(int b, int& R, int& C) { const int st = b / 1024, sb = b % 1024, swz = sb ^ (((sb >> 9) & 1) << 5); R = (st >> 1) * 16 + swz / 64; C = (st & 1) * 32 + (swz % 64) / 2; }
__host__ __device__ __forceinline__ int perm32(int rho) { const int n = rho >> 4, i = rho & 15; return 8 * (i >> 2) + 4 * n + (i & 3); }

struct Unit { int pm, pn; };
struct Gemm { const bf16_t* A; const bf16_t* Bt; int M, N, K; };

struct StaticOrder {
    int nM, nN, nwg, G, c;
    __host__ __device__ void init(int M, int N, int G_, int c_) { nM = M / BM; nN = N / BM; nwg = nM * nN; G = G_; c = c_; }
    __host__ __device__ bool next(int i, Unit& u) const {
        const long L = (long)i * G + c; if (L >= nwg) return false;
        int wgid = (int)L; { const int q = nwg / NXCD, r = nwg % NXCD, xcd = wgid % NXCD, off = wgid / NXCD; wgid = (xcd < r ? xcd * (q + 1) : r * (q + 1) + (xcd - r) * q) + off; }
        const int nig = WGM * nN, gid = wgid / nig, fm = gid * WGM, gsz = (nM - fm) < WGM ? (nM - fm) : WGM;
        u.pm = fm + ((wgid % nig) % gsz); u.pn = (wgid % nig) / gsz; return true;
    }
    __device__ __forceinline__ void a_ready(const Unit&) const {}
    __device__ __forceinline__ void done(const Unit&) const {}
};
__device__ __forceinline__ unsigned cvt_pk_bf16(float lo, float hi) { unsigned r; asm volatile("v_cvt_pk_bf16_f32 %0, %1, %2" : "=v"(r) : "v"(lo), "v"(hi)); return r; }
typedef float f32x2 __attribute__((ext_vector_type(2)));

struct EpiBf16P {
    static constexpr bool PERM = true, AFTER_DRAIN = false;
    bf16_t* O; int ldc;
    __device__ __forceinline__ void operator()(const f32x4 (&acc)[2][2][4][2], const Unit& u, int wr, int wc, int fr, int fq) const {
        const int row0 = u.pm * BM + wr * 64 + fr, col0 = u.pn * BM + wc * 32 + 8 * fq;
#pragma unroll
        for (int ai = 0; ai < 2; ++ai)
#pragma unroll
            for (int m = 0; m < 4; ++m) { bf16_t* rowp = O + (size_t)(row0 + ai * HALF + m * 16) * ldc + col0;
#pragma unroll
                for (int bj = 0; bj < 2; ++bj) { const f32x4 v0 = acc[ai][bj][m][0], v1 = acc[ai][bj][m][1];
                    u32x4 w; w.x = cvt_pk_bf16(v0[0], v0[1]); w.y = cvt_pk_bf16(v0[2], v0[3]); w.z = cvt_pk_bf16(v1[0], v1[1]); w.w = cvt_pk_bf16(v1[2], v1[3]);
                    *(u32x4*)(rowp + bj * HALF) = w; } }
    }
};
struct EpiResid {
    static constexpr bool PERM = true, AFTER_DRAIN = false;
    const bf16_t* X; bf16_t* Z; const float* g; float alpha;
    __device__ __forceinline__ void operator()(const f32x4 (&acc)[2][2][4][2], const Unit& u, int wr, int wc, int fr, int fq) const {
        const int row0 = u.pm * BM + wr * 64 + fr, col0 = u.pn * BM + wc * 32 + 8 * fq;
        f32x4 gv[2][2];
#pragma unroll
        for (int bj = 0; bj < 2; ++bj)
#pragma unroll
            for (int n = 0; n < 2; ++n) gv[bj][n] = *(const f32x4*)(g + col0 + bj * HALF + 4 * n);
#pragma unroll
        for (int ai = 0; ai < 2; ++ai) {
            u32x4 xv[4][2];
#pragma unroll
            for (int m = 0; m < 4; ++m)
#pragma unroll
                for (int bj = 0; bj < 2; ++bj) xv[m][bj] = *(const u32x4*)(X + (size_t)(row0 + ai * HALF + m * 16) * 2048 + col0 + bj * HALF);
#pragma unroll
            for (int m = 0; m < 4; ++m)
#pragma unroll
                for (int bj = 0; bj < 2; ++bj) { const f32x4 v0 = acc[ai][bj][m][0], v1 = acc[ai][bj][m][1]; const u32x4 x = xv[m][bj]; u32x4 w;
#define XLO_(q) __builtin_bit_cast(float, (q) << 16)
#define XHI_(q) __builtin_bit_cast(float, (q) & 0xffff0000u)
                    w.x = cvt_pk_bf16(XLO_(x.x) * alpha + gv[bj][0][0] * v0[0], XHI_(x.x) * alpha + gv[bj][0][1] * v0[1]);
                    w.y = cvt_pk_bf16(XLO_(x.y) * alpha + gv[bj][0][2] * v0[2], XHI_(x.y) * alpha + gv[bj][0][3] * v0[3]);
                    w.z = cvt_pk_bf16(XLO_(x.z) * alpha + gv[bj][1][0] * v1[0], XHI_(x.z) * alpha + gv[bj][1][1] * v1[1]);
                    w.w = cvt_pk_bf16(XLO_(x.w) * alpha + gv[bj][1][2] * v1[2], XHI_(x.w) * alpha + gv[bj][1][3] * v1[3]);
#undef XLO_
#undef XHI_
                    *(u32x4*)(Z + (size_t)(row0 + ai * HALF + m * 16) * 2048 + col0 + bj * HALF) = w; }
        }
    }
};
struct EpiStoreF32 {
    static constexpr bool PERM = true, AFTER_DRAIN = false;
    float* C; int ldc;
    __device__ __forceinline__ void operator()(const f32x4 (&acc)[2][2][4][2], const Unit& u, int wr, int wc, int fr, int fq) const {
        const int row0 = u.pm * BM + wr * 64 + fr, col0 = u.pn * BM + wc * 32 + 8 * fq;
#pragma unroll
        for (int ai = 0; ai < 2; ++ai)
#pragma unroll
            for (int m = 0; m < 4; ++m) { float* rowp = C + (size_t)(row0 + ai * HALF + m * 16) * ldc + col0;
#pragma unroll
                for (int bj = 0; bj < 2; ++bj) { *(f32x4*)(rowp + bj * HALF) = acc[ai][bj][m][0]; *(f32x4*)(rowp + bj * HALF + 4) = acc[ai][bj][m][1]; } }
    }
};

template <class Epi, class Sched, bool ALIGN_EPI = false, bool SP2 = false>
__device__ __forceinline__ void gemm_phase(PG8_LAS unsigned char* lds, const Gemm g, const Sched& S, const Epi& E) {
    int tid_ = threadIdx.x; asm volatile("" : "+v"(tid_));
    const int tid = tid_, wid = __builtin_amdgcn_readfirstlane(tid >> 6), lane = tid & 63, wr = wid >> 2, wc = wid & 3, fr = lane & 15, fq = lane >> 4;
    const int K = g.K, nt = K / BK;
    unsigned voffA[2], voffB[2];
#pragma unroll
    for (int i = 0; i < 2; ++i) { int R, C; stage_rc(tid * 16 + i * 8192, R, C); const int Rb = Epi::PERM ? ((R & ~31) + perm32(R & 31)) : R;
        voffA[i] = (unsigned)(R * K + C) * 2u; voffB[i] = (unsigned)(Rb * K + C) * 2u; }
    const size_t kstep = (size_t)(BK * 2);
    const size_t hstep = (size_t)HALF * K * 2;
    const size_t tstep = 2 * hstep;
    const unsigned ldsw = (unsigned)wid * 1024u;
    const int aoff = lds_byte(wr * 64 + fr, fq * 8), boff = lds_byte(wc * 32 + fr, fq * 8);
#define PG8_SA(b, h) (((b) * 2 + (h)) * HTB)
#define PG8_SB(b, h) ((4 + (b) * 2 + (h)) * HTB)
#define PG8_STAGE(bufoff, gbase, voff) do { _Pragma("unroll") for (int _i = 0; _i < 2; ++_i) \
        __builtin_amdgcn_global_load_lds((const unsigned*)((const char*)(gbase) + (voff)[_i]), (PG8_LAS unsigned*)(lds + (bufoff) + ldsw + _i * 8192), 16, 0, 0); } while (0)
#define PG8_LDA(dst, b, h) do { _Pragma("unroll") for (int m = 0; m < 4; ++m) _Pragma("unroll") for (int k = 0; k < 2; ++k) dst[m][k] = *(const PG8_LAS bf16x8*)(lds + PG8_SA(b, h) + aoff + m * 2048 + k * 1024); } while (0)
#define PG8_LDB(dst, b, h) do { _Pragma("unroll") for (int n = 0; n < 2; ++n) _Pragma("unroll") for (int k = 0; k < 2; ++k) dst[n][k] = *(const PG8_LAS bf16x8*)(lds + PG8_SB(b, h) + boff + n * 2048 + k * 1024); } while (0)
#define PG8_MMA(ai, bj, At, Bt) do { __builtin_amdgcn_s_setprio(1); _Pragma("unroll") for (int m = 0; m < 4; ++m) _Pragma("unroll") for (int n = 0; n < 2; ++n) _Pragma("unroll") for (int k = 0; k < 2; ++k) \
        acc[ai][bj][m][n] = __builtin_amdgcn_mfma_f32_16x16x32_bf16(Bt[n][k], At[m][k], acc[ai][bj][m][n], 0, 0, 0); __builtin_amdgcn_s_setprio(0); } while (0)
#define PG8_WAIT_V(n) asm volatile("s_waitcnt vmcnt(" #n ")" ::: "memory")
#define PG8_WAIT_L(n) asm volatile("s_waitcnt lgkmcnt(" #n ")" ::: "memory")
#define PG8_BAR __builtin_amdgcn_s_barrier()
#define PG8_SCHED __builtin_amdgcn_sched_barrier(0)
    Unit cur, nxt; int ui = 0;
    if (!S.next(0, cur)) return;
    f32x4 acc[2][2][4][2];
#pragma unroll
    for (int a = 0; a < 2; ++a)
#pragma unroll
        for (int b = 0; b < 2; ++b)
#pragma unroll
            for (int m = 0; m < 4; ++m)
#pragma unroll
                for (int n = 0; n < 2; ++n) acc[a][b][m][n] = (f32x4){0.f, 0.f, 0.f, 0.f};
    bf16x8 At[4][2], B0[2][2], B1[2][2];
    const char* cA = (const char*)g.A + (size_t)cur.pm * tstep; const char* cB = (const char*)g.Bt + (size_t)cur.pn * tstep;
    S.a_ready(cur);
    if constexpr (SP2) {
        PG8_STAGE(PG8_SB(0, 0), cB, voffB); PG8_STAGE(PG8_SB(0, 1), cB + hstep, voffB); PG8_STAGE(PG8_SA(0, 0), cA, voffA); PG8_STAGE(PG8_SA(0, 1), cA + hstep, voffA);
        if (wr == 1) PG8_BAR;
        PG8_WAIT_V(2); PG8_BAR;
        PG8_STAGE(PG8_SB(1, 0), cB + kstep, voffB); PG8_STAGE(PG8_SA(1, 0), cA + kstep, voffA); PG8_STAGE(PG8_SB(1, 1), cB + hstep + kstep, voffB);
        PG8_WAIT_V(6); PG8_BAR;
    } else {
        PG8_STAGE(PG8_SB(0, 0), cB, voffB); PG8_STAGE(PG8_SA(0, 0), cA, voffA); PG8_STAGE(PG8_SB(0, 1), cB + hstep, voffB); PG8_STAGE(PG8_SA(0, 1), cA + hstep, voffA);
        if (wr == 1) PG8_BAR;
        PG8_WAIT_V(4); PG8_BAR;
        PG8_STAGE(PG8_SB(1, 0), cB + kstep, voffB); PG8_STAGE(PG8_SA(1, 0), cA + kstep, voffA); PG8_STAGE(PG8_SB(1, 1), cB + hstep + kstep, voffB);
        PG8_WAIT_V(6); PG8_BAR;
    }
    for (;;) {
        const bool has_next = S.next(ui + 1, nxt);
        const char* nA = has_next ? (const char*)g.A + (size_t)nxt.pm * tstep : cA; const char* nB = has_next ? (const char*)g.Bt + (size_t)nxt.pn * tstep : cB;
        for (int t = 0; t < nt; t += 2) {
            const bool last = (t == nt - 2);
            const char* a1 = cA + (size_t)(t + 1) * kstep;
            const char* a2 = last ? nA : cA + (size_t)(t + 2) * kstep; const char* b2 = last ? nB : cB + (size_t)(t + 2) * kstep;
            const char* a3 = a2 + kstep; const char* b3 = b2 + kstep;
            if (last && has_next) S.a_ready(nxt);
            if constexpr (SP2) {
            PG8_LDB(B0, 0, 0); PG8_LDB(B1, 0, 1); PG8_SCHED; PG8_LDA(At, 0, 0); PG8_STAGE(PG8_SA(1, 1), a1 + hstep, voffA);
            PG8_WAIT_V(8); PG8_WAIT_L(0); PG8_BAR; PG8_MMA(0, 0, At, B0); PG8_MMA(0, 1, At, B1); PG8_BAR; PG8_SCHED;
            PG8_LDA(At, 0, 1); PG8_STAGE(PG8_SB(0, 0), b2, voffB); PG8_STAGE(PG8_SB(0, 1), b2 + hstep, voffB); PG8_STAGE(PG8_SA(0, 0), a2, voffA);
            PG8_WAIT_V(8); PG8_WAIT_L(0); PG8_BAR; PG8_MMA(1, 0, At, B0); PG8_MMA(1, 1, At, B1); PG8_BAR; PG8_SCHED;
            PG8_LDB(B0, 1, 0); PG8_LDB(B1, 1, 1); PG8_SCHED; PG8_LDA(At, 1, 0); PG8_STAGE(PG8_SA(0, 1), a2 + hstep, voffA);
            PG8_WAIT_V(8); PG8_WAIT_L(0); PG8_BAR; PG8_MMA(0, 0, At, B0); PG8_MMA(0, 1, At, B1); PG8_BAR; PG8_SCHED;
            PG8_LDA(At, 1, 1); PG8_STAGE(PG8_SB(1, 0), b3, voffB); PG8_STAGE(PG8_SB(1, 1), b3 + hstep, voffB); PG8_STAGE(PG8_SA(1, 0), a3, voffA);
            PG8_WAIT_V(8); PG8_WAIT_L(0); PG8_BAR; PG8_MMA(1, 0, At, B0); PG8_MMA(1, 1, At, B1); PG8_BAR; PG8_SCHED;
            } else {
            PG8_LDB(B0, 0, 0); PG8_SCHED; PG8_LDA(At, 0, 0); PG8_STAGE(PG8_SA(1, 1), a1 + hstep, voffA);
            PG8_WAIT_L(8); PG8_BAR; PG8_WAIT_L(0); PG8_MMA(0, 0, At, B0); PG8_BAR; PG8_SCHED;
            PG8_LDB(B1, 0, 1); PG8_STAGE(PG8_SB(0, 0), b2, voffB);
            PG8_BAR; PG8_WAIT_L(0); PG8_MMA(0, 1, At, B1); PG8_BAR;
            PG8_LDA(At, 0, 1); PG8_STAGE(PG8_SA(0, 0), a2, voffA);
            PG8_BAR; PG8_WAIT_L(0); PG8_MMA(1, 0, At, B0); PG8_BAR; PG8_SCHED;
            PG8_STAGE(PG8_SB(0, 1), b2 + hstep, voffB);
            PG8_WAIT_V(6); PG8_BAR; PG8_MMA(1, 1, At, B1); PG8_BAR;
            PG8_LDB(B0, 1, 0); PG8_SCHED; PG8_LDA(At, 1, 0); PG8_STAGE(PG8_SA(0, 1), a2 + hstep, voffA);
            PG8_WAIT_L(8); PG8_BAR; PG8_WAIT_L(0); PG8_MMA(0, 0, At, B0); PG8_BAR; PG8_SCHED;
            PG8_LDB(B1, 1, 1); PG8_STAGE(PG8_SB(1, 0), b3, voffB);
            PG8_BAR; PG8_WAIT_L(0); PG8_MMA(0, 1, At, B1); PG8_BAR;
            PG8_LDA(At, 1, 1); PG8_STAGE(PG8_SA(1, 0), a3, voffA);
            PG8_BAR; PG8_WAIT_L(0); PG8_MMA(1, 0, At, B0); PG8_BAR; PG8_SCHED;
            PG8_STAGE(PG8_SB(1, 1), b3 + hstep, voffB);
            PG8_WAIT_V(6); PG8_BAR; PG8_MMA(1, 1, At, B1); PG8_BAR;
            }
        }
        if constexpr (ALIGN_EPI) { if (wr == 0) PG8_BAR; }
        if constexpr (!Epi::AFTER_DRAIN) { E(acc, cur, wr, wc, fr, fq); S.done(cur); }
        if (!has_next) break;
#pragma unroll
        for (int a = 0; a < 2; ++a)
#pragma unroll
            for (int b = 0; b < 2; ++b)
#pragma unroll
                for (int m = 0; m < 4; ++m)
#pragma unroll
                    for (int n = 0; n < 2; ++n) acc[a][b][m][n] = (f32x4){0.f, 0.f, 0.f, 0.f};
        cur = nxt; cA = nA; cB = nB; ++ui;
        if constexpr (ALIGN_EPI) { if (wr == 1) PG8_BAR; }
    }
    PG8_WAIT_V(0);
    if constexpr (!ALIGN_EPI) { if (wr == 0) PG8_BAR; }
    PG8_BAR;
    if constexpr (Epi::AFTER_DRAIN) { E.fused(acc, cur, wr, wc, fr, fq, lds, wid, lane); S.done(cur); }
#undef PG8_SA
#undef PG8_SB
#undef PG8_STAGE
#undef PG8_LDA
#undef PG8_LDB
#undef PG8_MMA
#undef PG8_WAIT_V
#undef PG8_WAIT_L
#undef PG8_BAR
#undef PG8_SCHED
}
}
#include <cmath>
namespace attn_body {
using bf16=__hip_bfloat16;
using bf16x8=__attribute__((ext_vector_type(8)))short;
using s16x4=__attribute__((ext_vector_type(4)))short;
using f32x16=__attribute__((ext_vector_type(16)))float;
using u32x4=__attribute__((ext_vector_type(4)))unsigned;
constexpr int D=64;
constexpr int NW=8,QBLK=32,QB=QBLK*NW,KVBLK=64;
constexpr int ATTN_UNIT_ROWS=QB;
__device__ __forceinline__ int crow(int r,int hi){return (r&3)+8*(r>>2)+4*hi;}
#define SBAR() __builtin_amdgcn_sched_barrier(0)
__device__ __forceinline__ void cmask(f32x16&p0,f32x16&p1,int jb,int qrel,int hi){
  const float NEG=-INFINITY; int kb=64*jb+4*hi;
  #pragma unroll
  for(int r=0;r<16;++r){int kv=kb+(r&3)+8*(r>>2); if(kv>qrel)p0[r]=NEG; if(kv+32>qrel)p1[r]=NEG;}
}

constexpr int NSLOT=3, SLOTB=8192;
constexpr int LDS_K=0, LDS_V=NSLOT*SLOTB, LDS_WS=2*NSLOT*SLOTB, LDS_OST=LDS_WS+NW*64*4, LDS_BYTES=LDS_OST+NW*4096;
constexpr float C2=0.125f*1.4426950408889634f;
__device__ __forceinline__ void glds16(const void*gsrc,unsigned lds_dst){unsigned keep;
  asm volatile("s_mov_b32 %0, m0\n\ts_mov_b32 m0, %2\n\ts_nop 0\n\tglobal_load_lds_dwordx4 %1, off\n\ts_mov_b32 m0, %0":"=&s"(keep):"v"(gsrc),"s"(lds_dst):"memory");}
__device__ __forceinline__ float max3f(float a,float b,float c){float r;asm("v_max3_f32 %0, %1, %2, %3":"=v"(r):"v"(a),"v"(b),"v"(c));return r;}
__device__ __forceinline__ float max2f(float a,float b){float r;asm("v_max_f32_e32 %0, %1, %2":"=v"(r):"v"(a),"v"(b));return r;}
__device__ __forceinline__ float fadd_s(float a,float b){float r;asm("v_add_f32_e32 %0, %1, %2":"=v"(r):"v"(a),"v"(b));return r;}
__device__ __forceinline__ float fsub_s(float a,float b){float r;asm("v_sub_f32_e32 %0, %1, %2":"=v"(r):"v"(a),"v"(b));return r;}
typedef float f32x2_t __attribute__((ext_vector_type(2))); typedef __bf16 bf16x2_t __attribute__((ext_vector_type(2)));
__device__ __forceinline__ unsigned cvtpk_s(float lo,float hi){f32x2_t v={lo,hi};bf16x2_t b=__builtin_convertvector(v,bf16x2_t);return __builtin_bit_cast(unsigned,b);}
#define WAIT_BAR(N) asm volatile("s_waitcnt vmcnt(" #N ") lgkmcnt(0)\n\ts_barrier":::"memory")

__device__ __forceinline__ void qkt(f32x16&p0,f32x16&p1,const char*Kslot,const bf16x8*qr,const f32x16&negm,int r32,int hi){
  const char*kb=Kslot+hi*1024+r32*16;
  #pragma unroll
  for(int d0=0;d0<4;++d0){
    const bf16x8 b0=*reinterpret_cast<const bf16x8*>(kb+d0*2048);
    const bf16x8 b1=*reinterpret_cast<const bf16x8*>(kb+d0*2048+512);
    if(d0==0){p0=__builtin_amdgcn_mfma_f32_32x32x16_bf16(b0,qr[0],negm,0,0,0);p1=__builtin_amdgcn_mfma_f32_32x32x16_bf16(b1,qr[0],negm,0,0,0);}
    else{p0=__builtin_amdgcn_mfma_f32_32x32x16_bf16(b0,qr[d0],p0,0,0,0);p1=__builtin_amdgcn_mfma_f32_32x32x16_bf16(b1,qr[d0],p1,0,0,0);}}
}
typedef __attribute__((address_space(3))) const char* lds_cptr;
typedef short v4i16_t __attribute__((ext_vector_type(4)));
__device__ __forceinline__ void kload8(bf16x8*kf,lds_cptr kp){
  kf[0]=*(const __attribute__((address_space(3))) bf16x8*)(kp);      kf[1]=*(const __attribute__((address_space(3))) bf16x8*)(kp+512);
  kf[2]=*(const __attribute__((address_space(3))) bf16x8*)(kp+2048); kf[3]=*(const __attribute__((address_space(3))) bf16x8*)(kp+2560);
  kf[4]=*(const __attribute__((address_space(3))) bf16x8*)(kp+4096); kf[5]=*(const __attribute__((address_space(3))) bf16x8*)(kp+4608);
  kf[6]=*(const __attribute__((address_space(3))) bf16x8*)(kp+6144); kf[7]=*(const __attribute__((address_space(3))) bf16x8*)(kp+6656);
}
__device__ __forceinline__ void kload2(bf16x8*kf,lds_cptr kp,int j){ kf[2*j]=*(const __attribute__((address_space(3))) bf16x8*)(kp+j*2048); kf[2*j+1]=*(const __attribute__((address_space(3))) bf16x8*)(kp+j*2048+512); }
__device__ __forceinline__ s16x4 vtr(lds_cptr p){ return __builtin_bit_cast(s16x4,__builtin_amdgcn_ds_read_tr16_b64_v4i16((__attribute__((address_space(3))) v4i16_t*)p)); }
__device__ __forceinline__ float rowmax(const f32x16&p0,const f32x16&p1){
  float a=max3f(p0[0],p0[1],p1[0]),b=max3f(p0[2],p0[3],p1[1]);a=max3f(a,p1[2],p1[3]);
  #pragma unroll
  for(int r=4;r<16;r+=4){a=max3f(a,p0[r],p0[r+1]);b=max3f(b,p0[r+2],p0[r+3]);a=max3f(a,p1[r],p1[r+1]);b=max3f(b,p1[r+2],p1[r+3]);}
  const float m=max2f(a,b);
  auto rr=__builtin_amdgcn_permlane32_swap(__float_as_uint(m),__float_as_uint(m),false,false);
  return max2f(__uint_as_float(rr[0]),__uint_as_float(rr[1]));
}
__device__ __forceinline__ void pv(f32x16*o,int vb,bf16x8 pa0,bf16x8 pa1,bf16x8 pa2,bf16x8 pa3){
  #pragma unroll
  for(int d0=0;d0<2;++d0){s16x4 lo[4],hi[4];
    #pragma unroll
    for(int ks=0;ks<4;++ks){
      asm volatile("ds_read_b64_tr_b16 %0,%1 offset:%c2":"=&v"(lo[ks]):"v"(vb),"i"(d0*4096+ks*1024):"memory");
      asm volatile("ds_read_b64_tr_b16 %0,%1 offset:%c2":"=&v"(hi[ks]):"v"(vb),"i"(d0*4096+ks*1024+512):"memory");}
    asm volatile("s_waitcnt lgkmcnt(0)":::"memory");SBAR();
    #define PK(k) (bf16x8){lo[k][0],lo[k][1],lo[k][2],lo[k][3],hi[k][0],hi[k][1],hi[k][2],hi[k][3]}
    o[d0]=__builtin_amdgcn_mfma_f32_32x32x16_bf16(pa0,PK(0),o[d0],0,0,0);
    o[d0]=__builtin_amdgcn_mfma_f32_32x32x16_bf16(pa1,PK(1),o[d0],0,0,0);
    o[d0]=__builtin_amdgcn_mfma_f32_32x32x16_bf16(pa2,PK(2),o[d0],0,0,0);
    o[d0]=__builtin_amdgcn_mfma_f32_32x32x16_bf16(pa3,PK(3),o[d0],0,0,0);
    #undef PK
  }
}

#ifndef ATTN_STORE16
#define ATTN_STORE16(p,v) (*(u32x4*)(p)=(v))
#endif
template<int THRL,int MODE> __device__ __forceinline__ void attn_unit(const bf16*Qu,const int QP,const bf16*__restrict__ Kh,const int KP,const bf16*__restrict__ Vh,const int VP,bf16*Ou,const int OP,const int NT,char*shm,const int img_r0,const __attribute__((address_space(3))) float* rpb_tab){
  int tid_=threadIdx.x; asm volatile("":"+v"(tid_));
  const int tid=tid_,lane=tid&63,r32=lane&31,hi=lane>>5; const int wid=__builtin_amdgcn_readfirstlane(tid>>6);
  const bf16*Qw=Qu+(long)(wid*QBLK)*QP;
  const unsigned lds0=(unsigned)(uintptr_t)shm;
  float*wsf=(float*)(shm+LDS_WS)+wid*64;
  const bf16*ksrc=Kh+(long)lane*KP+wid*8;
  const bf16*vsrc=Vh+(long)(16*(wid&3)+(lane>>2))*VP+(wid>>2)*32+(lane&3)*8;
  const unsigned kdst=lds0+LDS_K+wid*1024, vdst=lds0+LDS_V+wid*1024;
  const int band0=(MODE==1)?min(max(img_r0-4,0),120):0;
  #define TROW(t) ((long)(t)*KVBLK+((MODE==1&&(t)>=4)?(long)band0*64:0l))
  #define DMA_K(t,slot) glds16(ksrc+TROW(t)*KP,(unsigned)__builtin_amdgcn_readfirstlane(kdst+(slot)))
  #define DMA_V(t,slot) glds16(vsrc+TROW(t)*VP,(unsigned)__builtin_amdgcn_readfirstlane(vdst+(slot)))
  const int vb0=(int)(lds0+LDS_V)+((lane>>4)&1)*32+(lane&3)*8+(4*hi+((lane&15)>>2))*64;
  const char*Kbase=shm+LDS_K; bf16x8 kf[8];
  const lds_cptr shm3=(lds_cptr)shm; const lds_cptr kp0=shm3+LDS_K+hi*1024+r32*16; const lds_cptr vp0=shm3+LDS_V+((lane>>4)&1)*32+(lane&3)*8+(4*hi+((lane&15)>>2))*64;
  DMA_K(0,0);DMA_V(0,0);DMA_K(1,SLOTB);
  bf16x8 qr[4];
  #pragma unroll
  for(int d0=0;d0<4;++d0)qr[d0]=*reinterpret_cast<const bf16x8*>(&Qw[(long)r32*QP+d0*16+hi*8]);
  if(MODE!=0){
    #pragma unroll
    for(int d0=0;d0<4;++d0){
      #pragma unroll
      for(int e=0;e<8;e+=2){ const float lo=__uint_as_float(((unsigned)(unsigned short)qr[d0][e])<<16)*C2, hi2=__uint_as_float(((unsigned)(unsigned short)qr[d0][e+1])<<16)*C2;
        const unsigned pk=cvtpk_s(lo,hi2); qr[d0][e]=(short)(pk&0xffffu); qr[d0][e+1]=(short)(pk>>16); } } }
  float mhat=0.f,l_reg=0.f;f32x16 o[2];o[0]=f32x16{};o[1]=f32x16{};f32x16 negm=f32x16{}; if(MODE!=1) asm volatile("":"+v"(negm));
  const int na_qc=32*(wid&1)+r32, na_cs=min(max(na_qc-8,0),48), na_r=img_r0+(wid>>1), na_rs=min(max(na_r-4,0),120);
  #define CMASK(P0,P1,t) do{ if(MODE==1&&(t)>=4){ const int br_=band0+(t)-4; const bool rok_=(br_>=na_rs)&&(br_<na_rs+8); \
      int qcl_=na_qc, csl_=na_cs, hil_=hi; asm volatile("":"+v"(qcl_),"+v"(csl_),"+v"(hil_));     \
      const int brow_=(rok_?(br_-na_r+7):0)*31-qcl_+15; \
      _Pragma("unroll") for(int r_=0;r_<16;++r_){ const int kc_=crow(r_,hil_); \
        const bool ok0_=rok_&&(kc_>=csl_)&&(kc_<csl_+16), ok1_=rok_&&(kc_+32>=csl_)&&(kc_+32<csl_+16); \
        const float b0_=rpb_tab[ok0_?brow_+kc_:0], b1_=rpb_tab[ok1_?brow_+kc_+32:0]; \
        P0[r_]=ok0_?P0[r_]+b0_*1.4426950408889634f:-INFINITY; P1[r_]=ok1_?P1[r_]+b1_*1.4426950408889634f:-INFINITY; } } }while(0)
  #define SUBREF(P0,P1) do{ if(MODE==1){ _Pragma("unroll") for(int r_=0;r_<16;++r_){P0[r_]-=mhat;P1[r_]-=mhat;} } }while(0)
  #define NEGMC ((MODE==1)?f32x16{}:negm)
  bool resc=false;
  #define START(P0,P1) do{ const float rm=rowmax(P0,P1); resc=false; \
    { const float dl=rm; mhat=fadd_s(mhat,dl); \
      _Pragma("unroll") for(int r=0;r<16;++r){P0[r]=fsub_s(P0[r],dl);P1[r]=fsub_s(P1[r],dl);} \
      if(MODE!=1){ _Pragma("unroll") for(int r=0;r<16;++r)negm[r]=-mhat; asm volatile("":"+v"(negm)); } } \
    _Pragma("unroll") for(int r=0;r<16;++r)P0[r]=__builtin_amdgcn_exp2f(P0[r]); }while(0)
  #define RESC() do{ if(resc){ asm volatile("s_waitcnt lgkmcnt(0)":::"memory"); \
      _Pragma("unroll") for(int d_=0;d_<2;++d_) _Pragma("unroll") for(int r=0;r<16;++r)o[d_][r]*=wsf[crow(r,hi)]; } }while(0)
  f32x16 pA0,pA1,pB0,pB1;
  int sl_prev=0,sl_cur=0,sl_next=SLOTB;
  #define ROT() do{sl_prev=sl_cur;sl_cur=sl_next;sl_next=(sl_next==(NSLOT-1)*SLOTB)?0:sl_next+SLOTB;}while(0)
  DMA_K(2,2*SLOTB);
  WAIT_BAR(3);
  qkt(pA0,pA1,Kbase,qr,negm,r32,hi);asm volatile("s_nop 15\n\ts_nop 7":"+v"(pA0),"+v"(pA1));CMASK(pA0,pA1,0);
  START(pA0,pA1);
  _Pragma("unroll") for(int r=0;r<16;++r)pA1[r]=__builtin_amdgcn_exp2f(pA1[r]);
  WAIT_BAR(0);
  DMA_K(3,0);DMA_V(1,SLOTB);
  ROT();
  kload8(kf,kp0+sl_cur);
  WAIT_BAR(2);
  s16x4 vlo[8],vhi[8]; u32x4 pw0,pw1,pw2,pw3;
  #define PKW(P,B) cvtpk_s(P[B],P[B+1])
  #define PAF(k) __builtin_bit_cast(bf16x8,pw##k)
  #define VFR(i) (bf16x8){vlo[i][0],vlo[i][1],vlo[i][2],vlo[i][3],vhi[i][0],vhi[i][1],vhi[i][2],vhi[i][3]}
  #define PIN(x) asm volatile("":"+v"(x))
  #define MX3(a,b,c) __builtin_fmaxf(__builtin_fmaxf((a),(b)),(c))
  #define GAPA(MF,A0,A1,A2,A3,W0,W1,PW) do{ MF; sacc+=A0; sacc+=A1; sacc+=A2; sacc+=A3; PIN(sacc); W0; W1; PIN(PW); SBAR(); }while(0)
  #define EX(v) __builtin_amdgcn_exp2f(v)
  #define GAPB(MF,X,B) do{ MF; X[B]=EX(X[B]); X[B+1]=EX(X[B+1]); X[B+2]=EX(X[B+2]); X[B+3]=EX(X[B+3]); PIN(X); SBAR(); }while(0)
  #define VRD(i) do{ vlo[i]=vtr(vp_+(((i)>>2)*4096+((i)&3)*1024)); vhi[i]=vtr(vp_+(((i)>>2)*4096+((i)&3)*1024+512)); }while(0)
  #define KRD(G,j) do{ if(G){ kload2(kf,kp0+sl_next,j); SBAR(); } }while(0)
  #define STEP(C0,C1,P0,P1,t,GK,GV,GL) do{ SBAR(); \
    const lds_cptr vp_=vp0+sl_prev; \
    VRD(0); SBAR(); float sacc=(P0[0]+P0[1]); \
    GAPA(C0=__builtin_amdgcn_mfma_f32_32x32x16_bf16(kf[0],qr[0],NEGMC,0,0,0), P0[2],P0[3],P0[4],P0[5],     pw0[0]=PKW(P0,0), pw0[1]=PKW(P0,2), pw0); \
    VRD(4); SBAR(); GAPA(C1=__builtin_amdgcn_mfma_f32_32x32x16_bf16(kf[1],qr[0],NEGMC,0,0,0), P0[6],P0[7],P0[8],P0[9],     pw0[2]=PKW(P0,4), pw0[3]=PKW(P0,6), pw0); \
    VRD(1); SBAR(); GAPA(C0=__builtin_amdgcn_mfma_f32_32x32x16_bf16(kf[2],qr[1],C0,0,0,0),   P0[10],P0[11],P0[12],P0[13], pw1[0]=PKW(P0,8), pw1[1]=PKW(P0,10), pw1); \
    VRD(5); SBAR(); GAPA(C1=__builtin_amdgcn_mfma_f32_32x32x16_bf16(kf[3],qr[1],C1,0,0,0),   P0[14],P0[15],P1[0],P1[1],   pw1[2]=PKW(P0,12),pw1[3]=PKW(P0,14), pw1); \
    VRD(2); SBAR(); GAPA(C0=__builtin_amdgcn_mfma_f32_32x32x16_bf16(kf[4],qr[2],C0,0,0,0),   P1[2],P1[3],P1[4],P1[5],     pw2[0]=PKW(P1,0), pw2[1]=PKW(P1,2), pw2); \
    VRD(6); SBAR(); GAPA(C1=__builtin_amdgcn_mfma_f32_32x32x16_bf16(kf[5],qr[2],C1,0,0,0),   P1[6],P1[7],P1[8],P1[9],     pw2[2]=PKW(P1,4), pw2[3]=PKW(P1,6), pw2); \
    VRD(3); SBAR(); GAPA(C0=__builtin_amdgcn_mfma_f32_32x32x16_bf16(kf[6],qr[3],C0,0,0,0),   P1[10],P1[11],P1[12],P1[13], pw3[0]=PKW(P1,8), pw3[1]=PKW(P1,10), pw3); \
    VRD(7); SBAR(); GAPA(C1=__builtin_amdgcn_mfma_f32_32x32x16_bf16(kf[7],qr[3],C1,0,0,0),   P1[14],P1[15],0.f,0.f,       pw3[2]=PKW(P1,12),pw3[3]=PKW(P1,14), pw3); \
    l_reg+=sacc; \
    if(GK){DMA_K((t)+3,sl_cur);} if(GV){DMA_V((t)+1,sl_next);} \
    SUBREF(C0,C1); CMASK(C0,C1,t); \
    { float a=MX3(C0[0],C0[1],C1[0]),b=MX3(C0[2],C0[3],C1[1]); a=MX3(a,C1[2],C1[3]); \
      _Pragma("unroll") for(int r=4;r<16;r+=4){a=MX3(a,C0[r],C0[r+1]);b=MX3(b,C0[r+2],C0[r+3]);a=MX3(a,C1[r],C1[r+1]);b=MX3(b,C1[r+2],C1[r+3]);} \
      float rm=__builtin_fmaxf(a,b); { auto rr=__builtin_amdgcn_permlane32_swap(__float_as_uint(rm),__float_as_uint(rm),false,false); rm=__builtin_fmaxf(__uint_as_float(rr[0]),__uint_as_float(rr[1])); } \
      resc=false; \
      if(__builtin_expect(__any(rm>(float)THRL),0)){ const float dl=__builtin_fmaxf(rm,0.f); mhat+=dl; \
        _Pragma("unroll") for(int r=0;r<16;++r){C0[r]-=dl;C1[r]-=dl;} \
        if(MODE!=1){ _Pragma("unroll") for(int r=0;r<16;++r)negm[r]=-mhat; asm volatile("":"+v"(negm)); } \
        const float f=__builtin_amdgcn_exp2f(-dl); l_reg*=f; if(hi==0)wsf[r32]=f; resc=true; } } \
    SBAR(); \
    GAPB(o[0]=__builtin_amdgcn_mfma_f32_32x32x16_bf16(PAF(0),VFR(0),o[0],0,0,0), C0,0); \
    GAPB(o[1]=__builtin_amdgcn_mfma_f32_32x32x16_bf16(PAF(0),VFR(4),o[1],0,0,0), C0,4); \
    KRD(GL,0); GAPB(o[0]=__builtin_amdgcn_mfma_f32_32x32x16_bf16(PAF(1),VFR(1),o[0],0,0,0), C0,8); \
    KRD(GL,1); GAPB(o[1]=__builtin_amdgcn_mfma_f32_32x32x16_bf16(PAF(1),VFR(5),o[1],0,0,0), C0,12); \
    KRD(GL,2); GAPB(o[0]=__builtin_amdgcn_mfma_f32_32x32x16_bf16(PAF(2),VFR(2),o[0],0,0,0), C1,0); \
    KRD(GL,3); GAPB(o[1]=__builtin_amdgcn_mfma_f32_32x32x16_bf16(PAF(2),VFR(6),o[1],0,0,0), C1,4); \
    GAPB(o[0]=__builtin_amdgcn_mfma_f32_32x32x16_bf16(PAF(3),VFR(3),o[0],0,0,0), C1,8); \
    GAPB(o[1]=__builtin_amdgcn_mfma_f32_32x32x16_bf16(PAF(3),VFR(7),o[1],0,0,0), C1,12); \
    }while(0)
  int t=1;
  for(;t+5<NT;t+=2){
    STEP(pB0,pB1,pA0,pA1,t,true,true,true);     WAIT_BAR(2); RESC(); ROT();
    STEP(pA0,pA1,pB0,pB1,t+1,true,true,true);   WAIT_BAR(2); RESC(); ROT();
  }
  #define ENDW(tt) do{ if((tt)+3<NT){WAIT_BAR(2);} else if((tt)+2<NT){WAIT_BAR(1);} else {WAIT_BAR(0);} }while(0)
  for(;t+1<NT;t+=2){
    STEP(pB0,pB1,pA0,pA1,t,(t+3<NT),(t+1<NT),(t+1<NT));       ENDW(t);   RESC(); ROT();
    STEP(pA0,pA1,pB0,pB1,t+1,(t+4<NT),(t+2<NT),(t+2<NT));     ENDW(t+1); RESC(); ROT();
  }
  STEP(pB0,pB1,pA0,pA1,NT-1,false,false,false); RESC();
  { float sacc=pB0[0]+pB0[1]; _Pragma("unroll") for(int r=2;r<16;++r)sacc+=pB0[r]; _Pragma("unroll") for(int r=0;r<16;++r)sacc+=pB1[r]; l_reg+=sacc;
    pw0=(u32x4){PKW(pB0,0),PKW(pB0,2),PKW(pB0,4),PKW(pB0,6)};pw1=(u32x4){PKW(pB0,8),PKW(pB0,10),PKW(pB0,12),PKW(pB0,14)};pw2=(u32x4){PKW(pB1,0),PKW(pB1,2),PKW(pB1,4),PKW(pB1,6)};pw3=(u32x4){PKW(pB1,8),PKW(pB1,10),PKW(pB1,12),PKW(pB1,14)};
    SBAR(); pv(o,vb0+sl_cur,PAF(0),PAF(1),PAF(2),PAF(3)); }
  #undef PKW
  #undef PAF
  #undef VFR
  #undef PIN
  #undef MX3
  #undef GAPA
  #undef GAPB
  #undef EX
  #undef VRD
  #undef KRD
  #undef STEP
  #undef ENDW
  {auto rr=__builtin_amdgcn_permlane32_swap(__float_as_uint(l_reg),__float_as_uint(l_reg),false,false);l_reg=__uint_as_float(rr[0])+__uint_as_float(rr[1]);}
  if(hi==0)wsf[32+r32]=l_reg;asm volatile("s_waitcnt lgkmcnt(0)":::"memory");
  float rli[16];
  #pragma unroll
  for(int r=0;r<16;++r)rli[r]=__builtin_amdgcn_rcpf(wsf[32+crow(r,hi)]);
  bf16*Ow=Ou+(long)(wid*QBLK)*OP;
  { bf16*stg=(bf16*)(shm+LDS_OST)+wid*2048;
    #pragma unroll
    for(int r=0;r<16;++r){const int orow=crow(r,hi);
      #pragma unroll
      for(int d0=0;d0<2;++d0)stg[orow*64+d0*32+r32]=__float2bfloat16(o[d0][r]*rli[r]);}
    asm volatile("s_waitcnt lgkmcnt(0)":::"memory");
    #pragma unroll
    for(int i=0;i<4;++i){const int row=i*8+(lane>>3),ch=lane&7; const u32x4 v=*(const u32x4*)(stg+row*64+ch*8); ATTN_STORE16(Ow+(long)row*OP+ch*8,v);} }
  asm volatile("s_waitcnt lgkmcnt(0)\n\ts_barrier":::"memory");
  #undef DMA_K
  #undef DMA_V
  #undef TROW
  #undef CMASK
  #undef SUBREF
  #undef NEGMC
  #undef START
  #undef RESC
  #undef ROT
}
constexpr int ATTN_LDS_BYTES=LDS_BYTES;
#undef SBAR
#undef WAIT_BAR
}

constexpr int D = 2048, T = 8192, LC = 256, MT = T + LC, DEPTH = 4;
constexpr int INW = 5408, INWP = 5632;
constexpr int C_NAQ = 0, C_NAK = 512, C_NAV = 1024, C_GQ = 1536, C_GK = 2048, C_GV = 2560, C_GG = 3584, C_GLR = 4608, C_CQ = 4640, C_CK = 5152, C_CV = 5280;
constexpr int NCH = MT / 64;
constexpr float LN_EPS = 1e-6f, ALPHA = 1.681792830507429f;
constexpr int NEXP = 16384;

constexpr size_t MiB = 1u << 20;
constexpr size_t WS_CTL = 0, CTL_ZERO_BYTES = 1 * MiB;
constexpr size_t WS_MOD = 1 * MiB;
constexpr size_t WS_ROPE = WS_MOD + 512 * 1024;
constexpr size_t WS_WIN = 2 * MiB;
constexpr size_t WS_WOUT = WS_WIN + 88 * MiB;
constexpr size_t WS_WP = WS_WOUT + 32 * MiB;
constexpr size_t WS_X = WS_WP + 32 * MiB;
constexpr size_t WS_Z = WS_X + 66 * MiB;
constexpr size_t WS_H = WS_Z + 66 * MiB;
constexpr size_t WS_P = WS_H + 33 * MiB;
constexpr size_t WS_QC = WS_P + 91 * MiB;
constexpr size_t WS_KC = WS_QC + 9 * MiB;
constexpr size_t WS_QTF = WS_KC + 3 * MiB;
constexpr size_t WS_QTB = WS_QTF + 9 * MiB;
constexpr size_t WS_OI = WS_QTB + 9 * MiB;
constexpr size_t WS_UPD = WS_OI + 33 * MiB;
constexpr size_t WS_SPREV = WS_UPD + 132 * MiB;
constexpr size_t WS_DEC = WS_SPREV + 132 * MiB;
constexpr size_t WS_MIX = WS_DEC + 1 * MiB;
constexpr size_t WS_ST = WS_MIX + 33 * MiB;
constexpr size_t WS_IDX = WS_ST + 66 * MiB;
constexpr size_t WS_GATE = WS_IDX + 5 * MiB;
constexpr size_t WS_PU = WS_GATE + 5 * MiB;
constexpr size_t WS_PV = WS_PU + 128 * MiB;
constexpr size_t WS_SCU = WS_PV + 128 * MiB;
constexpr size_t WS_SCV = WS_SCU + 1 * MiB;
constexpr size_t WS_VC = WS_SCV + 1 * MiB;
constexpr size_t WS_ACT = WS_VC + 3 * MiB;
constexpr size_t WS_PART = WS_ACT + 5 * MiB;
constexpr size_t WS_END = WS_PART + 67 * MiB;
constexpr int CW_BAR = 4096;

constexpr int RING_BYTES = 147456;
constexpr int LDSCTL_OFF = RING_BYTES, MISC_OFF = LDSCTL_OFF + 320;
constexpr int LDS_BYTES = 148480;
constexpr int NWAVES = 8, NT = 512;

#ifndef REP_MASK
#define REP_MASK 0
#endif
#define RP(b) ((((REP_MASK) >> (b)) & 1) ? 2 : 1)
#define GAS __attribute__((address_space(1)))
#define LAS __attribute__((address_space(3)))
typedef unsigned short bf16;
typedef unsigned v4u __attribute__((ext_vector_type(4)));
typedef unsigned v2u __attribute__((ext_vector_type(2)));
typedef float f32x4 __attribute__((ext_vector_type(4)));
typedef float f32x2 __attribute__((ext_vector_type(2)));
typedef short bf16x8v __attribute__((ext_vector_type(8)));
typedef float f32x16v __attribute__((ext_vector_type(16)));
#define LDS_WAIT() asm volatile("s_waitcnt lgkmcnt(0)" ::: "memory")
__device__ __forceinline__ unsigned f2bf(float f) { return (unsigned)__builtin_bit_cast(unsigned short, (__bf16)f); }
typedef __bf16 bf16x2_t __attribute__((ext_vector_type(2)));
__device__ __forceinline__ unsigned pk2(float lo, float hi) { const bf16x2_t b = __builtin_convertvector((f32x2){lo, hi}, bf16x2_t); return __builtin_bit_cast(unsigned, b); }
__device__ __forceinline__ float bflo(unsigned w) { return __builtin_bit_cast(float, w << 16); }
__device__ __forceinline__ float bfhi(unsigned w) { return __builtin_bit_cast(float, w & 0xffff0000u); }
__device__ __forceinline__ float bf1(bf16 v) { return __builtin_bit_cast(float, (unsigned)v << 16); }
__device__ __forceinline__ float wave_sum(float v) {
#pragma unroll
    for (int o = 1; o < 64; o <<= 1) v += __shfl_xor(v, o);
    return v;
}
__device__ __forceinline__ float silu_f(float x) { return x / (1.f + __expf(-x)); }
__device__ __forceinline__ float gelu_tanh(float x) { const float u = 0.7978845608028654f * (x + 0.044715f * x * x * x); const float t = 1.f - 2.f / (1.f + __expf(2.f * u)); return 0.5f * x * (1.f + t); }
__device__ __forceinline__ float logsigmoid_f(float z) { return fminf(z, 0.f) - __logf(1.f + __expf(-fabsf(z))); }

#define XB_TMO      128
#define XB_XCNT(j)  (256  + 64 * (j))
#define XB_XSUB(j)  (1280 + 64 * (j))
#define XB_XGEN(j)  (2304 + 64 * (j))
#define XB_TOP      3328
#define XB_TOPGEN   3392
#define XCD_BAR_WORDS 3456
#define XB_SPIN_CAP (1u << 21)
__device__ __forceinline__ unsigned xb_ld(unsigned* p)              { return __hip_atomic_load(p, __ATOMIC_RELAXED, __HIP_MEMORY_SCOPE_AGENT); }
__device__ __forceinline__ unsigned xb_add(unsigned* p, unsigned v) { return __hip_atomic_fetch_add(p, v, __ATOMIC_RELAXED, __HIP_MEMORY_SCOPE_AGENT); }
__device__ __forceinline__ unsigned xb_xcc_id() { return (unsigned)__builtin_amdgcn_s_getreg((3 << 11) | 20) & 0xFu; }
#define XB_SPIN(cond, bar) do { unsigned _sp = 0; while (cond) { __builtin_amdgcn_s_sleep(1); \
    if ((++_sp & 255u) == 0u) { if (xb_ld(&(bar)[XB_TMO])) break; if (_sp > XB_SPIN_CAP) { atomicAdd(&(bar)[XB_TMO], 1u); break; } } } } while (0)
struct XcdBarrier { unsigned* bar; unsigned x; volatile LAS unsigned* st; };
__device__ __forceinline__ XcdBarrier xcd_barrier_post(unsigned* bar, volatile LAS unsigned* st) {
    XcdBarrier b; b.bar = bar; b.x = xb_xcc_id(); b.st = st;
    if (threadIdx.x == 0) (void)xb_add(&bar[XB_XCNT(b.x)], 1u);
    return b;
}
__device__ __forceinline__ void xcd_barrier_complete(unsigned* bar, unsigned x, unsigned& nloc, unsigned& nx) {
    const unsigned G = gridDim.x * gridDim.y * gridDim.z;
    unsigned sum, cnt, mine, sp = 0u;
    for (;;) {
        sum = 0u; cnt = 0u; mine = 0u;
#pragma unroll
        for (unsigned j = 0; j < 16; ++j) { const unsigned c = xb_ld(&bar[XB_XCNT(j)]); sum += c; cnt += (c > 0u) ? 1u : 0u; mine = (j == x) ? c : mine; }
        if (sum == G) break;
        __builtin_amdgcn_s_sleep(1);
        if ((++sp & 255u) == 0u) { if (xb_ld(&bar[XB_TMO])) break; if (sp > XB_SPIN_CAP) { atomicAdd(&bar[XB_TMO], 1u); break; } }
    }
    nloc = mine > 0u ? mine : 1u; nx = cnt > 0u ? cnt : 1u;
}
__device__ __forceinline__ void xcd_barrier(const XcdBarrier& b) {
    asm volatile("s_waitcnt vmcnt(0)" ::: "memory");
    __syncthreads();
    if (threadIdx.x == 0) {
        unsigned* bar = b.bar;
        __builtin_amdgcn_s_waitcnt(0);
        unsigned nloc = b.st[0], nx = b.st[1];
        if (nloc == 0u) { xcd_barrier_complete(bar, b.x, nloc, nx); b.st[0] = nloc; b.st[1] = nx; }
        const unsigned old = xb_add(&bar[XB_XSUB(b.x)], 1u);
        const unsigned gen = old / nloc;
        if (old + 1u == (gen + 1u) * nloc) {
            __builtin_amdgcn_fence(__ATOMIC_RELEASE, "agent");
            asm volatile("s_waitcnt vmcnt(0)" ::: "memory");
            const unsigned og = xb_add(&bar[XB_TOP], 1u);
            const unsigned tg = og / nx;
            if (og + 1u == (tg + 1u) * nx) xb_add(&bar[XB_TOPGEN], 1u);
            else XB_SPIN(xb_ld(&bar[XB_TOPGEN]) == tg, bar);
            __builtin_amdgcn_fence(__ATOMIC_ACQUIRE, "agent");
            xb_add(&bar[XB_XGEN(b.x)], 1u);
            asm volatile("s_waitcnt vmcnt(0)" ::: "memory");
        } else {
            XB_SPIN(xb_ld(&bar[XB_XGEN(b.x)]) == gen, bar);
            __builtin_amdgcn_fence(__ATOMIC_ACQUIRE, "agent");
            asm volatile("s_waitcnt vmcnt(0)" ::: "memory");
        }
    }
    __syncthreads();
}

struct Args { const float* in[22]; float* out; unsigned char* ws; int ph_lo, ph_hi; };
struct Frame {
    LAS unsigned char* lds; char* ldsg;
    int tid, lane, wave, vcu, G;
    const __attribute__((address_space(4))) Args* ap;
};
#define IN_X(F) ((F).ap->in[0])
#define IN_C(F) ((F).ap->in[1])
#define IN_CTX(F) ((F).ap->in[2])
#define IN_CCTX(F) ((F).ap->in[3])
#define IN_WMOD(F) ((F).ap->in[4])
#define IN_BMOD(F) ((F).ap->in[5])
#define IN_WIN(F) ((F).ap->in[6])
#define IN_RPB(F) ((F).ap->in[7])
#define IN_GGW(F) ((F).ap->in[8])
#define IN_GGB(F) ((F).ap->in[9])
#define IN_GNW(F) ((F).ap->in[10])
#define IN_QNW(F) ((F).ap->in[11])
#define IN_KNW(F) ((F).ap->in[12])
#define IN_WOUT(F) ((F).ap->in[13])
#define IN_LN1G(F) ((F).ap->in[14])
#define IN_LN1B(F) ((F).ap->in[15])
#define IN_WQ(F) ((F).ap->in[16])
#define IN_SUBK(F) ((F).ap->in[17])
#define IN_PU(F) ((F).ap->in[18])
#define IN_PV(F) ((F).ap->in[19])
#define IN_LN2G(F) ((F).ap->in[20])
#define IN_LN2B(F) ((F).ap->in[21])
#define WSP(F, T_, off) ((T_*)((F).ap->ws + (off)))
__device__ __forceinline__ void launder(Frame& F) { int t_ = F.tid; asm volatile("" : "+v"(t_)); F.tid = t_; F.lane = t_ & 63; F.wave = __builtin_amdgcn_readfirstlane(t_ >> 6);
    const __attribute__((address_space(4))) Args* a_ = F.ap; asm volatile("" : "+s"(a_)); F.ap = a_; }

__device__ __forceinline__ void row_load_f32(const float* row, int lane, float (&v)[32]) {
#pragma unroll
    for (int j = 0; j < 4; ++j) { const f32x4 a = *(const f32x4*)(row + 8 * lane + 512 * j), b = *(const f32x4*)(row + 8 * lane + 512 * j + 4);
        v[8 * j + 0] = a[0]; v[8 * j + 1] = a[1]; v[8 * j + 2] = a[2]; v[8 * j + 3] = a[3]; v[8 * j + 4] = b[0]; v[8 * j + 5] = b[1]; v[8 * j + 6] = b[2]; v[8 * j + 7] = b[3]; }
}
__device__ __forceinline__ void row_store_f32(float* row, int lane, const float (&v)[32]) {
#pragma unroll
    for (int j = 0; j < 4; ++j) { *(f32x4*)(row + 8 * lane + 512 * j) = (f32x4){v[8 * j], v[8 * j + 1], v[8 * j + 2], v[8 * j + 3]}; *(f32x4*)(row + 8 * lane + 512 * j + 4) = (f32x4){v[8 * j + 4], v[8 * j + 5], v[8 * j + 6], v[8 * j + 7]}; }
}
__device__ __forceinline__ void row_load_bf16(const bf16* row, int lane, float (&v)[32]) {
#pragma unroll
    for (int j = 0; j < 4; ++j) { const v4u w = *(const v4u*)(row + 8 * lane + 512 * j);
        v[8 * j + 0] = bflo(w.x); v[8 * j + 1] = bfhi(w.x); v[8 * j + 2] = bflo(w.y); v[8 * j + 3] = bfhi(w.y); v[8 * j + 4] = bflo(w.z); v[8 * j + 5] = bfhi(w.z); v[8 * j + 6] = bflo(w.w); v[8 * j + 7] = bfhi(w.w); }
}
__device__ __forceinline__ void row_fetch_bf16(const bf16* row, int lane, v4u (&w)[4]) {
#pragma unroll
    for (int j = 0; j < 4; ++j) w[j] = *(const v4u*)(row + 8 * lane + 512 * j);
}
__device__ __forceinline__ void row_expand_bf16(const v4u (&w)[4], float (&v)[32]) {
#pragma unroll
    for (int j = 0; j < 4; ++j) { v[8 * j + 0] = bflo(w[j].x); v[8 * j + 1] = bfhi(w[j].x); v[8 * j + 2] = bflo(w[j].y); v[8 * j + 3] = bfhi(w[j].y); v[8 * j + 4] = bflo(w[j].z); v[8 * j + 5] = bfhi(w[j].z); v[8 * j + 6] = bflo(w[j].w); v[8 * j + 7] = bfhi(w[j].w); }
}
__device__ __forceinline__ void row_store_bf16(bf16* row, int lane, const float (&v)[32]) {
#pragma unroll
    for (int j = 0; j < 4; ++j) { v4u w; w.x = pk2(v[8 * j], v[8 * j + 1]); w.y = pk2(v[8 * j + 2], v[8 * j + 3]); w.z = pk2(v[8 * j + 4], v[8 * j + 5]); w.w = pk2(v[8 * j + 6], v[8 * j + 7]); *(v4u*)(row + 8 * lane + 512 * j) = w; }
}
__device__ __forceinline__ void row_norm(float (&v)[32]) {
    float s = 0.f;
#pragma unroll
    for (int i = 0; i < 32; ++i) s += v[i];
    const float mean = wave_sum(s) * (1.f / D); float q = 0.f;
#pragma unroll
    for (int i = 0; i < 32; ++i) { v[i] -= mean; q += v[i] * v[i]; }
    const float rstd = rsqrtf(wave_sum(q) * (1.f / D) + LN_EPS);
#pragma unroll
    for (int i = 0; i < 32; ++i) v[i] *= rstd;
}
__device__ __forceinline__ void row_affine(float (&v)[32], const float* mul, const float* add, int lane, float one) {
#pragma unroll
    for (int j = 0; j < 4; ++j)
#pragma unroll
        for (int h = 0; h < 2; ++h) { const f32x4 m = *(const f32x4*)(mul + 8 * lane + 512 * j + 4 * h), a = *(const f32x4*)(add + 8 * lane + 512 * j + 4 * h);
#pragma unroll
            for (int c = 0; c < 4; ++c) v[8 * j + 4 * h + c] = v[8 * j + 4 * h + c] * (one + m[c]) + a[c]; }
}

__device__ __forceinline__ void p0_transpose_item(const float* W, int K, int N, bf16* WT, LAS float* scr, int item, int lane) {
    const int nblk = N / 32, kb = item / nblk, nb = item % nblk, k0 = 64 * kb, n0 = 32 * nb;
#pragma unroll 8
    for (int i = 0; i < 32; ++i) { const int kk = 2 * i + (lane >> 5); scr[kk * 33 + (lane & 31)] = W[(size_t)(k0 + kk) * N + n0 + (lane & 31)]; }
    LDS_WAIT(); asm volatile("" ::: "memory");
    const int c = lane & 7;
#pragma unroll
    for (int j = 0; j < 4; ++j) { const int n = (lane >> 3) + 8 * j; const LAS float* s = scr + (8 * c) * 33 + n;
        v4u o; o.x = pk2(s[0 * 33], s[1 * 33]); o.y = pk2(s[2 * 33], s[3 * 33]); o.z = pk2(s[4 * 33], s[5 * 33]); o.w = pk2(s[6 * 33], s[7 * 33]);
        *(v4u*)(WT + (size_t)(n0 + n) * K + k0 + 8 * c) = o; }
    LDS_WAIT(); asm volatile("" ::: "memory");
}

__device__ __forceinline__ void phase_prologue_a(Frame& F) {
    launder(F);
    const int tid = F.tid, lane = F.lane, wave = F.wave;
    for (int rp = 0; rp < RP(16); ++rp) {
        LAS float* sc = (LAS float*)F.lds;
        LAS float* red = sc + 4096;
        for (int i = tid; i < D; i += NT) { sc[i] = silu_f(IN_C(F)[i]); sc[D + i] = silu_f(IN_CCTX(F)[i]); }
        __syncthreads();
        for (int u = F.vcu; u < DEPTH * 96; u += F.G) {
            const int l = u / 96, cg = u % 96;
            const float* W = IN_WMOD(F) + (size_t)l * D * 12288 + cg * 128 + 2 * lane;
            const int k0 = wave * 256; float a0 = 0.f, a1 = 0.f, b0 = 0.f, b1 = 0.f;
#pragma unroll 8
            for (int kk = 0; kk < 256; ++kk) { const f32x2 w = *(const f32x2*)(W + (size_t)(k0 + kk) * 12288); const float s0 = sc[k0 + kk], s1 = sc[D + k0 + kk];
                a0 += s0 * w.x; a1 += s0 * w.y; b0 += s1 * w.x; b1 += s1 * w.y; }
            LAS float* r = red + (wave * 64 + lane) * 4; r[0] = a0; r[1] = a1; r[2] = b0; r[3] = b1;
            __syncthreads();
            if (wave == 0) { float s[4] = {0.f, 0.f, 0.f, 0.f};
#pragma unroll
                for (int w = 0; w < 8; ++w)
#pragma unroll
                    for (int c = 0; c < 4; ++c) s[c] += red[(w * 64 + lane) * 4 + c];
                const int col = cg * 128 + 2 * lane; const float* bm = IN_BMOD(F) + l * 12288 + col; float* mo = WSP(F, float, WS_MOD) + (size_t)l * 2 * 12288 + col;
                mo[0] = s[0] + bm[0]; mo[1] = s[1] + bm[1]; mo[12288] = s[2] + bm[0]; mo[12288 + 1] = s[3] + bm[1]; }
            __syncthreads();
        }
        __syncthreads();
    }
    for (int rp = 0; rp < RP(17); ++rp) {
        LAS float* scr = (LAS float*)(F.lds + wave * 16384);
        const int gw = F.vcu * NWAVES + wave, NGW = F.G * NWAVES;
        constexpr int I_IN = (D / 64) * (INW / 32), I_OUT = (D / 64) * (D / 32), I_L = I_IN + I_OUT;
        for (int it = gw; it < DEPTH * I_L; it += NGW) {
            const int l = it / I_L, r = it % I_L;
            if (r < I_IN) p0_transpose_item(IN_WIN(F) + (size_t)l * D * INW, D, INW, WSP(F, bf16, WS_WIN) + (size_t)l * INWP * D, scr, r, lane);
            else p0_transpose_item(IN_WOUT(F) + (size_t)l * D * D, D, D, WSP(F, bf16, WS_WOUT) + (size_t)l * D * D, scr, r - I_IN, lane);
        }
        const int gt = F.vcu * NT + tid, NGT = F.G * NT;
        for (int i = gt; i < DEPTH * 57344; i += NGT) { const int l = i / 57344, r = i % 57344; *(v4u*)(WSP(F, bf16, WS_WIN) + (size_t)l * INWP * D + (size_t)INW * D + (size_t)r * 8) = (v4u){0u, 0u, 0u, 0u}; }
        for (int i = gt; i < 2048; i += NGT) {
            const int pos = i >> 4, p = i & 15;
            const float invf[16] = {1.0f, 0.5623413324356079f, 0.3162277638912201f, 0.17782793939113617f, 0.10000000149011612f, 0.05623413249850273f, 0.03162277489900589f, 0.017782794311642647f,
                                    0.009999999776482582f, 0.005623413249850273f, 0.003162277629598975f, 0.0017782794311642647f, 0.0010000000474974513f, 0.000562341301701963f, 0.0003162277571391314f, 0.00017782794020604342f};
            float th_f = invf[0];
#pragma unroll
            for (int q = 1; q < 16; ++q) th_f = (p == q) ? invf[q] : th_f;
            const double th = (double)th_f, t2 = th * th;
            double cs = 1.0, sn = th, tc = 1.0, ts = th;
#pragma unroll
            for (int n = 1; n <= 10; ++n) { tc *= -t2 / (double)((2 * n - 1) * (2 * n)); ts *= -t2 / (double)((2 * n) * (2 * n + 1)); cs += tc; sn += ts; }
            double rc = 1.0, rs = 0.0, bc = cs, bs = sn;
#pragma unroll
            for (int b = 0; b < 7; ++b) { if ((pos >> b) & 1) { const double nc = rc * bc - rs * bs, ns = rc * bs + rs * bc; rc = nc; rs = ns; } const double nb = bc * bc - bs * bs, nbs = 2.0 * bc * bs; bc = nb; bs = nbs; }
            WSP(F, float, WS_ROPE)[i] = (float)rc; WSP(F, float, WS_ROPE)[2048 + i] = (float)rs;
        }
        __syncthreads();
    }
    for (int rp = 0; rp < RP(18); ++rp) {
        const int gw = F.vcu * NWAVES + wave, NGW = F.G * NWAVES;
        for (int r = gw; r < 2 * DEPTH * NEXP; r += NGW) {
            const bool isv = r >= DEPTH * NEXP; const int rr = isv ? r - DEPTH * NEXP : r;
            const float* src = (isv ? IN_PV(F) : IN_PU(F)) + (size_t)rr * D;
            float v[32]; row_load_f32(src, lane, v);
            float mx = 0.f;
#pragma unroll
            for (int i = 0; i < 32; ++i) mx = fmaxf(mx, fabsf(v[i]));
#pragma unroll
            for (int o = 1; o < 64; o <<= 1) mx = fmaxf(mx, __shfl_xor(mx, o));
            const float sc = mx > 0.f ? 240.f / mx : 0.f;
            unsigned char* dst = WSP(F, unsigned char, isv ? WS_PV : WS_PU) + (size_t)rr * D + 16 * lane;
#pragma unroll
            for (int hf = 0; hf < 2; ++hf) { v4u o;
#pragma unroll
                for (int w = 0; w < 4; ++w) { const int b = 8 * (2 * hf + (w >> 1)) + 4 * (w & 1); int p = 0;
                    p = __builtin_amdgcn_cvt_pk_fp8_f32(v[b] * sc, v[b + 1] * sc, p, false); p = __builtin_amdgcn_cvt_pk_fp8_f32(v[b + 2] * sc, v[b + 3] * sc, p, true); o[w] = (unsigned)p; }
                *(v4u*)(dst + 1024 * hf) = o; }
            if (lane == 0) WSP(F, float, WS_SCU)[2 * rr + (isv ? 1 : 0)] = mx * (1.f / 240.f);
        }
    }
    for (int rp = 0; rp < RP(19); ++rp) {
        const int gw = F.vcu * NWAVES + wave, NGW = F.G * NWAVES, fr = lane & 15, fq = lane >> 4;
        for (int task = gw; task < DEPTH * 16 * 4 * 32; task += NGW) {
            const int l = task >> 11, hp = (task >> 7) & 15, mt = (task >> 5) & 3, nt = task & 31;
            const float* wq = IN_WQ(F) + (size_t)l * D * D + (size_t)(64 * nt + fr) * D + hp * 128 + 8 * fq;
            const float* sk = IN_SUBK(F) + (((size_t)l * 16 + hp) * 128 + 32 * mt + fr) * 128 + 8 * fq;
            f32x4 acc[4][2];
#pragma unroll
            for (int n = 0; n < 4; ++n)
#pragma unroll
                for (int m = 0; m < 2; ++m) acc[n][m] = (f32x4){0.f, 0.f, 0.f, 0.f};
#pragma unroll 1
            for (int ks = 0; ks < 4; ++ks) {
                f32x4 ar[4][2], br[2][2];
#pragma unroll
                for (int n = 0; n < 4; ++n) { ar[n][0] = *(const f32x4*)(wq + (size_t)(16 * n) * D + 32 * ks); ar[n][1] = *(const f32x4*)(wq + (size_t)(16 * n) * D + 32 * ks + 4); }
#pragma unroll
                for (int m = 0; m < 2; ++m) { br[m][0] = *(const f32x4*)(sk + (16 * m) * 128 + 32 * ks); br[m][1] = *(const f32x4*)(sk + (16 * m) * 128 + 32 * ks + 4); }
                bf16x8v ah[4], al[4], bh[2], bl[2];
#pragma unroll
                for (int n = 0; n < 4; ++n)
#pragma unroll
                    for (int e = 0; e < 8; ++e) { const float x = ar[n][e >> 2][e & 3]; const unsigned hb = f2bf(x); ah[n][e] = (short)hb; al[n][e] = (short)f2bf(x - __builtin_bit_cast(float, hb << 16)); }
#pragma unroll
                for (int m = 0; m < 2; ++m)
#pragma unroll
                    for (int e = 0; e < 8; ++e) { const float x = br[m][e >> 2][e & 3]; const unsigned hb = f2bf(x); bh[m][e] = (short)hb; bl[m][e] = (short)f2bf(x - __builtin_bit_cast(float, hb << 16)); }
#pragma unroll
                for (int n = 0; n < 4; ++n)
#pragma unroll
                    for (int m = 0; m < 2; ++m) { acc[n][m] = __builtin_amdgcn_mfma_f32_16x16x32_bf16(ah[n], bh[m], acc[n][m], 0, 0, 0);
                        acc[n][m] = __builtin_amdgcn_mfma_f32_16x16x32_bf16(ah[n], bl[m], acc[n][m], 0, 0, 0); acc[n][m] = __builtin_amdgcn_mfma_f32_16x16x32_bf16(al[n], bh[m], acc[n][m], 0, 0, 0); }
            }
#pragma unroll
            for (int n = 0; n < 4; ++n)
#pragma unroll
                for (int m = 0; m < 2; ++m) { bf16* dst = WSP(F, bf16, WS_WP) + ((size_t)l * D + hp * 128 + 32 * mt + 16 * m + fr) * D + 64 * nt + 16 * n + 4 * fq;
                    *(v2u*)dst = (v2u){pk2(acc[n][m][0], acc[n][m][1]), pk2(acc[n][m][2], acc[n][m][3])}; }
        }
    }
}

__device__ __forceinline__ void phase_ln0(Frame& F) {
    launder(F);
    const int gw = F.vcu * NWAVES + F.wave, NGW = F.G * NWAVES, lane = F.lane;
    for (int m = gw; m < MT; m += NGW) {
        const float* src = (m < LC) ? IN_CTX(F) + (size_t)m * D : IN_X(F) + (size_t)(m - LC) * D;
        const float* mod = WSP(F, float, WS_MOD) + (m < LC ? 12288 : 0);
        float v[32]; row_load_f32(src, lane, v);
        row_store_bf16(WSP(F, bf16, WS_X) + (size_t)m * D, lane, v);
        row_norm(v); row_affine(v, mod + D, mod, lane, 1.f);
        row_store_bf16(WSP(F, bf16, WS_H) + (size_t)m * D, lane, v);
    }
}

__device__ __forceinline__ void phase_qknorm(Frame& F, int l) {
    launder(F);
    const int heavy = (NCH * 4 > 2 * F.G && NCH * 4 - 2 * F.G < F.G / 2) ? NCH * 4 - 2 * F.G : 0;
    if (F.vcu < heavy) return;
    const int gw = (F.vcu - heavy) * NWAVES + F.wave, NGW = (F.G - heavy) * NWAVES, lane = F.lane, p = lane & 31, hsel = lane >> 5;
    const float* rc = WSP(F, float, WS_ROPE); const float* rsn = rc + 2048;
    const bf16* P = WSP(F, bf16, WS_P);
    for (int m = gw; m < MT; m += NGW) {
#pragma unroll
        for (int it = 0; it < 5; ++it) {
            const int hv = 2 * it + hsel;
            const int col = (hv < 8) ? (C_CQ + hv * 64) : (C_CK + (hv - 8) * 64);
            const unsigned w = *(const unsigned*)(P + (size_t)m * INWP + col + 2 * p);
            float x0 = bflo(w), x1 = bfhi(w);
            float ss = x0 * x0 + x1 * x1;
#pragma unroll
            for (int o = 1; o < 32; o <<= 1) ss += __shfl_xor(ss, o);
            const float rstd = rsqrtf(ss * (1.f / 64.f) + LN_EPS);
            const float* nw = (hv < 8 ? IN_QNW(F) : IN_KNW(F)) + l * 64 + 2 * p;
            x0 = x0 * rstd * nw[0]; x1 = x1 * rstd * nw[1];
            if (m >= LC) { const int t = m - LC, pos = (p < 16) ? (t >> 6) : (t & 63); const float c = rc[pos * 16 + (p & 15)], s = rsn[pos * 16 + (p & 15)];
                const float y0 = x0 * c - x1 * s, y1 = x0 * s + x1 * c; x0 = y0; x1 = y1; }
            if (hv < 8) *(unsigned*)(WSP(F, bf16, WS_QC) + (size_t)m * 512 + hv * 64 + 2 * p) = pk2(x0 * attn_body::C2, x1 * attn_body::C2);
            else *(unsigned*)(WSP(F, bf16, WS_KC) + (size_t)m * 128 + (hv - 8) * 64 + 2 * p) = pk2(x0, x1);
        }
        if (lane < 16) *(v4u*)(WSP(F, bf16, WS_VC) + (size_t)m * 128 + lane * 8) = *(const v4u*)(P + (size_t)m * INWP + C_CV + lane * 8);
    }
}

constexpr int GL_BSTR = 130, GL_QSTR = 136, GL_TSTR = 72;
constexpr int GL_OFF_BB = 33280, GL_OFF_QX = 66560, GL_OFF_KX = 83968, GL_OFF_KET = 101376;
__device__ __forceinline__ int crow32(int r, int hi) { return (r & 3) + 8 * (r >> 2) + 4 * hi; }
__device__ __forceinline__ void phase_gla_chunk(Frame& F, int l) {
    launder(F);
    const int tid = F.tid, lane = F.lane, wave = F.wave;
    LAS float* BF = (LAS float*)F.lds; LAS float* BB = (LAS float*)(F.lds + GL_OFF_BB);
    LAS bf16* VT = (LAS bf16*)F.lds;
    LAS bf16* QX = (LAS bf16*)(F.lds + GL_OFF_QX); LAS bf16* KX = (LAS bf16*)(F.lds + GL_OFF_KX);
    LAS float* LR = (LAS float*)(F.lds + GL_OFF_QX); LAS bf16* AC = (LAS bf16*)(F.lds + GL_OFF_QX);
    LAS bf16* KET = (LAS bf16*)(F.lds + GL_OFF_KET);
    const bf16* P = WSP(F, bf16, WS_P);
    for (int u = F.vcu; u < NCH * 4; u += F.G) {
        const int g = u >> 2, hh = u & 3, r0 = g * 64;
        unsigned short lrw[4];
#pragma unroll
        for (int c = 0; c < 4; ++c) { const int i = tid + c * NT; lrw[c] = P[(size_t)(r0 + (i >> 5)) * INWP + C_GLR + (i & 31)]; }
        const v4u kq0 = *(const v4u*)(P + (size_t)(r0 + lane) * INWP + C_GK + hh * 128 + wave * 16), kq1 = *(const v4u*)(P + (size_t)(r0 + lane) * INWP + C_GK + hh * 128 + wave * 16 + 8);
        unsigned qw8[8], kw8[8];
#pragma unroll
        for (int it = 0; it < 8; ++it) { const int i = it * 8 + wave; qw8[it] = *(const unsigned*)(P + (size_t)(r0 + i) * INWP + C_GQ + hh * 128 + 2 * lane); kw8[it] = *(const unsigned*)(P + (size_t)(r0 + i) * INWP + C_GK + hh * 128 + 2 * lane); }
        v4u vw4[4];
#pragma unroll
        for (int c4 = 0; c4 < 4; ++c4) vw4[c4] = *(const v4u*)(P + (size_t)(r0 + lane) * INWP + C_GV + hh * 256 + wave * 32 + 8 * c4);
#pragma unroll
        for (int c = 0; c < 4; ++c) LR[tid + c * NT] = bf1(lrw[c]);
        __syncthreads();
        { const int d = tid & 127, ig = tid >> 7;
          const float* Wf = IN_GGW(F) + ((size_t)l * 2 + 0) * 16 * 512 + hh * 128 + d; const float* Wb = IN_GGW(F) + ((size_t)l * 2 + 1) * 16 * 512 + hh * 128 + d;
          float wf[16], wb[16];
#pragma unroll
          for (int r = 0; r < 16; ++r) { wf[r] = Wf[r * 512]; wb[r] = Wb[r * 512]; }
          const float bfv = IN_GGB(F)[((size_t)l * 2 + 0) * 512 + hh * 128 + d], bbv = IN_GGB(F)[((size_t)l * 2 + 1) * 512 + hh * 128 + d];
          for (int i = ig * 16; i < ig * 16 + 16; ++i) { float zf = bfv, zb = bbv;
#pragma unroll
              for (int r = 0; r < 16; ++r) { zf += LR[i * 32 + r] * wf[r]; zb += LR[i * 32 + 16 + r] * wb[r]; }
              BF[i * GL_BSTR + d] = logsigmoid_f(zf) * (1.f / 16.f); BB[i * GL_BSTR + d] = logsigmoid_f(zb) * (1.f / 16.f); } }
        __syncthreads();
        if (tid < 128) { float sacc = 0.f;
#pragma unroll 8
            for (int i = 0; i < 64; ++i) { sacc += BF[i * GL_BSTR + tid]; BF[i * GL_BSTR + tid] = sacc; } }
        else if (tid < 256) { const int d = tid - 128; float sacc = 0.f;
#pragma unroll 8
            for (int i = 63; i >= 0; --i) { sacc += BB[i * GL_BSTR + d]; BB[i * GL_BSTR + d] = sacc; } }
        __syncthreads();
        { const int j = lane, d0 = wave * 16;
          const unsigned kw[8] = {kq0.x, kq0.y, kq0.z, kq0.w, kq1.x, kq1.y, kq1.z, kq1.w};
#pragma unroll
          for (int c = 0; c < 16; ++c) { const int d = d0 + c; const float kv = (c & 1) ? bfhi(kw[c >> 1]) : bflo(kw[c >> 1]);
              const float bl = BF[63 * GL_BSTR + d], b0 = BB[d];
              KET[(0 * 128 + d) * GL_TSTR + j] = (bf16)f2bf(kv * __expf(bl - BF[j * GL_BSTR + d]));
              KET[(1 * 128 + d) * GL_TSTR + j] = (bf16)f2bf(kv * __expf(b0 - BB[j * GL_BSTR + d]));
              if (j == 0) { WSP(F, float, WS_DEC)[((size_t)(0 * NCH + g) * 4 + hh) * 128 + d] = __expf(bl); WSP(F, float, WS_DEC)[((size_t)(1 * NCH + g) * 4 + hh) * 128 + d] = __expf(b0); } } }
        const int ti = wave >> 1, tjb = wave & 1, fr = lane & 15, fq = lane >> 4;
        f32x4 asum[2]; asum[0] = (f32x4){0.f, 0.f, 0.f, 0.f}; asum[1] = asum[0];
#pragma unroll 1
        for (int dir = 0; dir < 2; ++dir) {
            LAS float* BX = dir ? BB : BF; bf16* QTg = WSP(F, bf16, dir ? WS_QTB : WS_QTF);
            __syncthreads();
#pragma unroll
            for (int it = 0; it < 8; ++it) { const int i = it * 8 + wave, d = 2 * lane;
                const unsigned qw = qw8[it], kw = kw8[it];
                const f32x2 b = *(LAS f32x2*)(BX + i * GL_BSTR + d);
                const unsigned qt = pk2(bflo(qw) * 0.08838834764831845f * __expf(b.x), bfhi(qw) * 0.08838834764831845f * __expf(b.y)), kt = pk2(bflo(kw) * __expf(-b.x), bfhi(kw) * __expf(-b.y));
                *(LAS unsigned*)(QX + i * GL_QSTR + d) = qt; *(LAS unsigned*)(KX + i * GL_QSTR + d) = kt;
                *(unsigned*)(QTg + ((((size_t)((r0 + i) >> 5) * 4 + hh) * 8 + (lane >> 3)) * 64 + ((r0 + i) & 31) + 32 * ((lane >> 2) & 1)) * 8 + 2 * (lane & 3)) = qt; }
            __syncthreads();
            f32x4 acc[2]; acc[0] = (f32x4){0.f, 0.f, 0.f, 0.f}; acc[1] = acc[0];
#pragma unroll
            for (int ks = 0; ks < 4; ++ks) { const bf16x8v a = *(const LAS bf16x8v*)(QX + (16 * ti + fr) * GL_QSTR + 32 * ks + 8 * fq);
#pragma unroll
                for (int t = 0; t < 2; ++t) { const bf16x8v b = *(const LAS bf16x8v*)(KX + (16 * (2 * tjb + t) + fr) * GL_QSTR + 32 * ks + 8 * fq);
                    acc[t] = __builtin_amdgcn_mfma_f32_16x16x32_bf16(a, b, acc[t], 0, 0, 0); } }
#pragma unroll
            for (int t = 0; t < 2; ++t)
#pragma unroll
                for (int r = 0; r < 4; ++r) { const int i = 16 * ti + 4 * fq + r, j = 16 * (2 * tjb + t) + fr; const bool keep = dir ? (j >= i) : (j <= i); asum[t][r] += keep ? acc[t][r] : 0.f; }
        }
        __syncthreads();
#pragma unroll
        for (int t = 0; t < 2; ++t)
#pragma unroll
            for (int r = 0; r < 4; ++r) AC[(16 * ti + 4 * fq + r) * GL_TSTR + 16 * (2 * tjb + t) + fr] = (bf16)f2bf(asum[t][r]);
        { const int j = lane, v0 = wave * 32;
#pragma unroll
          for (int c4 = 0; c4 < 4; ++c4) { const v4u w = vw4[c4]; const unsigned ww[4] = {w.x, w.y, w.z, w.w};
#pragma unroll
              for (int c = 0; c < 8; ++c) VT[(v0 + 8 * c4 + c) * GL_TSTR + j] = (bf16)((c & 1) ? (ww[c >> 1] >> 16) : (ww[c >> 1] & 0xffffu)); } }
        __syncthreads();
        { const int r32 = lane & 31, hi = lane >> 5; bf16x8v vt[4];
#pragma unroll
          for (int ks = 0; ks < 4; ++ks) vt[ks] = *(const LAS bf16x8v*)(VT + (32 * wave + r32) * GL_TSTR + 16 * ks + 8 * hi);
#pragma unroll
          for (int t = 0; t < 2; ++t) { f32x16v o;
#pragma unroll
              for (int r = 0; r < 16; ++r) o[r] = 0.f;
#pragma unroll
              for (int ks = 0; ks < 4; ++ks) { const bf16x8v a = *(const LAS bf16x8v*)(AC + (32 * t + r32) * GL_TSTR + 16 * ks + 8 * hi); o = __builtin_amdgcn_mfma_f32_32x32x16_bf16(a, vt[ks], o, 0, 0, 0); }
              unsigned* oi = WSP(F, unsigned, WS_OI) + ((((size_t)(g * 4 + hh) * 2 + t) * 8 + wave) * 8) * 64 + lane;
#pragma unroll
              for (int i = 0; i < 8; ++i) oi[i * 64] = pk2(o[2 * i], o[2 * i + 1]); }
#pragma unroll 1
          for (int dir = 0; dir < 2; ++dir)
#pragma unroll
              for (int td = 0; td < 4; ++td) { f32x16v o;
#pragma unroll
                  for (int r = 0; r < 16; ++r) o[r] = 0.f;
#pragma unroll
                  for (int ks = 0; ks < 4; ++ks) { const bf16x8v b = *(const LAS bf16x8v*)(KET + (dir * 128 + 32 * td + r32) * GL_TSTR + 16 * ks + 8 * hi); o = __builtin_amdgcn_mfma_f32_32x32x16_bf16(b, vt[ks], o, 0, 0, 0); }
                  bf16* up = WSP(F, bf16, WS_UPD) + ((size_t)(dir * NCH + g) * 4 + hh) * 32768 + (size_t)((2 * wave + (r32 >> 4)) * 16 + 4 * td) * 128 + (r32 & 15) * 8 + 4 * hi;
#pragma unroll
                  for (int rq = 0; rq < 4; ++rq) *(v2u*)(up + rq * 128) = (v2u){pk2(o[4 * rq], o[4 * rq + 1]), pk2(o[4 * rq + 2], o[4 * rq + 3])}; } }
        __syncthreads();
    }
}

__device__ __forceinline__ void phase_attn(Frame& F, int l) {
    launder(F);
    const int tid = F.tid;
    for (int rp = 0; rp < RP(5); ++rp) {
        const int gt = F.vcu * NT + tid, NGT = F.G * NT;
        for (int e = gt; e < 2 * 4 * 256 * 64; e += NGT) {
            const int d2 = 8 * ((e >> 6) & 15) + 2 * (e & 3), v = 16 * ((e >> 10) & 15) + ((e >> 2) & 15), hh = (e >> 14) & 3, dir = e >> 16;
            f32x2 S = (f32x2){0.f, 0.f};
            const size_t frag = ((size_t)((v >> 5) * 8 + (d2 >> 4)) * 64 + (v & 31) + 32 * ((d2 >> 3) & 1)) * 8 + (d2 & 7);
#pragma unroll 12
            for (int s = 0; s < NCH; ++s) {
                const int g = dir == 0 ? s : (s < 4 ? 3 - s : NCH + 3 - s);
                const size_t hb = (size_t)(dir * NCH + g) * 4 + hh;
                *(unsigned*)(WSP(F, bf16, WS_SPREV) + hb * 32768 + frag) = pk2(S.x, S.y);
                const f32x2 dc = *(const f32x2*)(WSP(F, float, WS_DEC) + hb * 128 + d2); const unsigned uw = *(const unsigned*)(WSP(F, bf16, WS_UPD) + hb * 32768 + (size_t)((v >> 4) * 16 + (d2 >> 3)) * 128 + (v & 15) * 8 + (d2 & 7)); const f32x2 up = (f32x2){bflo(uw), bfhi(uw)};
                S = S * dc + up;
            }
        }
    }
    typedef attn_body::bf16 abf;
    const bf16* P = WSP(F, bf16, WS_P); bf16* MIX = WSP(F, bf16, WS_MIX);
    for (int rp = 0; rp < RP(12); ++rp) {
        for (int u = F.vcu; u < 256; u += F.G) {
            const int h = u >> 5, qb = u & 31; const size_t r0 = (size_t)LC + (size_t)qb * 256;
            attn_body::attn_unit<8, 0>((const abf*)(WSP(F, bf16, WS_QC) + r0 * 512 + h * 64), 512, (const abf*)(WSP(F, bf16, WS_KC) + (h >> 2) * 64), 128, (const abf*)(WSP(F, bf16, WS_VC) + (h >> 2) * 64), 128,
                                       (abf*)(MIX + r0 * D + 1536 + h * 64), D, NCH, F.ldsg, 0, (const LAS float*)F.lds);
        }
    }
    for (int rp = 0; rp < RP(13); ++rp) {
        for (int u = F.vcu; u < 256; u += F.G) {
            const int h = u >> 5, ir0 = (u & 31) * 4; const size_t r0 = (size_t)LC + (size_t)ir0 * 64;
            { LAS float* tab = (LAS float*)(F.lds + 98304); const float* rpb = IN_RPB(F) + ((size_t)l * 8 + h) * 465; for (int i = F.tid; i < 465; i += NT) tab[i] = rpb[i]; }
            const int band0 = min(max(ir0 - 4, 0), 120), nb = min(max(ir0 - 1, 0), 120) + 8 - band0, ntile = 4 + nb + (nb & 1);
            attn_body::attn_unit<8, 1>((const abf*)(P + r0 * INWP + C_NAQ + h * 64), INWP, (const abf*)(P + C_NAK + h * 64), INWP, (const abf*)(P + C_NAV + h * 64), INWP,
                                       (abf*)(MIX + r0 * D + h * 64), D, ntile, F.ldsg, ir0, (const LAS float*)(F.lds + 98304));
        }
    }
    if (l < DEPTH - 1) for (int rp = 0; rp < RP(14); ++rp) {
        for (int u = F.vcu; u < 16; u += F.G) {
            const int h = u & 7;
            if (u < 8) attn_body::attn_unit<8, 2>((const abf*)(P + C_NAQ + h * 64), INWP, (const abf*)(P + C_NAK + h * 64), INWP, (const abf*)(P + C_NAV + h * 64), INWP, (abf*)(MIX + h * 64), D, 4, F.ldsg, 0, (const LAS float*)F.lds);
            else attn_body::attn_unit<8, 0>((const abf*)(WSP(F, bf16, WS_QC) + h * 64), 512, (const abf*)(WSP(F, bf16, WS_KC) + (h >> 2) * 64), 128, (const abf*)(WSP(F, bf16, WS_VC) + (h >> 2) * 64), 128, (abf*)(MIX + 1536 + h * 64), D, 4, F.ldsg, 0, (const LAS float*)F.lds);
        }
    }
    __syncthreads();
}

__device__ __forceinline__ void phase_gla_out(Frame& F, int l) {
    launder(F);
    const int lane = F.lane, wave = F.wave, r32 = lane & 31, hi = lane >> 5;
    LAS float* PART = (LAS float*)F.lds;
    const int g_lo = (l < DEPTH - 1) ? 0 : 4;
    for (int u = F.vcu + g_lo * 4; u < NCH * 4; u += F.G) {
        const int g = u >> 2, hh = u & 3, r0 = g * 64, v = 32 * wave + r32;
        f32x16v o[2];
#pragma unroll
        for (int t = 0; t < 2; ++t) { const unsigned* oi = WSP(F, unsigned, WS_OI) + ((((size_t)(g * 4 + hh) * 2 + t) * 8 + wave) * 8) * 64 + lane;
#pragma unroll
            for (int i = 0; i < 8; ++i) { const unsigned w = oi[i * 64]; o[t][2 * i] = bflo(w); o[t][2 * i + 1] = bfhi(w); } }
        bf16x8v b[2][8], a[2][8];
#pragma unroll
        for (int dir = 0; dir < 2; ++dir) { const bf16* sp = WSP(F, bf16, WS_SPREV) + ((size_t)(dir * NCH + g) * 4 + hh) * 32768 + (size_t)wave * 4096 + lane * 8;
#pragma unroll
            for (int ks = 0; ks < 8; ++ks) b[dir][ks] = *(const bf16x8v*)(sp + 512 * ks); }
#pragma unroll
        for (int dir = 0; dir < 2; ++dir) {
            const bf16* qt = WSP(F, bf16, dir ? WS_QTB : WS_QTF) + ((size_t)(r0 >> 5) * 4 + hh) * 4096 + lane * 8;
#pragma unroll
            for (int t = 0; t < 2; ++t)
#pragma unroll
                for (int ks = 0; ks < 8; ++ks) a[t][ks] = *(const bf16x8v*)(qt + (size_t)t * 16384 + 512 * ks);
#pragma unroll
            for (int t = 0; t < 2; ++t)
#pragma unroll
                for (int ks = 0; ks < 8; ++ks) o[t] = __builtin_amdgcn_mfma_f32_32x32x16_bf16(a[t][ks], b[dir][ks], o[t], 0, 0, 0);
        }
        bf16 gtw[2][16];
#pragma unroll
        for (int t = 0; t < 2; ++t)
#pragma unroll
            for (int r = 0; r < 16; ++r) gtw[t][r] = WSP(F, bf16, WS_P)[(size_t)(r0 + 32 * t + crow32(r, hi)) * INWP + C_GG + hh * 256 + v];
#pragma unroll
        for (int t = 0; t < 2; ++t)
#pragma unroll
            for (int r = 0; r < 16; ++r) { float sq = o[t][r] * o[t][r];
#pragma unroll
                for (int off = 1; off < 32; off <<= 1) sq += __shfl_xor(sq, off);
                if (r32 == 0) PART[(32 * t + crow32(r, hi)) * 8 + wave] = sq; }
        __syncthreads();
        const float nw = IN_GNW(F)[l * 256 + v];
#pragma unroll
        for (int t = 0; t < 2; ++t)
#pragma unroll
            for (int r = 0; r < 16; ++r) { const int row = 32 * t + crow32(r, hi); const f32x4 p0 = *(const LAS f32x4*)(PART + row * 8), p1 = *(const LAS f32x4*)(PART + row * 8 + 4);
                const float ss = (p0[0] + p0[1]) + (p0[2] + p0[3]) + (p1[0] + p1[1]) + (p1[2] + p1[3]);
                const float rstd = rsqrtf(ss * (1.f / 256.f) + LN_EPS); const float gt = bf1(gtw[t][r]);
                WSP(F, bf16, WS_MIX)[(size_t)(r0 + row) * D + 512 + hh * 256 + v] = (bf16)f2bf(o[t][r] * rstd * nw * silu_f(gt)); }
        __syncthreads();
    }
}

__device__ __forceinline__ void phase_ln1(Frame& F, int l) {
    launder(F);
    const int gw = F.vcu * NWAVES + F.wave, NGW = F.G * NWAVES, lane = F.lane;
    const int m_lo = (l < DEPTH - 1) ? 0 : LC;
    v4u nz[4];
    { const int m = (m_lo + gw < MT) ? m_lo + gw : MT - 1; row_fetch_bf16(WSP(F, bf16, WS_Z) + (size_t)m * D, lane, nz); }
    for (int m = m_lo + gw; m < MT; m += NGW) {
        const float* mod = WSP(F, float, WS_MOD) + (size_t)l * 2 * 12288 + (m < LC ? 12288 : 0);
        float v[32]; row_expand_bf16(nz, v);
        { const int mn = (m + NGW < MT) ? m + NGW : m; row_fetch_bf16(WSP(F, bf16, WS_Z) + (size_t)mn * D, lane, nz); }
        row_norm(v); row_affine(v, IN_LN1G(F) + l * D, IN_LN1B(F) + l * D, lane, 0.f);
        row_store_bf16(WSP(F, bf16, WS_X) + (size_t)m * D, lane, v);
        row_norm(v); row_affine(v, mod + 4 * D, mod + 3 * D, lane, 1.f);
        row_store_bf16(WSP(F, bf16, WS_H) + (size_t)m * D, lane, v);
    }
}

__device__ __forceinline__ void tk_merge16(float (&a)[16]) {
#pragma unroll
    for (int j = 8; j > 0; j >>= 1)
#pragma unroll
        for (int i = 0; i < 16; ++i) { const int p = i ^ j; if (p > i) { const float hi = fmaxf(a[i], a[p]), lo = fminf(a[i], a[p]); a[i] = hi; a[p] = lo; } }
}
__device__ __forceinline__ void tk_sort16(float (&a)[16]) {
#pragma unroll
    for (int k = 2; k <= 16; k <<= 1)
#pragma unroll
        for (int j = k >> 1; j > 0; j >>= 1)
#pragma unroll
            for (int i = 0; i < 16; ++i) { const int p = i ^ j; if (p > i) { const float hi = fmaxf(a[i], a[p]), lo = fminf(a[i], a[p]); const bool dsc = ((i & k) == 0); a[i] = dsc ? hi : lo; a[p] = dsc ? lo : hi; } }
}
__device__ __forceinline__ void tk_top16of128(const float* sp, float (&run)[16]) {
    float nx[16];
#pragma unroll
    for (int i = 0; i < 16; ++i) nx[i] = sp[(size_t)i * MT];
#pragma unroll 1
    for (int c = 0; c < 8; ++c) {
        float ch[16];
#pragma unroll
        for (int i = 0; i < 16; ++i) ch[i] = __builtin_bit_cast(float, (__builtin_bit_cast(unsigned, nx[i]) & ~127u) | (unsigned)(c * 16 + i));
        if (c < 7) {
#pragma unroll
            for (int i = 0; i < 16; ++i) nx[i] = sp[(size_t)((c + 1) * 16 + i) * MT]; }
        tk_sort16(ch);
        if (c == 0) {
#pragma unroll
            for (int i = 0; i < 16; ++i) run[i] = ch[i];
        } else {
#pragma unroll
            for (int i = 0; i < 16; ++i) run[i] = fmaxf(run[i], ch[15 - i]);
            tk_merge16(run);
        }
    }
}
__device__ __forceinline__ void phase_topk(Frame& F, int l) {
    launder(F);
    const int lane = F.lane, h = F.wave, tid = F.tid;
    LAS float* TS = (LAS float*)F.lds;
    const int u_lo = (l < DEPTH - 1) ? 0 : 4;
    for (int u = F.vcu + u_lo; u < NCH; u += F.G) {
        const int tok = u * 64 + lane;
        float t1[16], t2[16];
        tk_top16of128(WSP(F, float, WS_ST) + (size_t)((h * 2 + 0) * 128) * MT + tok, t1);
        tk_top16of128(WSP(F, float, WS_ST) + (size_t)((h * 2 + 1) * 128) * MT + tok, t2);
#pragma unroll
        for (int i = 0; i < 16; ++i) { TS[i * NT + tid] = t1[i]; TS[(16 + i) * NT + tid] = t2[i]; }
        float tv[16];
#define TK_CAND(i_, j_) __builtin_bit_cast(float, (__builtin_bit_cast(unsigned, t1[i_] + t2[j_]) & ~255u) | (unsigned)((i_) * 16 + (j_)))
#pragma unroll
        for (int j = 0; j < 16; ++j) tv[j] = TK_CAND(0, j);
#pragma unroll
        for (int i = 1; i < 16; ++i) {
            const int len = 16 / (i + 1);
            if (len >= 3) {
#pragma unroll
                for (int k = 0; k < 16; ++k) if (15 - k < len) tv[k] = fmaxf(tv[k], TK_CAND(i, 15 - k));
                tk_merge16(tv);
            } else {
#pragma unroll
                for (int j = 0; j < len; ++j) { float v = TK_CAND(i, j);
#pragma unroll
                    for (int s2 = 0; s2 < 16; ++s2) { const float hi = fmaxf(tv[s2], v); v = fminf(tv[s2], v); tv[s2] = hi; } }
            }
        }
#undef TK_CAND
        LDS_WAIT();
        float sv[16]; int ti[16];
#pragma unroll
        for (int s2 = 0; s2 < 16; ++s2) { const unsigned code = __builtin_bit_cast(unsigned, tv[s2]) & 255u; const float a = TS[(code >> 4) * NT + tid], b = TS[(16 + (code & 15u)) * NT + tid];
            sv[s2] = a + b; ti[s2] = (int)((__builtin_bit_cast(unsigned, a) & 127u) * 128u + (__builtin_bit_cast(unsigned, b) & 127u)); }
        float mx = sv[0];
#pragma unroll
        for (int s2 = 1; s2 < 16; ++s2) mx = fmaxf(mx, sv[s2]);
        float e[16], sum = 0.f;
#pragma unroll
        for (int s2 = 0; s2 < 16; ++s2) { e[s2] = __expf(sv[s2] - mx); sum += e[s2]; }
        const float inv = 1.f / sum;
        int* ip = WSP(F, int, WS_IDX) + (size_t)tok * 128 + h * 16; float* gp = WSP(F, float, WS_GATE) + (size_t)tok * 128 + h * 16;
#pragma unroll
        for (int s4 = 0; s4 < 4; ++s4) { *(v4u*)(ip + 4 * s4) = (v4u){(unsigned)ti[4 * s4], (unsigned)ti[4 * s4 + 1], (unsigned)ti[4 * s4 + 2], (unsigned)ti[4 * s4 + 3]};
            *(f32x4*)(gp + 4 * s4) = (f32x4){e[4 * s4] * inv, e[4 * s4 + 1] * inv, e[4 * s4 + 2] * inv, e[4 * s4 + 3] * inv}; }
        LDS_WAIT();
    }
}

template <int CTRL> __device__ __forceinline__ float dpp_f(float v) { return __builtin_bit_cast(float, __builtin_amdgcn_update_dpp(0, __builtin_bit_cast(int, v), CTRL, 0xF, 0xF, true)); }
__device__ __forceinline__ void phase_peer(Frame& F, int l) {
    launder(F);
    const int lane = F.lane, r8 = lane >> 3, l8 = lane & 7;
    const int gsz = F.G >> 3, grp = F.vcu / gsz, gwv = (F.vcu % gsz) * NWAVES + F.wave, gnw = gsz * NWAVES;
    const unsigned char* U = WSP(F, unsigned char, WS_PU) + (size_t)l * NEXP * D;
    const int* IDX = WSP(F, int, WS_IDX); const bf16* H = WSP(F, bf16, WS_H);
    LAS int* ET = (LAS int*)(F.lds + F.wave * 1024);
    const int m_lo = (l < DEPTH - 1) ? 0 : LC;
    const int wpos = ((lane & 7) * 16 + (lane >> 3));
#pragma unroll 1
    for (int sub = 0; sub < 2; ++sub) {
        const int s = 8 * sub + grp;
        const unsigned coff = 128u * (unsigned)s + 16u * (unsigned)l8;
        const int o0 = 8 * (8 * (s & 7) + l8) + 1024 * (s >> 3);
        unsigned* part = WSP(F, unsigned, WS_PART) + (size_t)s * MT * 64;
        int m = m_lo + gwv;
        int eL = IDX[(size_t)m * 128 + lane], eH = IDX[(size_t)m * 128 + 64 + lane];
#pragma unroll 1
        for (; m < MT; m += gnw) {
            ET[wpos] = eL; ET[wpos + 8] = eH;
            const v4u hw0 = *(const v4u*)(H + (size_t)m * D + o0), hw1 = *(const v4u*)(H + (size_t)m * D + o0 + 512);
            LDS_WAIT();
            int e16[16];
#pragma unroll
            for (int q = 0; q < 16; ++q) e16[q] = ET[r8 * 16 + q];
            v4u r[16];
#pragma unroll
            for (int j = 0; j < 16; ++j) r[j] = *(const v4u*)(U + ((unsigned)e16[j] * 2048u + coff));
            { const int mn = (m + gnw < MT) ? m + gnw : m; eL = IDX[(size_t)mn * 128 + lane]; eH = IDX[(size_t)mn * 128 + 64 + lane]; }
            f32x2 h[8];
            h[0] = (f32x2){bflo(hw0.x), bfhi(hw0.x)}; h[1] = (f32x2){bflo(hw0.y), bfhi(hw0.y)}; h[2] = (f32x2){bflo(hw0.z), bfhi(hw0.z)}; h[3] = (f32x2){bflo(hw0.w), bfhi(hw0.w)};
            h[4] = (f32x2){bflo(hw1.x), bfhi(hw1.x)}; h[5] = (f32x2){bflo(hw1.y), bfhi(hw1.y)}; h[6] = (f32x2){bflo(hw1.z), bfhi(hw1.z)}; h[7] = (f32x2){bflo(hw1.w), bfhi(hw1.w)};
            float d[16];
#pragma unroll
            for (int j = 0; j < 16; j += 2) { f32x2 p = (f32x2){0.f, 0.f}, q = (f32x2){0.f, 0.f};
#pragma unroll
                for (int w = 0; w < 4; ++w) { const f32x2 lo = __builtin_amdgcn_cvt_pk_f32_fp8((int)r[j][w], false), lo2 = __builtin_amdgcn_cvt_pk_f32_fp8((int)r[j + 1][w], false);
                    const f32x2 hi = __builtin_amdgcn_cvt_pk_f32_fp8((int)r[j][w], true), hi2 = __builtin_amdgcn_cvt_pk_f32_fp8((int)r[j + 1][w], true);
                    p += lo * h[2 * w]; q += lo2 * h[2 * w]; p += hi * h[2 * w + 1]; q += hi2 * h[2 * w + 1]; }
                d[j] = p.x + p.y; d[j + 1] = q.x + q.y; }
            const bool c2 = (l8 & 4) != 0, c1 = (l8 & 2) != 0, c0 = (l8 & 1) != 0;
            float e1[8], e2[4];
#pragma unroll
            for (int jj = 0; jj < 8; ++jj) { const int ja = (jj & 3) | ((jj >> 2) << 3); const float kp = c2 ? d[ja | 4] : d[ja], sd = c2 ? d[ja] : d[ja | 4]; e1[jj] = kp + dpp_f<0x141>(sd); }
#pragma unroll
            for (int y = 0; y < 4; ++y) { const int x = (y & 1) | ((y >> 1) << 2); const float kp = c1 ? e1[x | 2] : e1[x], sd = c1 ? e1[x] : e1[x | 2]; e2[y] = kp + dpp_f<0x4E>(sd); }
            const float v0 = (c0 ? e2[1] : e2[0]) + dpp_f<0xB1>(c0 ? e2[0] : e2[1]), v1 = (c0 ? e2[3] : e2[2]) + dpp_f<0xB1>(c0 ? e2[2] : e2[3]);
            part[(size_t)m * 64 + 8 * l8 + r8] = pk2(v0, v1);
            LDS_WAIT();
        }
    }
}

__device__ __forceinline__ void phase_peer_act(Frame& F, int l) {
    launder(F);
    const int gw = F.vcu * NWAVES + F.wave, NGW = F.G * NWAVES, lane = F.lane;
    const f32x2* SUV = WSP(F, f32x2, WS_SCU) + l * NEXP;
    const int m_lo = (l < DEPTH - 1) ? 0 : LC;
    for (int m0 = m_lo + gw; m0 < MT; m0 += 2 * NGW) {
        const int m1 = m0 + NGW; const bool two = m1 < MT; const int mm[2] = {m0, two ? m1 : m0};
        float dsum[2][2]; int e[2][2]; float gt[2][2];
#pragma unroll
        for (int t = 0; t < 2; ++t)
#pragma unroll
            for (int hlf = 0; hlf < 2; ++hlf) { const int k = 64 * hlf + lane; e[t][hlf] = WSP(F, int, WS_IDX)[(size_t)mm[t] * 128 + k]; gt[t][hlf] = WSP(F, float, WS_GATE)[(size_t)mm[t] * 128 + k]; }
#pragma unroll
        for (int t = 0; t < 2; ++t) { float d0 = 0.f, d1 = 0.f;
#pragma unroll
            for (int s = 0; s < 16; ++s) { const unsigned w = WSP(F, unsigned, WS_PART)[((size_t)s * MT + mm[t]) * 64 + lane]; d0 += bflo(w); d1 += bfhi(w); }
            dsum[t][0] = d0; dsum[t][1] = d1; }
#pragma unroll
        for (int t = 0; t < 2; ++t)
#pragma unroll
            for (int hlf = 0; hlf < 2; ++hlf) { const int k = 64 * hlf + lane;
                const f32x2 sc = SUV[e[t][hlf]];
                const float a = gelu_tanh(dsum[t][hlf] * sc.x) * gt[t][hlf] * sc.y;
                if (t == 0 || two) WSP(F, float, WS_ACT)[(size_t)mm[t] * 128 + k] = a; }
    }
}

__device__ __forceinline__ void phase_peer_v(Frame& F, int l) {
    launder(F);
    const int lane = F.lane, r8 = lane >> 3, l8 = lane & 7;
    const int gsz = F.G >> 3, grp = F.vcu / gsz, gwv = (F.vcu % gsz) * NWAVES + F.wave, gnw = gsz * NWAVES;
    const unsigned char* V = WSP(F, unsigned char, WS_PV) + (size_t)l * NEXP * D;
    const int* IDX = WSP(F, int, WS_IDX); const float* ACT = WSP(F, float, WS_ACT);
    LAS int* ET = (LAS int*)(F.lds + F.wave * 1024); LAS float* AT = (LAS float*)(F.lds + F.wave * 1024 + 512);
    const int m_lo = (l < DEPTH - 1) ? 0 : LC;
    const int wpos = ((lane & 7) * 16 + (lane >> 3));
    const bool b5 = (lane & 32) != 0, b4 = (lane & 16) != 0, b3 = (lane & 8) != 0;
#pragma unroll 1
    for (int sub = 0; sub < 2; ++sub) {
        const int s = 8 * sub + grp;
        const unsigned coff = 128u * (unsigned)s + 16u * (unsigned)l8;
        const int o0 = 8 * (8 * (s & 7) + l8) + 1024 * (s >> 3);
        int m = m_lo + gwv;
        int eL = IDX[(size_t)m * 128 + lane], eH = IDX[(size_t)m * 128 + 64 + lane]; float aL = ACT[(size_t)m * 128 + lane], aH = ACT[(size_t)m * 128 + 64 + lane];
#pragma unroll 1
        for (; m < MT; m += gnw) {
            ET[wpos] = eL; ET[wpos + 8] = eH; AT[wpos] = aL; AT[wpos + 8] = aH;
            LDS_WAIT();
            int e16[16]; float a[16];
#pragma unroll
            for (int q = 0; q < 16; ++q) { e16[q] = ET[r8 * 16 + q]; a[q] = AT[r8 * 16 + q]; }
            v4u r[16];
#pragma unroll
            for (int j = 0; j < 16; ++j) r[j] = *(const v4u*)(V + ((unsigned)e16[j] * 2048u + coff));
            { const int mn = (m + gnw < MT) ? m + gnw : m; eL = IDX[(size_t)mn * 128 + lane]; eH = IDX[(size_t)mn * 128 + 64 + lane]; aL = ACT[(size_t)mn * 128 + lane]; aH = ACT[(size_t)mn * 128 + 64 + lane]; }
            f32x2 acc[8];
#pragma unroll
            for (int i = 0; i < 8; ++i) acc[i] = (f32x2){0.f, 0.f};
#pragma unroll
            for (int j = 0; j < 16; ++j)
#pragma unroll
                for (int w = 0; w < 4; ++w) { const f32x2 lo = __builtin_amdgcn_cvt_pk_f32_fp8((int)r[j][w], false), hi = __builtin_amdgcn_cvt_pk_f32_fp8((int)r[j][w], true);
                    acc[2 * w] += lo * a[j]; acc[2 * w + 1] += hi * a[j]; }
            f32x2 g1[4], g2[2];
#pragma unroll
            for (int i = 0; i < 4; ++i) { const f32x2 kp = b5 ? acc[i + 4] : acc[i], sd = b5 ? acc[i] : acc[i + 4]; g1[i] = (f32x2){kp.x + __shfl_xor(sd.x, 32), kp.y + __shfl_xor(sd.y, 32)}; }
#pragma unroll
            for (int i = 0; i < 2; ++i) { const f32x2 kp = b4 ? g1[i + 2] : g1[i], sd = b4 ? g1[i] : g1[i + 2]; g2[i] = (f32x2){kp.x + __shfl_xor(sd.x, 16), kp.y + __shfl_xor(sd.y, 16)}; }
            { const f32x2 kp = b3 ? g2[1] : g2[0], sd = b3 ? g2[0] : g2[1]; const f32x2 res = (f32x2){kp.x + dpp_f<0x128>(sd.x), kp.y + dpp_f<0x128>(sd.y)};
              *(unsigned*)(WSP(F, bf16, WS_Z) + (size_t)m * D + o0 + (r8 < 4 ? 2 * r8 : 512 + 2 * (r8 - 4))) = pk2(res.x, res.y); }
            LDS_WAIT();
        }
    }
}

__device__ __forceinline__ void phase_peer_tail(Frame& F, int l) {
    launder(F);
    const int gw = F.vcu * NWAVES + F.wave, NGW = F.G * NWAVES, lane = F.lane;
    const int m_lo = (l < DEPTH - 1) ? 0 : LC;
    v4u nx[4], no[4];
    { const int m = (m_lo + gw < MT) ? m_lo + gw : MT - 1; row_fetch_bf16(WSP(F, bf16, WS_X) + (size_t)m * D, lane, nx); row_fetch_bf16(WSP(F, bf16, WS_Z) + (size_t)m * D, lane, no); }
    for (int m = m_lo + gw; m < MT; m += NGW) {
        const float* mod = WSP(F, float, WS_MOD) + (size_t)l * 2 * 12288 + (m < LC ? 12288 : 0);
        float x[32], o[32]; row_expand_bf16(nx, x); row_expand_bf16(no, o);
        { const int mn = (m + NGW < MT) ? m + NGW : m; row_fetch_bf16(WSP(F, bf16, WS_X) + (size_t)mn * D, lane, nx); row_fetch_bf16(WSP(F, bf16, WS_Z) + (size_t)mn * D, lane, no); }
#pragma unroll
        for (int j = 0; j < 4; ++j)
#pragma unroll
            for (int hf = 0; hf < 2; ++hf) { const f32x4 gv = *(const f32x4*)(mod + 5 * D + 8 * lane + 512 * j + 4 * hf);
#pragma unroll
                for (int c = 0; c < 4; ++c) x[8 * j + 4 * hf + c] = ALPHA * x[8 * j + 4 * hf + c] + gv[c] * o[8 * j + 4 * hf + c]; }
        row_norm(x); row_affine(x, IN_LN2G(F) + l * D, IN_LN2B(F) + l * D, lane, 0.f);
        if (l < DEPTH - 1) {
            row_store_bf16(WSP(F, bf16, WS_X) + (size_t)m * D, lane, x);
            const float* modn = WSP(F, float, WS_MOD) + (size_t)(l + 1) * 2 * 12288 + (m < LC ? 12288 : 0);
            row_norm(x); row_affine(x, modn + D, modn, lane, 1.f);
            row_store_bf16(WSP(F, bf16, WS_H) + (size_t)m * D, lane, x);
        } else {
            row_store_f32(F.ap->out + (size_t)(m - LC) * D, lane, x);
        }
    }
}

template <int MODE> __device__ __forceinline__ void ctx_gemm(Frame& F, const bf16* A, const bf16* Bt, const bf16* X, bf16* Z, const float* g, float* ST) {
    launder(F);
    const int lane = F.lane, fr = lane & 15, fq = lane >> 4, w = F.wave;
    LAS f32x4* red = (LAS f32x4*)F.lds;
#pragma unroll 1
    for (int wt = F.vcu; wt < 256; wt += F.G) {
        const int rg = wt & 7, cg = wt >> 3;
        const bf16* ap = A + (size_t)(32 * rg + fr) * D + 8 * fq + 256 * w; const bf16* bp = Bt + (size_t)(64 * cg + fr) * D + 8 * fq + 256 * w;
        f32x4 acc[2][4];
#pragma unroll
        for (int m = 0; m < 2; ++m)
#pragma unroll
            for (int n = 0; n < 4; ++n) acc[m][n] = (f32x4){0.f, 0.f, 0.f, 0.f};
#pragma unroll 1
        for (int kb = 0; kb < 8; kb += 4) {
            bf16x8v a[4][2], b[4][4];
#pragma unroll
            for (int i = 0; i < 4; ++i) {
#pragma unroll
                for (int m = 0; m < 2; ++m) a[i][m] = *(const bf16x8v*)(ap + (size_t)(16 * m) * D + 32 * (kb + i));
#pragma unroll
                for (int n = 0; n < 4; ++n) b[i][n] = *(const bf16x8v*)(bp + (size_t)(16 * n) * D + 32 * (kb + i)); }
            __builtin_amdgcn_sched_barrier(0);
#pragma unroll
            for (int i = 0; i < 4; ++i)
#pragma unroll
                for (int m = 0; m < 2; ++m)
#pragma unroll
                    for (int n = 0; n < 4; ++n) acc[m][n] = __builtin_amdgcn_mfma_f32_16x16x32_bf16(a[i][m], b[i][n], acc[m][n], 0, 0, 0);
        }
        asm volatile("s_waitcnt vmcnt(0)" ::: "memory");
        __syncthreads();
#pragma unroll
        for (int m = 0; m < 2; ++m)
#pragma unroll
            for (int n = 0; n < 4; ++n) red[(w * 8 + m * 4 + n) * 64 + lane] = acc[m][n];
        __syncthreads();
        f32x4 sum = red[w * 64 + lane];
#pragma unroll
        for (int ww = 1; ww < 8; ++ww) sum += red[(ww * 8 + w) * 64 + lane];
        { const int m = w >> 2, n = w & 3; const int col = 64 * cg + 16 * n + fr, row0 = 32 * rg + 16 * m + 4 * fq;
          if (MODE == 0) { const float gv = g[col];
#pragma unroll
              for (int r = 0; r < 4; ++r) Z[(size_t)(row0 + r) * D + col] = (bf16)f2bf(ALPHA * bflo((unsigned)X[(size_t)(row0 + r) * D + col]) + gv * sum[r]); }
          else *(f32x4*)(ST + (size_t)col * MT + row0) = sum; }
        __syncthreads();
    }
}

#ifndef MK_MULTI
#define MK_MULTI 0
#endif
constexpr int NPL = 12, NPHASE = 2 + DEPTH * NPL;
__global__ void __launch_bounds__(NT, 2) trunk_fwd(Args args) {
    extern __shared__ __attribute__((aligned(16))) unsigned char lds[];
    Frame F;
    F.lds = (LAS unsigned char*)lds; F.ldsg = (char*)lds;
    F.tid = threadIdx.x; F.lane = F.tid & 63; F.wave = __builtin_amdgcn_readfirstlane(F.tid >> 6);
    F.G = gridDim.x; { const int bx = blockIdx.x; F.vcu = (F.G % 8 == 0) ? (bx % 8) * (F.G / 8) + bx / 8 : bx; }
    F.ap = (const __attribute__((address_space(4))) Args*)__builtin_amdgcn_kernarg_segment_ptr();
    volatile LAS unsigned* MISC = (volatile LAS unsigned*)(F.lds + MISC_OFF);
    for (int u = F.tid; u < (LDS_BYTES - LDSCTL_OFF) / 4; u += NT) ((LAS unsigned*)(F.lds + LDSCTL_OFF))[u] = 0u;
    __syncthreads();
    XcdBarrier bar; bar.bar = WSP(F, unsigned, WS_CTL) + CW_BAR; bar.x = 0; bar.st = nullptr;
    if (!MK_MULTI) bar = xcd_barrier_post(WSP(F, unsigned, WS_CTL) + CW_BAR, MISC + 8);
    const int lo = args.ph_lo, hi = args.ph_hi;
#ifndef PH_MASK
#define PH_MASK 0xFFFFFF
#endif
#define IN(k) (lo <= (k) && (k) < hi)
#define PM(b) ((PH_MASK >> (b)) & 1)
#define SEAM(k) do { if (!MK_MULTI && IN(k) && IN((k) + 1)) xcd_barrier(bar); } while (0)

    if (PM(0) && IN(0)) { for (int rp = 0; rp < RP(0); ++rp) phase_prologue_a(F); } SEAM(0);
    if (PM(1) && IN(1)) { for (int rp = 0; rp < RP(1); ++rp) phase_ln0(F); } SEAM(1);
#pragma unroll 1
    for (int l = 0; l < DEPTH; ++l) {
        const int pb = 2 + l * NPL;
        const bool ctxu = l < DEPTH - 1;
        if (PM(2) && IN(pb + 0)) for (int rp = 0; rp < RP(2); ++rp) {
            pg8::Gemm g{WSP(F, bf16, WS_H), WSP(F, bf16, WS_WIN) + (size_t)l * INWP * D, MT, INWP, D}; pg8::StaticOrder S; S.init(MT, INWP, F.G, (int)blockIdx.x);
            pg8::EpiBf16P E{WSP(F, bf16, WS_P), INWP};
            pg8::gemm_phase<pg8::EpiBf16P, pg8::StaticOrder, true, true>(F.lds, g, S, E);
        }
        SEAM(pb + 0);
        if (IN(pb + 1)) { if (PM(3)) for (int rp = 0; rp < RP(3); ++rp) phase_qknorm(F, l); if (PM(4)) for (int rp = 0; rp < RP(4); ++rp) phase_gla_chunk(F, l); }
        SEAM(pb + 1);
        if (PM(5) && IN(pb + 2)) { phase_attn(F, l); }
        SEAM(pb + 2);
        if (PM(6) && IN(pb + 3)) { for (int rp = 0; rp < RP(6); ++rp) phase_gla_out(F, l); }
        SEAM(pb + 3);
        if (PM(7) && IN(pb + 4)) for (int rp = 0; rp < RP(7); ++rp) {
            const float* modl = WSP(F, float, WS_MOD) + (size_t)l * 2 * 12288;
            pg8::Gemm g{WSP(F, bf16, WS_MIX) + (size_t)LC * D, WSP(F, bf16, WS_WOUT) + (size_t)l * D * D, T, D, D}; pg8::StaticOrder S; S.init(T, D, F.G, (int)blockIdx.x);
            pg8::EpiResid E{WSP(F, bf16, WS_X) + (size_t)LC * D, WSP(F, bf16, WS_Z) + (size_t)LC * D, modl + 2 * D, ALPHA};
            pg8::gemm_phase<pg8::EpiResid, pg8::StaticOrder, true, true>(F.lds, g, S, E);
            if (ctxu) ctx_gemm<0>(F, WSP(F, bf16, WS_MIX), WSP(F, bf16, WS_WOUT) + (size_t)l * D * D, WSP(F, bf16, WS_X), WSP(F, bf16, WS_Z), modl + 12288 + 2 * D, nullptr);
        }
        SEAM(pb + 4);
        if (PM(8) && IN(pb + 5)) { for (int rp = 0; rp < RP(8); ++rp) phase_ln1(F, l); }
        SEAM(pb + 5);
        if (PM(9) && IN(pb + 6)) for (int rp = 0; rp < RP(9); ++rp) {
            pg8::Gemm g{WSP(F, bf16, WS_WP) + (size_t)l * D * D, WSP(F, bf16, WS_H) + (size_t)LC * D, D, T, D}; pg8::StaticOrder S; S.init(D, T, F.G, (int)blockIdx.x);
            pg8::EpiStoreF32 E{WSP(F, float, WS_ST) + LC, MT};
            pg8::gemm_phase<pg8::EpiStoreF32, pg8::StaticOrder, true, true>(F.lds, g, S, E);
            if (ctxu) ctx_gemm<1>(F, WSP(F, bf16, WS_H), WSP(F, bf16, WS_WP) + (size_t)l * D * D, nullptr, nullptr, nullptr, WSP(F, float, WS_ST));
        }
        SEAM(pb + 6);
        if (PM(10) && IN(pb + 7)) { for (int rp = 0; rp < RP(10); ++rp) phase_topk(F, l); }
        SEAM(pb + 7);
        if (PM(11) && IN(pb + 8)) { for (int rp = 0; rp < RP(11); ++rp) phase_peer(F, l); }
        SEAM(pb + 8);
        if (PM(22) && IN(pb + 9)) { for (int rp = 0; rp < RP(22); ++rp) phase_peer_act(F, l); }
        SEAM(pb + 9);
        if (PM(20) && IN(pb + 10)) { for (int rp = 0; rp < RP(20); ++rp) phase_peer_v(F, l); }
        SEAM(pb + 10);
        if (PM(21) && IN(pb + 11)) { phase_peer_tail(F, l); }
        SEAM(pb + 11);
    }
#undef IN
#undef SEAM
}

extern "C" void kernel_launch(void* const* d_in, const int* in_sizes, int n_in, void* d_out, int out_size, void* d_ws, size_t ws_size, hipStream_t stream) {
    static int grid = 0;
    if (grid == 0) {
        if (n_in != 22 || out_size != T * D || ws_size < WS_END) { fprintf(stderr, "kernel_launch: unexpected shapes (n_in %d, out %d, ws %zu); nothing launched\n", n_in, out_size, ws_size); grid = -1; return; }
        int dev = 0, cus = 0, per_cu = 0;
        if (hipGetDevice(&dev) != hipSuccess || hipDeviceGetAttribute(&cus, hipDeviceAttributeMultiprocessorCount, dev) != hipSuccess) { grid = -1; return; }
        if (hipFuncSetAttribute((const void*)trunk_fwd, hipFuncAttributeMaxDynamicSharedMemorySize, LDS_BYTES) != hipSuccess) { fprintf(stderr, "kernel_launch: hipFuncSetAttribute failed\n"); grid = -1; return; }
        if (hipOccupancyMaxActiveBlocksPerMultiprocessor(&per_cu, (const void*)trunk_fwd, NT, LDS_BYTES) != hipSuccess || per_cu < 1)
            fprintf(stderr, "kernel_launch: note: occupancy query reports %d workgroups per CU\n", per_cu);
        (void)hipGetLastError();
        grid = cus;
    }
    if (grid < 0) return;
    if (hipMemsetAsync((char*)d_ws + WS_CTL, 0, CTL_ZERO_BYTES, stream) != hipSuccess) return;
    Args a{};
    for (int i = 0; i < 22; ++i) a.in[i] = (const float*)d_in[i];
    a.out = (float*)d_out; a.ws = (unsigned char*)d_ws;
#if MK_MULTI
    for (int p = 0; p < NPHASE; ++p) { a.ph_lo = p; a.ph_hi = p + 1; hipLaunchKernelGGL(trunk_fwd, dim3(grid), dim3(NT), LDS_BYTES, stream, a); }
#else
    a.ph_lo = 0; a.ph_hi = NPHASE; hipLaunchKernelGGL(trunk_fwd, dim3(grid), dim3(NT), LDS_BYTES, stream, a);
#endif
}
```

```cpp
#include <hip/hip_runtime.h>
#include <cstdio>
#include <cstdint>
#include <hip/hip_bf16.h>
#define MK_MULTI 0
namespace pg8 {
#define PG8_LAS __attribute__((address_space(3)))
typedef unsigned short bf16_t;
typedef short bf16x8 __attribute__((ext_vector_type(8)));
typedef float f32x4 __attribute__((ext_vector_type(4)));
typedef unsigned u32x4 __attribute__((ext_vector_type(4)));
constexpr int BM = 256, BK = 64, HALF = 128, HTB = HALF * BK * 2  , STAGE_BYTES = 8 * HTB, NXCD = 8, WGM = 8;

__host__ __device__ __forceinline__ int lds_byte(int r, int c) { const int st = (r >> 4) * 2 + (c >> 5), rr = r & 15, cc = c & 31, ob = rr * 64 + cc * 2; return st * 1024 + (ob ^ (((ob >> 9) & 1) << 5)); }
__host__ __device__ __forceinline__ void stage_rc(int b, int& R, int& C) { const int st = b / 1024, sb = b % 1024, swz = sb ^ (((sb >> 9) & 1) << 5); R = (st >> 1) * 16 + swz / 64; C = (st & 1) * 32 + (swz % 64) / 2; }
__host__ __device__ __forceinline__ int perm32(int rho) { const int n = rho >> 4, i = rho & 15; return 8 * (i >> 2) + 4 * n + (i & 3); }

struct Unit { int pm, pn; };
struct Gemm { const bf16_t* A; const bf16_t* Bt; int M, N, K; };

struct StaticOrder {
    int nM, nN, nwg, G, c;
    __host__ __device__ void init(int M, int N, int G_, int c_) { nM = M / BM; nN = N / BM; nwg = nM * nN; G = G_; c = c_; }
    __host__ __device__ bool next(int i, Unit& u) const {
        const long L = (long)i * G + c; if (L >= nwg) return false;
        int wgid = (int)L; { const int q = nwg / NXCD, r = nwg % NXCD, xcd = wgid % NXCD, off = wgid / NXCD; wgid = (xcd < r ? xcd * (q + 1) : r * (q + 1) + (xcd - r) * q) + off; }
        const int nig = WGM * nN, gid = wgid / nig, fm = gid * WGM, gsz = (nM - fm) < WGM ? (nM - fm) : WGM;
        u.pm = fm + ((wgid % nig) % gsz); u.pn = (wgid % nig) / gsz; return true;
    }
    __device__ __forceinline__ void a_ready(const Unit&) const {}
    __device__ __forceinline__ void done(const Unit&) const {}
};
__device__ __forceinline__ unsigned cvt_pk_bf16(float lo, float hi) { unsigned r; asm volatile("v_cvt_pk_bf16_f32 %0, %1, %2" : "=v"(r) : "v"(lo), "v"(hi)); return r; }
typedef float f32x2 __attribute__((ext_vector_type(2)));

struct EpiBf16P {
    static constexpr bool PERM = true, AFTER_DRAIN = false;
    bf16_t* O; int ldc;
    __device__ __forceinline__ void operator()(const f32x4 (&acc)[2][2][4][2], const Unit& u, int wr, int wc, int fr, int fq) const {
        const int row0 = u.pm * BM + wr * 64 + fr, col0 = u.pn * BM + wc * 32 + 8 * fq;
#pragma unroll
        for (int ai = 0; ai < 2; ++ai)
#pragma unroll
            for (int m = 0; m < 4; ++m) { bf16_t* rowp = O + (size_t)(row0 + ai * HALF + m * 16) * ldc + col0;
#pragma unroll
                for (int bj = 0; bj < 2; ++bj) { const f32x4 v0 = acc[ai][bj][m][0], v1 = acc[ai][bj][m][1];
                    u32x4 w; w.x = cvt_pk_bf16(v0[0], v0[1]); w.y = cvt_pk_bf16(v0[2], v0[3]); w.z = cvt_pk_bf16(v1[0], v1[1]); w.w = cvt_pk_bf16(v1[2], v1[3]);
                    *(u32x4*)(rowp + bj * HALF) = w; } }
    }
};
struct EpiResid {
    static constexpr bool PERM = true, AFTER_DRAIN = false;
    const bf16_t* X; bf16_t* Z; const float* g; float alpha;
    __device__ __forceinline__ void operator()(const f32x4 (&acc)[2][2][4][2], const Unit& u, int wr, int wc, int fr, int fq) const {
        const int row0 = u.pm * BM + wr * 64 + fr, col0 = u.pn * BM + wc * 32 + 8 * fq;
        f32x4 gv[2][2];
#pragma unroll
        for (int bj = 0; bj < 2; ++bj)
#pragma unroll
            for (int n = 0; n < 2; ++n) gv[bj][n] = *(const f32x4*)(g + col0 + bj * HALF + 4 * n);
#pragma unroll
        for (int ai = 0; ai < 2; ++ai) {
            u32x4 xv[4][2];
#pragma unroll
            for (int m = 0; m < 4; ++m)
#pragma unroll
                for (int bj = 0; bj < 2; ++bj) xv[m][bj] = *(const u32x4*)(X + (size_t)(row0 + ai * HALF + m * 16) * 2048 + col0 + bj * HALF);
#pragma unroll
            for (int m = 0; m < 4; ++m)
#pragma unroll
                for (int bj = 0; bj < 2; ++bj) { const f32x4 v0 = acc[ai][bj][m][0], v1 = acc[ai][bj][m][1]; const u32x4 x = xv[m][bj]; u32x4 w;
#define XLO_(q) __builtin_bit_cast(float, (q) << 16)
#define XHI_(q) __builtin_bit_cast(float, (q) & 0xffff0000u)
                    w.x = cvt_pk_bf16(XLO_(x.x) * alpha + gv[bj][0][0] * v0[0], XHI_(x.x) * alpha + gv[bj][0][1] * v0[1]);
                    w.y = cvt_pk_bf16(XLO_(x.y) * alpha + gv[bj][0][2] * v0[2], XHI_(x.y) * alpha + gv[bj][0][3] * v0[3]);
                    w.z = cvt_pk_bf16(XLO_(x.z) * alpha + gv[bj][1][0] * v1[0], XHI_(x.z) * alpha + gv[bj][1][1] * v1[1]);
                    w.w = cvt_pk_bf16(XLO_(x.w) * alpha + gv[bj][1][2] * v1[2], XHI_(x.w) * alpha + gv[bj][1][3] * v1[3]);
#undef XLO_
#undef XHI_
                    *(u32x4*)(Z + (size_t)(row0 + ai * HALF + m * 16) * 2048 + col0 + bj * HALF) = w; }
        }
    }
};
struct EpiStoreF32 {
    static constexpr bool PERM = true, AFTER_DRAIN = false;
    float* C; int ldc;
    __device__ __forceinline__ void operator()(const f32x4 (&acc)[2][2][4][2], const Unit& u, int wr, int wc, int fr, int fq) const {
        const int row0 = u.pm * BM + wr * 64 + fr, col0 = u.pn * BM + wc * 32 + 8 * fq;
#pragma unroll
        for (int ai = 0; ai < 2; ++ai)
#pragma unroll
            for (int m = 0; m < 4; ++m) { float* rowp = C + (size_t)(row0 + ai * HALF + m * 16) * ldc + col0;
#pragma unroll
                for (int bj = 0; bj < 2; ++bj) { *(f32x4*)(rowp + bj * HALF) = acc[ai][bj][m][0]; *(f32x4*)(rowp + bj * HALF + 4) = acc[ai][bj][m][1]; } }
    }
};

template <class Epi, class Sched, bool ALIGN_EPI = false, bool SP2 = false>
__device__ __forceinline__ void gemm_phase(PG8_LAS unsigned char* lds, const Gemm g, const Sched& S, const Epi& E) {
    int tid_ = threadIdx.x; asm volatile("" : "+v"(tid_));
    const int tid = tid_, wid = __builtin_amdgcn_readfirstlane(tid >> 6), lane = tid & 63, wr = wid >> 2, wc = wid & 3, fr = lane & 15, fq = lane >> 4;
    const int K = g.K, nt = K / BK;
    unsigned voffA[2], voffB[2];
#pragma unroll
    for (int i = 0; i < 2; ++i) { int R, C; stage_rc(tid * 16 + i * 8192, R, C); const int Rb = Epi::PERM ? ((R & ~31) + perm32(R & 31)) : R;
        voffA[i] = (unsigned)(R * K + C) * 2u; voffB[i] = (unsigned)(Rb * K + C) * 2u; }
    const size_t kstep = (size_t)(BK * 2);
    const size_t hstep = (size_t)HALF * K * 2;
    const size_t tstep = 2 * hstep;
    const unsigned ldsw = (unsigned)wid * 1024u;
    const int aoff = lds_byte(wr * 64 + fr, fq * 8), boff = lds_byte(wc * 32 + fr, fq * 8);
#define PG8_SA(b, h) (((b) * 2 + (h)) * HTB)
#define PG8_SB(b, h) ((4 + (b) * 2 + (h)) * HTB)
#define PG8_STAGE(bufoff, gbase, voff) do { _Pragma("unroll") for (int _i = 0; _i < 2; ++_i) \
        __builtin_amdgcn_global_load_lds((const unsigned*)((const char*)(gbase) + (voff)[_i]), (PG8_LAS unsigned*)(lds + (bufoff) + ldsw + _i * 8192), 16, 0, 0); } while (0)
#define PG8_LDA(dst, b, h) do { _Pragma("unroll") for (int m = 0; m < 4; ++m) _Pragma("unroll") for (int k = 0; k < 2; ++k) dst[m][k] = *(const PG8_LAS bf16x8*)(lds + PG8_SA(b, h) + aoff + m * 2048 + k * 1024); } while (0)
#define PG8_LDB(dst, b, h) do { _Pragma("unroll") for (int n = 0; n < 2; ++n) _Pragma("unroll") for (int k = 0; k < 2; ++k) dst[n][k] = *(const PG8_LAS bf16x8*)(lds + PG8_SB(b, h) + boff + n * 2048 + k * 1024); } while (0)
#define PG8_MMA(ai, bj, At, Bt) do { __builtin_amdgcn_s_setprio(1); _Pragma("unroll") for (int m = 0; m < 4; ++m) _Pragma("unroll") for (int n = 0; n < 2; ++n) _Pragma("unroll") for (int k = 0; k < 2; ++k) \
        acc[ai][bj][m][n] = __builtin_amdgcn_mfma_f32_16x16x32_bf16(Bt[n][k], At[m][k], acc[ai][bj][m][n], 0, 0, 0); __builtin_amdgcn_s_setprio(0); } while (0)
#define PG8_WAIT_V(n) asm volatile("s_waitcnt vmcnt(" #n ")" ::: "memory")
#define PG8_WAIT_L(n) asm volatile("s_waitcnt lgkmcnt(" #n ")" ::: "memory")
#define PG8_BAR __builtin_amdgcn_s_barrier()
#define PG8_SCHED __builtin_amdgcn_sched_barrier(0)
    Unit cur, nxt; int ui = 0;
    if (!S.next(0, cur)) return;
    f32x4 acc[2][2][4][2];
#pragma unroll
    for (int a = 0; a < 2; ++a)
#pragma unroll
        for (int b = 0; b < 2; ++b)
#pragma unroll
            for (int m = 0; m < 4; ++m)
#pragma unroll
                for (int n = 0; n < 2; ++n) acc[a][b][m][n] = (f32x4){0.f, 0.f, 0.f, 0.f};
    bf16x8 At[4][2], B0[2][2], B1[2][2];
    const char* cA = (const char*)g.A + (size_t)cur.pm * tstep; const char* cB = (const char*)g.Bt + (size_t)cur.pn * tstep;
    S.a_ready(cur);
    if constexpr (SP2) {
        PG8_STAGE(PG8_SB(0, 0), cB, voffB); PG8_STAGE(PG8_SB(0, 1), cB + hstep, voffB); PG8_STAGE(PG8_SA(0, 0), cA, voffA); PG8_STAGE(PG8_SA(0, 1), cA + hstep, voffA);
        if (wr == 1) PG8_BAR;
        PG8_WAIT_V(2); PG8_BAR;
        PG8_STAGE(PG8_SB(1, 0), cB + kstep, voffB); PG8_STAGE(PG8_SA(1, 0), cA + kstep, voffA); PG8_STAGE(PG8_SB(1, 1), cB + hstep + kstep, voffB);
        PG8_WAIT_V(6); PG8_BAR;
    } else {
        PG8_STAGE(PG8_SB(0, 0), cB, voffB); PG8_STAGE(PG8_SA(0, 0), cA, voffA); PG8_STAGE(PG8_SB(0, 1), cB + hstep, voffB); PG8_STAGE(PG8_SA(0, 1), cA + hstep, voffA);
        if (wr == 1) PG8_BAR;
        PG8_WAIT_V(4); PG8_BAR;
        PG8_STAGE(PG8_SB(1, 0), cB + kstep, voffB); PG8_STAGE(PG8_SA(1, 0), cA + kstep, voffA); PG8_STAGE(PG8_SB(1, 1), cB + hstep + kstep, voffB);
        PG8_WAIT_V(6); PG8_BAR;
    }
    for (;;) {
        const bool has_next = S.next(ui + 1, nxt);
        const char* nA = has_next ? (const char*)g.A + (size_t)nxt.pm * tstep : cA; const char* nB = has_next ? (const char*)g.Bt + (size_t)nxt.pn * tstep : cB;
        for (int t = 0; t < nt; t += 2) {
            const bool last = (t == nt - 2);
            const char* a1 = cA + (size_t)(t + 1) * kstep;
            const char* a2 = last ? nA : cA + (size_t)(t + 2) * kstep; const char* b2 = last ? nB : cB + (size_t)(t + 2) * kstep;
            const char* a3 = a2 + kstep; const char* b3 = b2 + kstep;
            if (last && has_next) S.a_ready(nxt);
            if constexpr (SP2) {
            PG8_LDB(B0, 0, 0); PG8_LDB(B1, 0, 1); PG8_SCHED; PG8_LDA(At, 0, 0); PG8_STAGE(PG8_SA(1, 1), a1 + hstep, voffA);
            PG8_WAIT_V(8); PG8_WAIT_L(0); PG8_BAR; PG8_MMA(0, 0, At, B0); PG8_MMA(0, 1, At, B1); PG8_BAR; PG8_SCHED;
            PG8_LDA(At, 0, 1); PG8_STAGE(PG8_SB(0, 0), b2, voffB); PG8_STAGE(PG8_SB(0, 1), b2 + hstep, voffB); PG8_STAGE(PG8_SA(0, 0), a2, voffA);
            PG8_WAIT_V(8); PG8_WAIT_L(0); PG8_BAR; PG8_MMA(1, 0, At, B0); PG8_MMA(1, 1, At, B1); PG8_BAR; PG8_SCHED;
            PG8_LDB(B0, 1, 0); PG8_LDB(B1, 1, 1); PG8_SCHED; PG8_LDA(At, 1, 0); PG8_STAGE(PG8_SA(0, 1), a2 + hstep, voffA);
            PG8_WAIT_V(8); PG8_WAIT_L(0); PG8_BAR; PG8_MMA(0, 0, At, B0); PG8_MMA(0, 1, At, B1); PG8_BAR; PG8_SCHED;
            PG8_LDA(At, 1, 1); PG8_STAGE(PG8_SB(1, 0), b3, voffB); PG8_STAGE(PG8_SB(1, 1), b3 + hstep, voffB); PG8_STAGE(PG8_SA(1, 0), a3, voffA);
            PG8_WAIT_V(8); PG8_WAIT_L(0); PG8_BAR; PG8_MMA(1, 0, At, B0); PG8_MMA(1, 1, At, B1); PG8_BAR; PG8_SCHED;
            } else {
            PG8_LDB(B0, 0, 0); PG8_SCHED; PG8_LDA(At, 0, 0); PG8_STAGE(PG8_SA(1, 1), a1 + hstep, voffA);
            PG8_WAIT_L(8); PG8_BAR; PG8_WAIT_L(0); PG8_MMA(0, 0, At, B0); PG8_BAR; PG8_SCHED;
            PG8_LDB(B1, 0, 1); PG8_STAGE(PG8_SB(0, 0), b2, voffB);
            PG8_BAR; PG8_WAIT_L(0); PG8_MMA(0, 1, At, B1); PG8_BAR;
            PG8_LDA(At, 0, 1); PG8_STAGE(PG8_SA(0, 0), a2, voffA);
            PG8_BAR; PG8_WAIT_L(0); PG8_MMA(1, 0, At, B0); PG8_BAR; PG8_SCHED;
            PG8_STAGE(PG8_SB(0, 1), b2 + hstep, voffB);
            PG8_WAIT_V(6); PG8_BAR; PG8_MMA(1, 1, At, B1); PG8_BAR;
            PG8_LDB(B0, 1, 0); PG8_SCHED; PG8_LDA(At, 1, 0); PG8_STAGE(PG8_SA(0, 1), a2 + hstep, voffA);
            PG8_WAIT_L(8); PG8_BAR; PG8_WAIT_L(0); PG8_MMA(0, 0, At, B0); PG8_BAR; PG8_SCHED;
            PG8_LDB(B1, 1, 1); PG8_STAGE(PG8_SB(1, 0), b3, voffB);
            PG8_BAR; PG8_WAIT_L(0); PG8_MMA(0, 1, At, B1); PG8_BAR;
            PG8_LDA(At, 1, 1); PG8_STAGE(PG8_SA(1, 0), a3, voffA);
            PG8_BAR; PG8_WAIT_L(0); PG8_MMA(1, 0, At, B0); PG8_BAR; PG8_SCHED;
            PG8_STAGE(PG8_SB(1, 1), b3 + hstep, voffB);
            PG8_WAIT_V(6); PG8_BAR; PG8_MMA(1, 1, At, B1); PG8_BAR;
            }
        }
        if constexpr (ALIGN_EPI) { if (wr == 0) PG8_BAR; }
        if constexpr (!Epi::AFTER_DRAIN) { E(acc, cur, wr, wc, fr, fq); S.done(cur); }
        if (!has_next) break;
#pragma unroll
        for (int a = 0; a < 2; ++a)
#pragma unroll
            for (int b = 0; b < 2; ++b)
#pragma unroll
                for (int m = 0; m < 4; ++m)
#pragma unroll
                    for (int n = 0; n < 2; ++n) acc[a][b][m][n] = (f32x4){0.f, 0.f, 0.f, 0.f};
        cur = nxt; cA = nA; cB = nB; ++ui;
        if constexpr (ALIGN_EPI) { if (wr == 1) PG8_BAR; }
    }
    PG8_WAIT_V(0);
    if constexpr (!ALIGN_EPI) { if (wr == 0) PG8_BAR; }
    PG8_BAR;
    if constexpr (Epi::AFTER_DRAIN) { E.fused(acc, cur, wr, wc, fr, fq, lds, wid, lane); S.done(cur); }
#undef PG8_SA
#undef PG8_SB
#undef PG8_STAGE
#undef PG8_LDA
#undef PG8_LDB
#undef PG8_MMA
#undef PG8_WAIT_V
#undef PG8_WAIT_L
#undef PG8_BAR
#undef PG8_SCHED
}
}
#include <cmath>
namespace attn_body {
using bf16=__hip_bfloat16;
using bf16x8=__attribute__((ext_vector_type(8)))short;
using s16x4=__attribute__((ext_vector_type(4)))short;
using f32x16=__attribute__((ext_vector_type(16)))float;
using u32x4=__attribute__((ext_vector_type(4)))unsigned;
constexpr int D=64;
constexpr int NW=8,QBLK=32,QB=QBLK*NW,KVBLK=64;
constexpr int ATTN_UNIT_ROWS=QB;
__device__ __forceinline__ int crow(int r,int hi){return (r&3)+8*(r>>2)+4*hi;}
#define SBAR() __builtin_amdgcn_sched_barrier(0)
__device__ __forceinline__ void cmask(f32x16&p0,f32x16&p1,int jb,int qrel,int hi){
  const float NEG=-INFINITY; int kb=64*jb+4*hi;
  #pragma unroll
  for(int r=0;r<16;++r){int kv=kb+(r&3)+8*(r>>2); if(kv>qrel)p0[r]=NEG; if(kv+32>qrel)p1[r]=NEG;}
}

constexpr int NSLOT=3, SLOTB=8192;
constexpr int LDS_K=0, LDS_V=NSLOT*SLOTB, LDS_WS=2*NSLOT*SLOTB, LDS_OST=LDS_WS+NW*64*4, LDS_BYTES=LDS_OST+NW*4096;
constexpr float C2=0.125f*1.4426950408889634f;
__device__ __forceinline__ void glds16(const void*gsrc,unsigned lds_dst){unsigned keep;
  asm volatile("s_mov_b32 %0, m0\n\ts_mov_b32 m0, %2\n\ts_nop 0\n\tglobal_load_lds_dwordx4 %1, off\n\ts_mov_b32 m0, %0":"=&s"(keep):"v"(gsrc),"s"(lds_dst):"memory");}
__device__ __forceinline__ float max3f(float a,float b,float c){float r;asm("v_max3_f32 %0, %1, %2, %3":"=v"(r):"v"(a),"v"(b),"v"(c));return r;}
__device__ __forceinline__ float max2f(float a,float b){float r;asm("v_max_f32_e32 %0, %1, %2":"=v"(r):"v"(a),"v"(b));return r;}
__device__ __forceinline__ float fadd_s(float a,float b){float r;asm("v_add_f32_e32 %0, %1, %2":"=v"(r):"v"(a),"v"(b));return r;}
__device__ __forceinline__ float fsub_s(float a,float b){float r;asm("v_sub_f32_e32 %0, %1, %2":"=v"(r):"v"(a),"v"(b));return r;}
typedef float f32x2_t __attribute__((ext_vector_type(2))); typedef __bf16 bf16x2_t __attribute__((ext_vector_type(2)));
__device__ __forceinline__ unsigned cvtpk_s(float lo,float hi){f32x2_t v={lo,hi};bf16x2_t b=__builtin_convertvector(v,bf16x2_t);return __builtin_bit_cast(unsigned,b);}
#define WAIT_BAR(N) asm volatile("s_waitcnt vmcnt(" #N ") lgkmcnt(0)\n\ts_barrier":::"memory")

__device__ __forceinline__ void qkt(f32x16&p0,f32x16&p1,const char*Kslot,const bf16x8*qr,const f32x16&negm,int r32,int hi){
  const char*kb=Kslot+hi*1024+r32*16;
  #pragma unroll
  for(int d0=0;d0<4;++d0){
    const bf16x8 b0=*reinterpret_cast<const bf16x8*>(kb+d0*2048);
    const bf16x8 b1=*reinterpret_cast<const bf16x8*>(kb+d0*2048+512);
    if(d0==0){p0=__builtin_amdgcn_mfma_f32_32x32x16_bf16(b0,qr[0],negm,0,0,0);p1=__builtin_amdgcn_mfma_f32_32x32x16_bf16(b1,qr[0],negm,0,0,0);}
    else{p0=__builtin_amdgcn_mfma_f32_32x32x16_bf16(b0,qr[d0],p0,0,0,0);p1=__builtin_amdgcn_mfma_f32_32x32x16_bf16(b1,qr[d0],p1,0,0,0);}}
}
typedef __attribute__((address_space(3))) const char* lds_cptr;
typedef short v4i16_t __attribute__((ext_vector_type(4)));
__device__ __forceinline__ void kload8(bf16x8*kf,lds_cptr kp){
  kf[0]=*(const __attribute__((address_space(3))) bf16x8*)(kp);      kf[1]=*(const __attribute__((address_space(3))) bf16x8*)(kp+512);
  kf[2]=*(const __attribute__((address_space(3))) bf16x8*)(kp+2048); kf[3]=*(const __attribute__((address_space(3))) bf16x8*)(kp+2560);
  kf[4]=*(const __attribute__((address_space(3))) bf16x8*)(kp+4096); kf[5]=*(const __attribute__((address_space(3))) bf16x8*)(kp+4608);
  kf[6]=*(const __attribute__((address_space(3))) bf16x8*)(kp+6144); kf[7]=*(const __attribute__((address_space(3))) bf16x8*)(kp+6656);
}
__device__ __forceinline__ void kload2(bf16x8*kf,lds_cptr kp,int j){ kf[2*j]=*(const __attribute__((address_space(3))) bf16x8*)(kp+j*2048); kf[2*j+1]=*(const __attribute__((address_space(3))) bf16x8*)(kp+j*2048+512); }
__device__ __forceinline__ s16x4 vtr(lds_cptr p){ return __builtin_bit_cast(s16x4,__builtin_amdgcn_ds_read_tr16_b64_v4i16((__attribute__((address_space(3))) v4i16_t*)p)); }
__device__ __forceinline__ float rowmax(const f32x16&p0,const f32x16&p1){
  float a=max3f(p0[0],p0[1],p1[0]),b=max3f(p0[2],p0[3],p1[1]);a=max3f(a,p1[2],p1[3]);
  #pragma unroll
  for(int r=4;r<16;r+=4){a=max3f(a,p0[r],p0[r+1]);b=max3f(b,p0[r+2],p0[r+3]);a=max3f(a,p1[r],p1[r+1]);b=max3f(b,p1[r+2],p1[r+3]);}
  const float m=max2f(a,b);
  auto rr=__builtin_amdgcn_permlane32_swap(__float_as_uint(m),__float_as_uint(m),false,false);
  return max2f(__uint_as_float(rr[0]),__uint_as_float(rr[1]));
}
__device__ __forceinline__ void pv(f32x16*o,int vb,bf16x8 pa0,bf16x8 pa1,bf16x8 pa2,bf16x8 pa3){
  #pragma unroll
  for(int d0=0;d0<2;++d0){s16x4 lo[4],hi[4];
    #pragma unroll
    for(int ks=0;ks<4;++ks){
      asm volatile("ds_read_b64_tr_b16 %0,%1 offset:%c2":"=&v"(lo[ks]):"v"(vb),"i"(d0*4096+ks*1024):"memory");
      asm volatile("ds_read_b64_tr_b16 %0,%1 offset:%c2":"=&v"(hi[ks]):"v"(vb),"i"(d0*4096+ks*1024+512):"memory");}
    asm volatile("s_waitcnt lgkmcnt(0)":::"memory");SBAR();
    #define PK(k) (bf16x8){lo[k][0],lo[k][1],lo[k][2],lo[k][3],hi[k][0],hi[k][1],hi[k][2],hi[k][3]}
    o[d0]=__builtin_amdgcn_mfma_f32_32x32x16_bf16(pa0,PK(0),o[d0],0,0,0);
    o[d0]=__builtin_amdgcn_mfma_f32_32x32x16_bf16(pa1,PK(1),o[d0],0,0,0);
    o[d0]=__builtin_amdgcn_mfma_f32_32x32x16_bf16(pa2,PK(2),o[d0],0,0,0);
    o[d0]=__builtin_amdgcn_mfma_f32_32x32x16_bf16(pa3,PK(3),o[d0],0,0,0);
    #undef PK
  }
}

#ifndef ATTN_STORE16
#define ATTN_STORE16(p,v) (*(u32x4*)(p)=(v))
#endif
template<int THRL,int MODE> __device__ __forceinline__ void attn_unit(const bf16*Qu,const int QP,const bf16*__restrict__ Kh,const int KP,const bf16*__restrict__ Vh,const int VP,bf16*Ou,const int OP,const int NT,char*shm,const int img_r0,const __attribute__((address_space(3))) float* rpb_tab){
  int tid_=threadIdx.x; asm volatile("":"+v"(tid_));
  const int tid=tid_,lane=tid&63,r32=lane&31,hi=lane>>5; const int wid=__builtin_amdgcn_readfirstlane(tid>>6);
  const bf16*Qw=Qu+(long)(wid*QBLK)*QP;
  const unsigned lds0=(unsigned)(uintptr_t)shm;
  float*wsf=(float*)(shm+LDS_WS)+wid*64;
  const bf16*ksrc=Kh+(long)lane*KP+wid*8;
  const bf16*vsrc=Vh+(long)(16*(wid&3)+(lane>>2))*VP+(wid>>2)*32+(lane&3)*8;
  const unsigned kdst=lds0+LDS_K+wid*1024, vdst=lds0+LDS_V+wid*1024;
  const int band0=(MODE==1)?min(max(img_r0-4,0),120):0;
  #define TROW(t) ((long)(t)*KVBLK+((MODE==1&&(t)>=4)?(long)band0*64:0l))
  #define DMA_K(t,slot) glds16(ksrc+TROW(t)*KP,(unsigned)__builtin_amdgcn_readfirstlane(kdst+(slot)))
  #define DMA_V(t,slot) glds16(vsrc+TROW(t)*VP,(unsigned)__builtin_amdgcn_readfirstlane(vdst+(slot)))
  const int vb0=(int)(lds0+LDS_V)+((lane>>4)&1)*32+(lane&3)*8+(4*hi+((lane&15)>>2))*64;
  const char*Kbase=shm+LDS_K; bf16x8 kf[8];
  const lds_cptr shm3=(lds_cptr)shm; const lds_cptr kp0=shm3+LDS_K+hi*1024+r32*16; const lds_cptr vp0=shm3+LDS_V+((lane>>4)&1)*32+(lane&3)*8+(4*hi+((lane&15)>>2))*64;
  DMA_K(0,0);DMA_V(0,0);DMA_K(1,SLOTB);
  bf16x8 qr[4];
  #pragma unroll
  for(int d0=0;d0<4;++d0)qr[d0]=*reinterpret_cast<const bf16x8*>(&Qw[(long)r32*QP+d0*16+hi*8]);
  if(MODE!=0){
    #pragma unroll
    for(int d0=0;d0<4;++d0){
      #pragma unroll
      for(int e=0;e<8;e+=2){ const float lo=__uint_as_float(((unsigned)(unsigned short)qr[d0][e])<<16)*C2, hi2=__uint_as_float(((unsigned)(unsigned short)qr[d0][e+1])<<16)*C2;
        const unsigned pk=cvtpk_s(lo,hi2); qr[d0][e]=(short)(pk&0xffffu); qr[d0][e+1]=(short)(pk>>16); } } }
  float mhat=0.f,l_reg=0.f;f32x16 o[2];o[0]=f32x16{};o[1]=f32x16{};f32x16 negm=f32x16{}; if(MODE!=1) asm volatile("":"+v"(negm));
  const int na_qc=32*(wid&1)+r32, na_cs=min(max(na_qc-8,0),48), na_r=img_r0+(wid>>1), na_rs=min(max(na_r-4,0),120);
  #define CMASK(P0,P1,t) do{ if(MODE==1&&(t)>=4){ const int br_=band0+(t)-4; const bool rok_=(br_>=na_rs)&&(br_<na_rs+8); \
      int qcl_=na_qc, csl_=na_cs, hil_=hi; asm volatile("":"+v"(qcl_),"+v"(csl_),"+v"(hil_));     \
      const int brow_=(rok_?(br_-na_r+7):0)*31-qcl_+15; \
      _Pragma("unroll") for(int r_=0;r_<16;++r_){ const int kc_=crow(r_,hil_); \
        const bool ok0_=rok_&&(kc_>=csl_)&&(kc_<csl_+16), ok1_=rok_&&(kc_+32>=csl_)&&(kc_+32<csl_+16); \
        const float b0_=rpb_tab[ok0_?brow_+kc_:0], b1_=rpb_tab[ok1_?brow_+kc_+32:0]; \
        P0[r_]=ok0_?P0[r_]+b0_*1.4426950408889634f:-INFINITY; P1[r_]=ok1_?P1[r_]+b1_*1.4426950408889634f:-INFINITY; } } }while(0)
  #define SUBREF(P0,P1) do{ if(MODE==1){ _Pragma("unroll") for(int r_=0;r_<16;++r_){P0[r_]-=mhat;P1[r_]-=mhat;} } }while(0)
  #define NEGMC ((MODE==1)?f32x16{}:negm)
  bool resc=false;
  #define START(P0,P1) do{ const float rm=rowmax(P0,P1); resc=false; \
    { const float dl=rm; mhat=fadd_s(mhat,dl); \
      _Pragma("unroll") for(int r=0;r<16;++r){P0[r]=fsub_s(P0[r],dl);P1[r]=fsub_s(P1[r],dl);} \
      if(MODE!=1){ _Pragma("unroll") for(int r=0;r<16;++r)negm[r]=-mhat; asm volatile("":"+v"(negm)); } } \
    _Pragma("unroll") for(int r=0;r<16;++r)P0[r]=__builtin_amdgcn_exp2f(P0[r]); }while(0)
  #define RESC() do{ if(resc){ asm volatile("s_waitcnt lgkmcnt(0)":::"memory"); \
      _Pragma("unroll") for(int d_=0;d_<2;++d_) _Pragma("unroll") for(int r=0;r<16;++r)o[d_][r]*=wsf[crow(r,hi)]; } }while(0)
  f32x16 pA0,pA1,pB0,pB1;
  int sl_prev=0,sl_cur=0,sl_next=SLOTB;
  #define ROT() do{sl_prev=sl_cur;sl_cur=sl_next;sl_next=(sl_next==(NSLOT-1)*SLOTB)?0:sl_next+SLOTB;}while(0)
  DMA_K(2,2*SLOTB);
  WAIT_BAR(3);
  qkt(pA0,pA1,Kbase,qr,negm,r32,hi);asm volatile("s_nop 15\n\ts_nop 7":"+v"(pA0),"+v"(pA1));CMASK(pA0,pA1,0);
  START(pA0,pA1);
  _Pragma("unroll") for(int r=0;r<16;++r)pA1[r]=__builtin_amdgcn_exp2f(pA1[r]);
  WAIT_BAR(0);
  DMA_K(3,0);DMA_V(1,SLOTB);
  ROT();
  kload8(kf,kp0+sl_cur);
  WAIT_BAR(2);
  s16x4 vlo[8],vhi[8]; u32x4 pw0,pw1,pw2,pw3;
  #define PKW(P,B) cvtpk_s(P[B],P[B+1])
  #define PAF(k) __builtin_bit_cast(bf16x8,pw##k)
  #define VFR(i) (bf16x8){vlo[i][0],vlo[i][1],vlo[i][2],vlo[i][3],vhi[i][0],vhi[i][1],vhi[i][2],vhi[i][3]}
  #define PIN(x) asm volatile("":"+v"(x))
  #define MX3(a,b,c) __builtin_fmaxf(__builtin_fmaxf((a),(b)),(c))
  #define GAPA(MF,A0,A1,A2,A3,W0,W1,PW) do{ MF; sacc+=A0; sacc+=A1; sacc+=A2; sacc+=A3; PIN(sacc); W0; W1; PIN(PW); SBAR(); }while(0)
  #define EX(v) __builtin_amdgcn_exp2f(v)
  #define GAPB(MF,X,B) do{ MF; X[B]=EX(X[B]); X[B+1]=EX(X[B+1]); X[B+2]=EX(X[B+2]); X[B+3]=EX(X[B+3]); PIN(X); SBAR(); }while(0)
  #define VRD(i) do{ vlo[i]=vtr(vp_+(((i)>>2)*4096+((i)&3)*1024)); vhi[i]=vtr(vp_+(((i)>>2)*4096+((i)&3)*1024+512)); }while(0)
  #define KRD(G,j) do{ if(G){ kload2(kf,kp0+sl_next,j); SBAR(); } }while(0)
  #define STEP(C0,C1,P0,P1,t,GK,GV,GL) do{ SBAR(); \
    const lds_cptr vp_=vp0+sl_prev; \
    VRD(0); SBAR(); float sacc=(P0[0]+P0[1]); \
    GAPA(C0=__builtin_amdgcn_mfma_f32_32x32x16_bf16(kf[0],qr[0],NEGMC,0,0,0), P0[2],P0[3],P0[4],P0[5],     pw0[0]=PKW(P0,0), pw0[1]=PKW(P0,2), pw0); \
    VRD(4); SBAR(); GAPA(C1=__builtin_amdgcn_mfma_f32_32x32x16_bf16(kf[1],qr[0],NEGMC,0,0,0), P0[6],P0[7],P0[8],P0[9],     pw0[2]=PKW(P0,4), pw0[3]=PKW(P0,6), pw0); \
    VRD(1); SBAR(); GAPA(C0=__builtin_amdgcn_mfma_f32_32x32x16_bf16(kf[2],qr[1],C0,0,0,0),   P0[10],P0[11],P0[12],P0[13], pw1[0]=PKW(P0,8), pw1[1]=PKW(P0,10), pw1); \
    VRD(5); SBAR(); GAPA(C1=__builtin_amdgcn_mfma_f32_32x32x16_bf16(kf[3],qr[1],C1,0,0,0),   P0[14],P0[15],P1[0],P1[1],   pw1[2]=PKW(P0,12),pw1[3]=PKW(P0,14), pw1); \
    VRD(2); SBAR(); GAPA(C0=__builtin_amdgcn_mfma_f32_32x32x16_bf16(kf[4],qr[2],C0,0,0,0),   P1[2],P1[3],P1[4],P1[5],     pw2[0]=PKW(P1,0), pw2[1]=PKW(P1,2), pw2); \
    VRD(6); SBAR(); GAPA(C1=__builtin_amdgcn_mfma_f32_32x32x16_bf16(kf[5],qr[2],C1,0,0,0),   P1[6],P1[7],P1[8],P1[9],     pw2[2]=PKW(P1,4), pw2[3]=PKW(P1,6), pw2); \
    VRD(3); SBAR(); GAPA(C0=__builtin_amdgcn_mfma_f32_32x32x16_bf16(kf[6],qr[3],C0,0,0,0),   P1[10],P1[11],P1[12],P1[13], pw3[0]=PKW(P1,8), pw3[1]=PKW(P1,10), pw3); \
    VRD(7); SBAR(); GAPA(C1=__builtin_amdgcn_mfma_f32_32x32x16_bf16(kf[7],qr[3],C1,0,0,0),   P1[14],P1[15],0.f,0.f,       pw3[2]=PKW(P1,12),pw3[3]=PKW(P1,14), pw3); \
    l_reg+=sacc; \
    if(GK){DMA_K((t)+3,sl_cur);} if(GV){DMA_V((t)+1,sl_next);} \
    SUBREF(C0,C1); CMASK(C0,C1,t); \
    { float a=MX3(C0[0],C0[1],C1[0]),b=MX3(C0[2],C0[3],C1[1]); a=MX3(a,C1[2],C1[3]); \
      _Pragma("unroll") for(int r=4;r<16;r+=4){a=MX3(a,C0[r],C0[r+1]);b=MX3(b,C0[r+2],C0[r+3]);a=MX3(a,C1[r],C1[r+1]);b=MX3(b,C1[r+2],C1[r+3]);} \
      float rm=__builtin_fmaxf(a,b); { auto rr=__builtin_amdgcn_permlane32_swap(__float_as_uint(rm),__float_as_uint(rm),false,false); rm=__builtin_fmaxf(__uint_as_float(rr[0]),__uint_as_float(rr[1])); } \
      resc=false; \
      if(__builtin_expect(__any(rm>(float)THRL),0)){ const float dl=__builtin_fmaxf(rm,0.f); mhat+=dl; \
        _Pragma("unroll") for(int r=0;r<16;++r){C0[r]-=dl;C1[r]-=dl;} \
        if(MODE!=1){ _Pragma("unroll") for(int r=0;r<16;++r)negm[r]=-mhat; asm volatile("":"+v"(negm)); } \
        const float f=__builtin_amdgcn_exp2f(-dl); l_reg*=f; if(hi==0)wsf[r32]=f; resc=true; } } \
    SBAR(); \
    GAPB(o[0]=__builtin_amdgcn_mfma_f32_32x32x16_bf16(PAF(0),VFR(0),o[0],0,0,0), C0,0); \
    GAPB(o[1]=__builtin_amdgcn_mfma_f32_32x32x16_bf16(PAF(0),VFR(4),o[1],0,0,0), C0,4); \
    KRD(GL,0); GAPB(o[0]=__builtin_amdgcn_mfma_f32_32x32x16_bf16(PAF(1),VFR(1),o[0],0,0,0), C0,8); \
    KRD(GL,1); GAPB(o[1]=__builtin_amdgcn_mfma_f32_32x32x16_bf16(PAF(1),VFR(5),o[1],0,0,0), C0,12); \
    KRD(GL,2); GAPB(o[0]=__builtin_amdgcn_mfma_f32_32x32x16_bf16(PAF(2),VFR(2),o[0],0,0,0), C1,0); \
    KRD(GL,3); GAPB(o[1]=__builtin_amdgcn_mfma_f32_32x32x16_bf16(PAF(2),VFR(6),o[1],0,0,0), C1,4); \
    GAPB(o[0]=__builtin_amdgcn_mfma_f32_32x32x16_bf16(PAF(3),VFR(3),o[0],0,0,0), C1,8); \
    GAPB(o[1]=__builtin_amdgcn_mfma_f32_32x32x16_bf16(PAF(3),VFR(7),o[1],0,0,0), C1,12); \
    }while(0)
  int t=1;
  for(;t+5<NT;t+=2){
    STEP(pB0,pB1,pA0,pA1,t,true,true,true);     WAIT_BAR(2); RESC(); ROT();
    STEP(pA0,pA1,pB0,pB1,t+1,true,true,true);   WAIT_BAR(2); RESC(); ROT();
  }
  #define ENDW(tt) do{ if((tt)+3<NT){WAIT_BAR(2);} else if((tt)+2<NT){WAIT_BAR(1);} else {WAIT_BAR(0);} }while(0)
  for(;t+1<NT;t+=2){
    STEP(pB0,pB1,pA0,pA1,t,(t+3<NT),(t+1<NT),(t+1<NT));       ENDW(t);   RESC(); ROT();
    STEP(pA0,pA1,pB0,pB1,t+1,(t+4<NT),(t+2<NT),(t+2<NT));     ENDW(t+1); RESC(); ROT();
  }
  STEP(pB0,pB1,pA0,pA1,NT-1,false,false,false); RESC();
  { float sacc=pB0[0]+pB0[1]; _Pragma("unroll") for(int r=2;r<16;++r)sacc+=pB0[r]; _Pragma("unroll") for(int r=0;r<16;++r)sacc+=pB1[r]; l_reg+=sacc;
    pw0=(u32x4){PKW(pB0,0),PKW(pB0,2),PKW(pB0,4),PKW(pB0,6)};pw1=(u32x4){PKW(pB0,8),PKW(pB0,10),PKW(pB0,12),PKW(pB0,14)};pw2=(u32x4){PKW(pB1,0),PKW(pB1,2),PKW(pB1,4),PKW(pB1,6)};pw3=(u32x4){PKW(pB1,8),PKW(pB1,10),PKW(pB1,12),PKW(pB1,14)};
    SBAR(); pv(o,vb0+sl_cur,PAF(0),PAF(1),PAF(2),PAF(3)); }
  #undef PKW
  #undef PAF
  #undef VFR
  #undef PIN
  #undef MX3
  #undef GAPA
  #undef GAPB
  #undef EX
  #undef VRD
  #undef KRD
  #undef STEP
  #undef ENDW
  {auto rr=__builtin_amdgcn_permlane32_swap(__float_as_uint(l_reg),__float_as_uint(l_reg),false,false);l_reg=__uint_as_float(rr[0])+__uint_as_float(rr[1]);}
  if(hi==0)wsf[32+r32]=l_reg;asm volatile("s_waitcnt lgkmcnt(0)":::"memory");
  float rli[16];
  #pragma unroll
  for(int r=0;r<16;++r)rli[r]=__builtin_amdgcn_rcpf(wsf[32+crow(r,hi)]);
  bf16*Ow=Ou+(long)(wid*QBLK)*OP;
  { bf16*stg=(bf16*)(shm+LDS_OST)+wid*2048;
    #pragma unroll
    for(int r=0;r<16;++r){const int orow=crow(r,hi);
      #pragma unroll
      for(int d0=0;d0<2;++d0)stg[orow*64+d0*32+r32]=__float2bfloat16(o[d0][r]*rli[r]);}
    asm volatile("s_waitcnt lgkmcnt(0)":::"memory");
    #pragma unroll
    for(int i=0;i<4;++i){const int row=i*8+(lane>>3),ch=lane&7; const u32x4 v=*(const u32x4*)(stg+row*64+ch*8); ATTN_STORE16(Ow+(long)row*OP+ch*8,v);} }
  asm volatile("s_waitcnt lgkmcnt(0)\n\ts_barrier":::"memory");
  #undef DMA_K
  #undef DMA_V
  #undef TROW
  #undef CMASK
  #undef SUBREF
  #undef NEGMC
  #undef START
  #undef RESC
  #undef ROT
}
constexpr int ATTN_LDS_BYTES=LDS_BYTES;
#undef SBAR
#undef WAIT_BAR
}

constexpr int D = 2048, T = 8192, LC = 256, MT = T + LC, DEPTH = 4;
constexpr int INW = 5408, INWP = 5632;
constexpr int C_NAQ = 0, C_NAK = 512, C_NAV = 1024, C_GQ = 1536, C_GK = 2048, C_GV = 2560, C_GG = 3584, C_GLR = 4608, C_CQ = 4640, C_CK = 5152, C_CV = 5280;
constexpr int NCH = MT / 64;
constexpr float LN_EPS = 1e-6f, ALPHA = 1.681792830507429f;
constexpr int NEXP = 16384;

constexpr size_t MiB = 1u << 20;
constexpr size_t WS_CTL = 0, CTL_ZERO_BYTES = 32 * 1024;
constexpr size_t WS_MOD = 1 * MiB;
constexpr size_t WS_ROPE = WS_MOD + 512 * 1024;
constexpr size_t WS_WIN = 2 * MiB;
constexpr size_t WS_WOUT = WS_WIN + 88 * MiB;
constexpr size_t WS_WP = WS_WOUT + 32 * MiB;
constexpr size_t WS_X = WS_WP + 32 * MiB;
constexpr size_t WS_Z = WS_X + 66 * MiB;
constexpr size_t WS_H = WS_Z + 66 * MiB;
constexpr size_t WS_P = WS_H + 33 * MiB;
constexpr size_t WS_QC = WS_P + 91 * MiB;
constexpr size_t WS_KC = WS_QC + 9 * MiB;
constexpr size_t WS_QTF = WS_KC + 3 * MiB;
constexpr size_t WS_QTB = WS_QTF + 9 * MiB;
constexpr size_t WS_OI = WS_QTB + 9 * MiB;
constexpr size_t WS_UPD = WS_OI + 33 * MiB;
constexpr size_t WS_SPREV = WS_UPD + 132 * MiB;
constexpr size_t WS_DEC = WS_SPREV + 132 * MiB;
constexpr size_t WS_MIX = WS_DEC + 1 * MiB;
constexpr size_t WS_ST = WS_MIX + 33 * MiB;
constexpr size_t WS_IDX = WS_ST + 66 * MiB;
constexpr size_t WS_GATE = WS_IDX + 5 * MiB;
constexpr size_t WS_PU = WS_GATE + 5 * MiB;
constexpr size_t WS_PV = WS_PU + 128 * MiB;
constexpr size_t WS_SCU = WS_PV + 128 * MiB;
constexpr size_t WS_SCV = WS_SCU + 1 * MiB;
constexpr size_t WS_VC = WS_SCV + 1 * MiB;
constexpr size_t WS_ACT = WS_VC + 3 * MiB;
constexpr size_t WS_PART = WS_ACT + 5 * MiB;
constexpr size_t WS_END = WS_PART + 67 * MiB;
constexpr int CW_BAR = 4096;

constexpr int RING_BYTES = 147456;
constexpr int LDSCTL_OFF = RING_BYTES, MISC_OFF = LDSCTL_OFF + 320;
constexpr int LDS_BYTES = 148480;
constexpr int NWAVES = 8, NT = 512;

#ifndef REP_MASK
#define REP_MASK 0
#endif
#define RP(b) ((((REP_MASK) >> (b)) & 1) ? 2 : 1)
#define GAS __attribute__((address_space(1)))
#define LAS __attribute__((address_space(3)))
typedef unsigned short bf16;
typedef unsigned v4u __attribute__((ext_vector_type(4)));
typedef unsigned v2u __attribute__((ext_vector_type(2)));
typedef float f32x4 __attribute__((ext_vector_type(4)));
typedef float f32x2 __attribute__((ext_vector_type(2)));
typedef short bf16x8v __attribute__((ext_vector_type(8)));
typedef float f32x16v __attribute__((ext_vector_type(16)));
#define LDS_WAIT() asm volatile("s_waitcnt lgkmcnt(0)" ::: "memory")
__device__ __forceinline__ unsigned f2bf(float f) { return (unsigned)__builtin_bit_cast(unsigned short, (__bf16)f); }
typedef __bf16 bf16x2_t __attribute__((ext_vector_type(2)));
__device__ __forceinline__ unsigned pk2(float lo, float hi) { const bf16x2_t b = __builtin_convertvector((f32x2){lo, hi}, bf16x2_t); return __builtin_bit_cast(unsigned, b); }
__device__ __forceinline__ float bflo(unsigned w) { return __builtin_bit_cast(float, w << 16); }
__device__ __forceinline__ float bfhi(unsigned w) { return __builtin_bit_cast(float, w & 0xffff0000u); }
__device__ __forceinline__ float bf1(bf16 v) { return __builtin_bit_cast(float, (unsigned)v << 16); }
__device__ __forceinline__ float wave_sum(float v) {
#pragma unroll
    for (int o = 1; o < 64; o <<= 1) v += __shfl_xor(v, o);
    return v;
}
__device__ __forceinline__ float silu_f(float x) { return x / (1.f + __expf(-x)); }
__device__ __forceinline__ float gelu_tanh(float x) { const float u = 0.7978845608028654f * (x + 0.044715f * x * x * x); const float t = 1.f - 2.f / (1.f + __expf(2.f * u)); return 0.5f * x * (1.f + t); }
__device__ __forceinline__ float logsigmoid_f(float z) { return fminf(z, 0.f) - __logf(1.f + __expf(-fabsf(z))); }

#define XB_TMO      128
#define XB_XCNT(j)  (256  + 64 * (j))
#define XB_XSUB(j)  (1280 + 64 * (j))
#define XB_XGEN(j)  (2304 + 64 * (j))
#define XB_TOP      3328
#define XB_TOPGEN   3392
#define XCD_BAR_WORDS 3456
#define XB_SPIN_CAP (1u << 21)
__device__ __forceinline__ unsigned xb_ld(unsigned* p)              { return __hip_atomic_load(p, __ATOMIC_RELAXED, __HIP_MEMORY_SCOPE_AGENT); }
__device__ __forceinline__ unsigned xb_add(unsigned* p, unsigned v) { return __hip_atomic_fetch_add(p, v, __ATOMIC_RELAXED, __HIP_MEMORY_SCOPE_AGENT); }
__device__ __forceinline__ unsigned xb_xcc_id() { return (unsigned)__builtin_amdgcn_s_getreg((3 << 11) | 20) & 0xFu; }
#define XB_SPIN(cond, bar) do { unsigned _sp = 0; while (cond) { __builtin_amdgcn_s_sleep(1); \
    if ((++_sp & 255u) == 0u) { if (xb_ld(&(bar)[XB_TMO])) break; if (_sp > XB_SPIN_CAP) { atomicAdd(&(bar)[XB_TMO], 1u); break; } } } } while (0)
struct XcdBarrier { unsigned* bar; unsigned x; volatile LAS unsigned* st; };
__device__ __forceinline__ XcdBarrier xcd_barrier_post(unsigned* bar, volatile LAS unsigned* st) {
    XcdBarrier b; b.bar = bar; b.x = xb_xcc_id(); b.st = st;
    if (threadIdx.x == 0) (void)xb_add(&bar[XB_XCNT(b.x)], 1u);
    return b;
}
__device__ __forceinline__ void xcd_barrier_complete(unsigned* bar, unsigned x, unsigned& nloc, unsigned& nx) {
    const unsigned G = gridDim.x * gridDim.y * gridDim.z;
    unsigned sum, cnt, mine, sp = 0u;
    for (;;) {
        sum = 0u; cnt = 0u; mine = 0u;
#pragma unroll
        for (unsigned j = 0; j < 16; ++j) { const unsigned c = xb_ld(&bar[XB_XCNT(j)]); sum += c; cnt += (c > 0u) ? 1u : 0u; mine = (j == x) ? c : mine; }
        if (sum == G) break;
        __builtin_amdgcn_s_sleep(1);
        if ((++sp & 255u) == 0u) { if (xb_ld(&bar[XB_TMO])) break; if (sp > XB_SPIN_CAP) { atomicAdd(&bar[XB_TMO], 1u); break; } }
    }
    nloc = mine > 0u ? mine : 1u; nx = cnt > 0u ? cnt : 1u;
}
__device__ __forceinline__ void xcd_barrier(const XcdBarrier& b) {
    asm volatile("s_waitcnt vmcnt(0)" ::: "memory");
    __syncthreads();
    if (threadIdx.x == 0) {
        unsigned* bar = b.bar;
        __builtin_amdgcn_s_waitcnt(0);
        unsigned nloc = b.st[0], nx = b.st[1];
        if (nloc == 0u) { xcd_barrier_complete(bar, b.x, nloc, nx); b.st[0] = nloc; b.st[1] = nx; }
        const unsigned old = xb_add(&bar[XB_XSUB(b.x)], 1u);
        const unsigned gen = old / nloc;
        if (old + 1u == (gen + 1u) * nloc) {
            __builtin_amdgcn_fence(__ATOMIC_RELEASE, "agent");
            asm volatile("s_waitcnt vmcnt(0)" ::: "memory");
            const unsigned og = xb_add(&bar[XB_TOP], 1u);
            const unsigned tg = og / nx;
            if (og + 1u == (tg + 1u) * nx) xb_add(&bar[XB_TOPGEN], 1u);
            else XB_SPIN(xb_ld(&bar[XB_TOPGEN]) == tg, bar);
            __builtin_amdgcn_fence(__ATOMIC_ACQUIRE, "agent");
            xb_add(&bar[XB_XGEN(b.x)], 1u);
            asm volatile("s_waitcnt vmcnt(0)" ::: "memory");
        } else {
            XB_SPIN(xb_ld(&bar[XB_XGEN(b.x)]) == gen, bar);
            __builtin_amdgcn_fence(__ATOMIC_ACQUIRE, "agent");
            asm volatile("s_waitcnt vmcnt(0)" ::: "memory");
        }
    }
    __syncthreads();
}

struct Args { const float* in[22]; float* out; unsigned char* ws; int ph_lo, ph_hi; };
struct Frame {
    LAS unsigned char* lds; char* ldsg;
    int tid, lane, wave, vcu, G;
    const __attribute__((address_space(4))) Args* ap;
};
#define IN_X(F) ((F).ap->in[0])
#define IN_C(F) ((F).ap->in[1])
#define IN_CTX(F) ((F).ap->in[2])
#define IN_CCTX(F) ((F).ap->in[3])
#define IN_WMOD(F) ((F).ap->in[4])
#define IN_BMOD(F) ((F).ap->in[5])
#define IN_WIN(F) ((F).ap->in[6])
#define IN_RPB(F) ((F).ap->in[7])
#define IN_GGW(F) ((F).ap->in[8])
#define IN_GGB(F) ((F).ap->in[9])
#define IN_GNW(F) ((F).ap->in[10])
#define IN_QNW(F) ((F).ap->in[11])
#define IN_KNW(F) ((F).ap->in[12])
#define IN_WOUT(F) ((F).ap->in[13])
#define IN_LN1G(F) ((F).ap->in[14])
#define IN_LN1B(F) ((F).ap->in[15])
#define IN_WQ(F) ((F).ap->in[16])
#define IN_SUBK(F) ((F).ap->in[17])
#define IN_PU(F) ((F).ap->in[18])
#define IN_PV(F) ((F).ap->in[19])
#define IN_LN2G(F) ((F).ap->in[20])
#define IN_LN2B(F) ((F).ap->in[21])
#define WSP(F, T_, off) ((T_*)((F).ap->ws + (off)))
__device__ __forceinline__ void launder(Frame& F) { int t_ = F.tid; asm volatile("" : "+v"(t_)); F.tid = t_; F.lane = t_ & 63; F.wave = __builtin_amdgcn_readfirstlane(t_ >> 6);
    const __attribute__((address_space(4))) Args* a_ = F.ap; asm volatile("" : "+s"(a_)); F.ap = a_; }

__device__ __forceinline__ void row_load_f32(const float* row, int lane, float (&v)[32]) {
#pragma unroll
    for (int j = 0; j < 4; ++j) { const f32x4 a = *(const f32x4*)(row + 8 * lane + 512 * j), b = *(const f32x4*)(row + 8 * lane + 512 * j + 4);
        v[8 * j + 0] = a[0]; v[8 * j + 1] = a[1]; v[8 * j + 2] = a[2]; v[8 * j + 3] = a[3]; v[8 * j + 4] = b[0]; v[8 * j + 5] = b[1]; v[8 * j + 6] = b[2]; v[8 * j + 7] = b[3]; }
}
__device__ __forceinline__ void row_store_f32(float* row, int lane, const float (&v)[32]) {
#pragma unroll
    for (int j = 0; j < 4; ++j) { *(f32x4*)(row + 8 * lane + 512 * j) = (f32x4){v[8 * j], v[8 * j + 1], v[8 * j + 2], v[8 * j + 3]}; *(f32x4*)(row + 8 * lane + 512 * j + 4) = (f32x4){v[8 * j + 4], v[8 * j + 5], v[8 * j + 6], v[8 * j + 7]}; }
}
__device__ __forceinline__ void row_load_bf16(const bf16* row, int lane, float (&v)[32]) {
#pragma unroll
    for (int j = 0; j < 4; ++j) { const v4u w = *(const v4u*)(row + 8 * lane + 512 * j);
        v[8 * j + 0] = bflo(w.x); v[8 * j + 1] = bfhi(w.x); v[8 * j + 2] = bflo(w.y); v[8 * j + 3] = bfhi(w.y); v[8 * j + 4] = bflo(w.z); v[8 * j + 5] = bfhi(w.z); v[8 * j + 6] = bflo(w.w); v[8 * j + 7] = bfhi(w.w); }
}
__device__ __forceinline__ void row_fetch_bf16(const bf16* row, int lane, v4u (&w)[4]) {
#pragma unroll
    for (int j = 0; j < 4; ++j) w[j] = *(const v4u*)(row + 8 * lane + 512 * j);
}
__device__ __forceinline__ void row_expand_bf16(const v4u (&w)[4], float (&v)[32]) {
#pragma unroll
    for (int j = 0; j < 4; ++j) { v[8 * j + 0] = bflo(w[j].x); v[8 * j + 1] = bfhi(w[j].x); v[8 * j + 2] = bflo(w[j].y); v[8 * j + 3] = bfhi(w[j].y); v[8 * j + 4] = bflo(w[j].z); v[8 * j + 5] = bfhi(w[j].z); v[8 * j + 6] = bflo(w[j].w); v[8 * j + 7] = bfhi(w[j].w); }
}
__device__ __forceinline__ void row_store_bf16(bf16* row, int lane, const float (&v)[32]) {
#pragma unroll
    for (int j = 0; j < 4; ++j) { v4u w; w.x = pk2(v[8 * j], v[8 * j + 1]); w.y = pk2(v[8 * j + 2], v[8 * j + 3]); w.z = pk2(v[8 * j + 4], v[8 * j + 5]); w.w = pk2(v[8 * j + 6], v[8 * j + 7]); *(v4u*)(row + 8 * lane + 512 * j) = w; }
}
__device__ __forceinline__ void row_norm(float (&v)[32]) {
    float s = 0.f;
#pragma unroll
    for (int i = 0; i < 32; ++i) s += v[i];
    const float mean = wave_sum(s) * (1.f / D); float q = 0.f;
#pragma unroll
    for (int i = 0; i < 32; ++i) { v[i] -= mean; q += v[i] * v[i]; }
    const float rstd = rsqrtf(wave_sum(q) * (1.f / D) + LN_EPS);
#pragma unroll
    for (int i = 0; i < 32; ++i) v[i] *= rstd;
}
__device__ __forceinline__ void row_affine(float (&v)[32], const float* mul, const float* add, int lane, float one) {
#pragma unroll
    for (int j = 0; j < 4; ++j)
#pragma unroll
        for (int h = 0; h < 2; ++h) { const f32x4 m = *(const f32x4*)(mul + 8 * lane + 512 * j + 4 * h), a = *(const f32x4*)(add + 8 * lane + 512 * j + 4 * h);
#pragma unroll
            for (int c = 0; c < 4; ++c) v[8 * j + 4 * h + c] = v[8 * j + 4 * h + c] * (one + m[c]) + a[c]; }
}

__device__ __forceinline__ void p0_transpose_item(const float* W, int K, int N, bf16* WT, LAS float* scr, int item, int lane) {
    const int nblk = N / 32, kb = item / nblk, nb = item % nblk, k0 = 64 * kb, n0 = 32 * nb;
#pragma unroll 8
    for (int i = 0; i < 32; ++i) { const int kk = 2 * i + (lane >> 5); scr[kk * 33 + (lane & 31)] = W[(size_t)(k0 + kk) * N + n0 + (lane & 31)]; }
    LDS_WAIT(); asm volatile("" ::: "memory");
    const int c = lane & 7;
#pragma unroll
    for (int j = 0; j < 4; ++j) { const int n = (lane >> 3) + 8 * j; const LAS float* s = scr + (8 * c) * 33 + n;
        v4u o; o.x = pk2(s[0 * 33], s[1 * 33]); o.y = pk2(s[2 * 33], s[3 * 33]); o.z = pk2(s[4 * 33], s[5 * 33]); o.w = pk2(s[6 * 33], s[7 * 33]);
        *(v4u*)(WT + (size_t)(n0 + n) * K + k0 + 8 * c) = o; }
    LDS_WAIT(); asm volatile("" ::: "memory");
}

__device__ __forceinline__ void phase_prologue_a(Frame& F) {
    launder(F);
    const int tid = F.tid, lane = F.lane, wave = F.wave;
    for (int rp = 0; rp < RP(16); ++rp) {
        LAS float* sc = (LAS float*)F.lds;
        LAS float* red = sc + 4096;
        for (int i = tid; i < D; i += NT) { sc[i] = silu_f(IN_C(F)[i]); sc[D + i] = silu_f(IN_CCTX(F)[i]); }
        __syncthreads();
        for (int u = F.vcu; u < DEPTH * 96; u += F.G) {
            const int l = u / 96, cg = u % 96;
            const float* W = IN_WMOD(F) + (size_t)l * D * 12288 + cg * 128 + 2 * lane;
            const int k0 = wave * 256; float a0 = 0.f, a1 = 0.f, b0 = 0.f, b1 = 0.f;
#pragma unroll 8
            for (int kk = 0; kk < 256; ++kk) { const f32x2 w = *(const f32x2*)(W + (size_t)(k0 + kk) * 12288); const float s0 = sc[k0 + kk], s1 = sc[D + k0 + kk];
                a0 += s0 * w.x; a1 += s0 * w.y; b0 += s1 * w.x; b1 += s1 * w.y; }
            LAS float* r = red + (wave * 64 + lane) * 4; r[0] = a0; r[1] = a1; r[2] = b0; r[3] = b1;
            __syncthreads();
            if (wave == 0) { float s[4] = {0.f, 0.f, 0.f, 0.f};
#pragma unroll
                for (int w = 0; w < 8; ++w)
#pragma unroll
                    for (int c = 0; c < 4; ++c) s[c] += red[(w * 64 + lane) * 4 + c];
                const int col = cg * 128 + 2 * lane; const float* bm = IN_BMOD(F) + l * 12288 + col; float* mo = WSP(F, float, WS_MOD) + (size_t)l * 2 * 12288 + col;
                mo[0] = s[0] + bm[0]; mo[1] = s[1] + bm[1]; mo[12288] = s[2] + bm[0]; mo[12288 + 1] = s[3] + bm[1]; }
            __syncthreads();
        }
        __syncthreads();
    }
    for (int rp = 0; rp < RP(17); ++rp) {
        LAS float* scr = (LAS float*)(F.lds + wave * 16384);
        const int gw = F.vcu * NWAVES + wave, NGW = F.G * NWAVES;
        constexpr int I_IN = (D / 64) * (INW / 32), I_OUT = (D / 64) * (D / 32), I_L = I_IN + I_OUT;
        for (int it = gw; it < DEPTH * I_L; it += NGW) {
            const int l = it / I_L, r = it % I_L;
            if (r < I_IN) p0_transpose_item(IN_WIN(F) + (size_t)l * D * INW, D, INW, WSP(F, bf16, WS_WIN) + (size_t)l * INWP * D, scr, r, lane);
            else p0_transpose_item(IN_WOUT(F) + (size_t)l * D * D, D, D, WSP(F, bf16, WS_WOUT) + (size_t)l * D * D, scr, r - I_IN, lane);
        }
        const int gt = F.vcu * NT + tid, NGT = F.G * NT;
        for (int i = gt; i < DEPTH * 57344; i += NGT) { const int l = i / 57344, r = i % 57344; *(v4u*)(WSP(F, bf16, WS_WIN) + (size_t)l * INWP * D + (size_t)INW * D + (size_t)r * 8) = (v4u){0u, 0u, 0u, 0u}; }
        for (int i = gt; i < 2048; i += NGT) {
            const int pos = i >> 4, p = i & 15;
            const float invf[16] = {1.0f, 0.5623413324356079f, 0.3162277638912201f, 0.17782793939113617f, 0.10000000149011612f, 0.05623413249850273f, 0.03162277489900589f, 0.017782794311642647f,
                                    0.009999999776482582f, 0.005623413249850273f, 0.003162277629598975f, 0.0017782794311642647f, 0.0010000000474974513f, 0.000562341301701963f, 0.0003162277571391314f, 0.00017782794020604342f};
            float th_f = invf[0];
#pragma unroll
            for (int q = 1; q < 16; ++q) th_f = (p == q) ? invf[q] : th_f;
            const double th = (double)th_f, t2 = th * th;
            double cs = 1.0, sn = th, tc = 1.0, ts = th;
#pragma unroll
            for (int n = 1; n <= 10; ++n) { tc *= -t2 / (double)((2 * n - 1) * (2 * n)); ts *= -t2 / (double)((2 * n) * (2 * n + 1)); cs += tc; sn += ts; }
            double rc = 1.0, rs = 0.0, bc = cs, bs = sn;
#pragma unroll
            for (int b = 0; b < 7; ++b) { if ((pos >> b) & 1) { const double nc = rc * bc - rs * bs, ns = rc * bs + rs * bc; rc = nc; rs = ns; } const double nb = bc * bc - bs * bs, nbs = 2.0 * bc * bs; bc = nb; bs = nbs; }
            WSP(F, float, WS_ROPE)[i] = (float)rc; WSP(F, float, WS_ROPE)[2048 + i] = (float)rs;
        }
        __syncthreads();
    }
    for (int rp = 0; rp < RP(18); ++rp) {
        const int gw = F.vcu * NWAVES + wave, NGW = F.G * NWAVES;
        for (int r = gw; r < 2 * DEPTH * NEXP; r += NGW) {
            const bool isv = r >= DEPTH * NEXP; const int rr = isv ? r - DEPTH * NEXP : r;
            const float* src = (isv ? IN_PV(F) : IN_PU(F)) + (size_t)rr * D;
            float v[32]; row_load_f32(src, lane, v);
            float mx = 0.f;
#pragma unroll
            for (int i = 0; i < 32; ++i) mx = fmaxf(mx, fabsf(v[i]));
#pragma unroll
            for (int o = 1; o < 64; o <<= 1) mx = fmaxf(mx, __shfl_xor(mx, o));
            const float sc = mx > 0.f ? 240.f / mx : 0.f;
            unsigned char* dst = WSP(F, unsigned char, isv ? WS_PV : WS_PU) + (size_t)rr * D + 16 * lane;
#pragma unroll
            for (int hf = 0; hf < 2; ++hf) { v4u o;
#pragma unroll
                for (int w = 0; w < 4; ++w) { const int b = 8 * (2 * hf + (w >> 1)) + 4 * (w & 1); int p = 0;
                    p = __builtin_amdgcn_cvt_pk_fp8_f32(v[b] * sc, v[b + 1] * sc, p, false); p = __builtin_amdgcn_cvt_pk_fp8_f32(v[b + 2] * sc, v[b + 3] * sc, p, true); o[w] = (unsigned)p; }
                *(v4u*)(dst + 1024 * hf) = o; }
            if (lane == 0) WSP(F, float, WS_SCU)[2 * rr + (isv ? 1 : 0)] = mx * (1.f / 240.f);
        }
    }
    for (int rp = 0; rp < RP(19); ++rp) {
        const int gw = F.vcu * NWAVES + wave, NGW = F.G * NWAVES, fr = lane & 15, fq = lane >> 4;
        for (int task = gw; task < DEPTH * 16 * 4 * 32; task += NGW) {
            const int l = task >> 11, hp = (task >> 7) & 15, mt = (task >> 5) & 3, nt = task & 31;
            const float* wq = IN_WQ(F) + (size_t)l * D * D + (size_t)(64 * nt + fr) * D + hp * 128 + 8 * fq;
            const float* sk = IN_SUBK(F) + (((size_t)l * 16 + hp) * 128 + 32 * mt + fr) * 128 + 8 * fq;
            f32x4 acc[4][2];
#pragma unroll
            for (int n = 0; n < 4; ++n)
#pragma unroll
                for (int m = 0; m < 2; ++m) acc[n][m] = (f32x4){0.f, 0.f, 0.f, 0.f};
#define WP_LOAD(AR, BR, ks_) do { _Pragma("unroll") for (int n = 0; n < 4; ++n) { AR[n][0] = *(const f32x4*)(wq + (size_t)(16 * n) * D + 32 * (ks_)); AR[n][1] = *(const f32x4*)(wq + (size_t)(16 * n) * D + 32 * (ks_) + 4); } \
                _Pragma("unroll") for (int m = 0; m < 2; ++m) { BR[m][0] = *(const f32x4*)(sk + (16 * m) * 128 + 32 * (ks_)); BR[m][1] = *(const f32x4*)(sk + (16 * m) * 128 + 32 * (ks_) + 4); } } while (0)
#define WP_STEP(AR, BR) do { bf16x8v ah[4], al[4], bh[2], bl[2]; \
                _Pragma("unroll") for (int n = 0; n < 4; ++n) _Pragma("unroll") for (int e = 0; e < 8; ++e) { const float x = AR[n][e >> 2][e & 3]; const unsigned hb = f2bf(x); ah[n][e] = (short)hb; al[n][e] = (short)f2bf(x - __builtin_bit_cast(float, hb << 16)); } \
                _Pragma("unroll") for (int m = 0; m < 2; ++m) _Pragma("unroll") for (int e = 0; e < 8; ++e) { const float x = BR[m][e >> 2][e & 3]; const unsigned hb = f2bf(x); bh[m][e] = (short)hb; bl[m][e] = (short)f2bf(x - __builtin_bit_cast(float, hb << 16)); } \
                _Pragma("unroll") for (int n = 0; n < 4; ++n) _Pragma("unroll") for (int m = 0; m < 2; ++m) { acc[n][m] = __builtin_amdgcn_mfma_f32_16x16x32_bf16(ah[n], bh[m], acc[n][m], 0, 0, 0); \
                    acc[n][m] = __builtin_amdgcn_mfma_f32_16x16x32_bf16(ah[n], bl[m], acc[n][m], 0, 0, 0); acc[n][m] = __builtin_amdgcn_mfma_f32_16x16x32_bf16(al[n], bh[m], acc[n][m], 0, 0, 0); } } while (0)
            { f32x4 arA[4][2], brA[2][2], arB[4][2], brB[2][2];
              WP_LOAD(arA, brA, 0);
#pragma unroll 1
              for (int ks = 0; ks < 4; ks += 2) {
                  WP_LOAD(arB, brB, ks + 1);
                  __builtin_amdgcn_sched_barrier(0);
                  WP_STEP(arA, brA);
                  __builtin_amdgcn_sched_barrier(0);
                  { const int kn = (ks + 2 < 4) ? ks + 2 : ks; WP_LOAD(arA, brA, kn); }
                  __builtin_amdgcn_sched_barrier(0);
                  WP_STEP(arB, brB);
                  __builtin_amdgcn_sched_barrier(0);
              } }
#undef WP_LOAD
#undef WP_STEP
#pragma unroll
            for (int n = 0; n < 4; ++n)
#pragma unroll
                for (int m = 0; m < 2; ++m) { bf16* dst = WSP(F, bf16, WS_WP) + ((size_t)l * D + hp * 128 + 32 * mt + 16 * m + fr) * D + 64 * nt + 16 * n + 4 * fq;
                    *(v2u*)dst = (v2u){pk2(acc[n][m][0], acc[n][m][1]), pk2(acc[n][m][2], acc[n][m][3])}; }
        }
    }
}

__device__ __forceinline__ void phase_ln0(Frame& F) {
    launder(F);
    const int gw = F.vcu * NWAVES + F.wave, NGW = F.G * NWAVES, lane = F.lane;
    for (int m = gw; m < MT; m += NGW) {
        const float* src = (m < LC) ? IN_CTX(F) + (size_t)m * D : IN_X(F) + (size_t)(m - LC) * D;
        const float* mod = WSP(F, float, WS_MOD) + (m < LC ? 12288 : 0);
        float v[32]; row_load_f32(src, lane, v);
        row_store_bf16(WSP(F, bf16, WS_X) + (size_t)m * D, lane, v);
        row_norm(v); row_affine(v, mod + D, mod, lane, 1.f);
        row_store_bf16(WSP(F, bf16, WS_H) + (size_t)m * D, lane, v);
    }
}

__device__ __forceinline__ void phase_qknorm(Frame& F, int l) {
    launder(F);
    const int heavy = (NCH * 4 > 2 * F.G && NCH * 4 - 2 * F.G < F.G / 2) ? NCH * 4 - 2 * F.G : 0;
    if (F.vcu < heavy) return;
    const int gw = (F.vcu - heavy) * NWAVES + F.wave, NGW = (F.G - heavy) * NWAVES, lane = F.lane, p = lane & 31, hsel = lane >> 5;
    const float* rc = WSP(F, float, WS_ROPE); const float* rsn = rc + 2048;
    const bf16* P = WSP(F, bf16, WS_P);
    const float nq0 = IN_QNW(F)[l * 64 + 2 * p], nq1 = IN_QNW(F)[l * 64 + 2 * p + 1], nk0 = IN_KNW(F)[l * 64 + 2 * p], nk1 = IN_KNW(F)[l * 64 + 2 * p + 1];
    unsigned wn[5]; v4u vcn = (v4u){0u, 0u, 0u, 0u};
#define QK_LOAD(m_) do { _Pragma("unroll") for (int it = 0; it < 5; ++it) { const int hv = 2 * it + hsel; const int col = (hv < 8) ? (C_CQ + hv * 64) : (C_CK + (hv - 8) * 64); \
        wn[it] = *(const unsigned*)(P + (size_t)(m_) * INWP + col + 2 * p); } if (lane < 16) vcn = *(const v4u*)(P + (size_t)(m_) * INWP + C_CV + lane * 8); } while (0)
    if (gw < MT) QK_LOAD(gw);
#pragma unroll 1
    for (int m = gw; m < MT; m += NGW) {
        unsigned w5[5]; v4u vc = vcn;
#pragma unroll
        for (int it = 0; it < 5; ++it) w5[it] = wn[it];
        float c = 1.f, sn = 0.f;
        if (m >= LC) { const int t = m - LC, pos = (p < 16) ? (t >> 6) : (t & 63); c = rc[pos * 16 + (p & 15)]; sn = rsn[pos * 16 + (p & 15)]; }
        if (m + NGW < MT) QK_LOAD(m + NGW);
        unsigned y[5];
#pragma unroll
        for (int it = 0; it < 5; ++it) {
            const int hv = 2 * it + hsel;
            float x0 = bflo(w5[it]), x1 = bfhi(w5[it]);
            float ss = x0 * x0 + x1 * x1;
#pragma unroll
            for (int o = 1; o < 32; o <<= 1) ss += __shfl_xor(ss, o);
            const float rstd = rsqrtf(ss * (1.f / 64.f) + LN_EPS);
            x0 = x0 * rstd * (hv < 8 ? nq0 : nk0); x1 = x1 * rstd * (hv < 8 ? nq1 : nk1);
            { const float y0 = x0 * c - x1 * sn, y1 = x0 * sn + x1 * c; x0 = y0; x1 = y1; }
            y[it] = (hv < 8) ? pk2(x0 * attn_body::C2, x1 * attn_body::C2) : pk2(x0, x1);
        }
#pragma unroll
        for (int it = 0; it < 5; ++it) { const int hv = 2 * it + hsel;
            if (hv < 8) *(unsigned*)(WSP(F, bf16, WS_QC) + (size_t)m * 512 + hv * 64 + 2 * p) = y[it];
            else *(unsigned*)(WSP(F, bf16, WS_KC) + (size_t)m * 128 + (hv - 8) * 64 + 2 * p) = y[it]; }
        if (lane < 16) *(v4u*)(WSP(F, bf16, WS_VC) + (size_t)m * 128 + lane * 8) = vc;
    }
#undef QK_LOAD
}

constexpr int GL_BSTR = 130, GL_QSTR = 136, GL_TSTR = 72;
constexpr int GL_OFF_BB = 33280, GL_OFF_QX = 66560, GL_OFF_KX = 83968, GL_OFF_KET = 101376;
template <int CTRL> __device__ __forceinline__ float dpp_f(float v) { return __builtin_bit_cast(float, __builtin_amdgcn_update_dpp(0, __builtin_bit_cast(int, v), CTRL, 0xF, 0xF, true)); }
__device__ __forceinline__ int crow32(int r, int hi) { return (r & 3) + 8 * (r >> 2) + 4 * hi; }
__device__ __forceinline__ void phase_gla_chunk(Frame& F, int l) {
    launder(F);
    const int tid = F.tid, lane = F.lane, wave = F.wave;
    LAS float* BF = (LAS float*)F.lds; LAS float* BB = (LAS float*)(F.lds + GL_OFF_BB);
    LAS bf16* VT = (LAS bf16*)F.lds;
    LAS bf16* QX = (LAS bf16*)(F.lds + GL_OFF_QX); LAS bf16* KX = (LAS bf16*)(F.lds + GL_OFF_KX);
    LAS float* LR = (LAS float*)(F.lds + GL_OFF_QX); LAS bf16* AC = (LAS bf16*)(F.lds + GL_OFF_QX);
    LAS bf16* KET = (LAS bf16*)(F.lds + GL_OFF_KET);
    const bf16* P = WSP(F, bf16, WS_P);
    for (int u = F.vcu; u < NCH * 4; u += F.G) {
        const int g = u >> 2, hh = u & 3, r0 = g * 64;
        unsigned short lrw[4];
#pragma unroll
        for (int c = 0; c < 4; ++c) { const int i = tid + c * NT; lrw[c] = P[(size_t)(r0 + (i >> 5)) * INWP + C_GLR + (i & 31)]; }
        const v4u kq0 = *(const v4u*)(P + (size_t)(r0 + lane) * INWP + C_GK + hh * 128 + wave * 16), kq1 = *(const v4u*)(P + (size_t)(r0 + lane) * INWP + C_GK + hh * 128 + wave * 16 + 8);
        unsigned qw8[8], kw8[8];
#pragma unroll
        for (int it = 0; it < 8; ++it) { const int i = it * 8 + wave; qw8[it] = *(const unsigned*)(P + (size_t)(r0 + i) * INWP + C_GQ + hh * 128 + 2 * lane); kw8[it] = *(const unsigned*)(P + (size_t)(r0 + i) * INWP + C_GK + hh * 128 + 2 * lane); }
        v4u vw4[4];
#pragma unroll
        for (int c4 = 0; c4 < 4; ++c4) vw4[c4] = *(const v4u*)(P + (size_t)(r0 + lane) * INWP + C_GV + hh * 256 + wave * 32 + 8 * c4);
#pragma unroll
        for (int c = 0; c < 4; ++c) LR[tid + c * NT] = bf1(lrw[c]);
        __syncthreads();
        { const int d = tid & 127, ig = tid >> 7;
          const float* Wf = IN_GGW(F) + ((size_t)l * 2 + 0) * 16 * 512 + hh * 128 + d; const float* Wb = IN_GGW(F) + ((size_t)l * 2 + 1) * 16 * 512 + hh * 128 + d;
          float wf[16], wb[16];
#pragma unroll
          for (int r = 0; r < 16; ++r) { wf[r] = Wf[r * 512]; wb[r] = Wb[r * 512]; }
          const float bfv = IN_GGB(F)[((size_t)l * 2 + 0) * 512 + hh * 128 + d], bbv = IN_GGB(F)[((size_t)l * 2 + 1) * 512 + hh * 128 + d];
          for (int i = ig * 16; i < ig * 16 + 16; ++i) { float zf = bfv, zb = bbv;
#pragma unroll
              for (int r = 0; r < 16; ++r) { zf += LR[i * 32 + r] * wf[r]; zb += LR[i * 32 + 16 + r] * wb[r]; }
              BF[i * GL_BSTR + d] = logsigmoid_f(zf) * (1.f / 16.f); BB[i * GL_BSTR + d] = logsigmoid_f(zb) * (1.f / 16.f); } }
        __syncthreads();
        if (tid < 128) { float sacc = 0.f;
#pragma unroll 8
            for (int i = 0; i < 64; ++i) { sacc += BF[i * GL_BSTR + tid]; BF[i * GL_BSTR + tid] = sacc; } }
        else if (tid < 256) { const int d = tid - 128; float sacc = 0.f;
#pragma unroll 8
            for (int i = 63; i >= 0; --i) { sacc += BB[i * GL_BSTR + d]; BB[i * GL_BSTR + d] = sacc; } }
        __syncthreads();
        { const int j = lane, d0 = wave * 16;
          const unsigned kw[8] = {kq0.x, kq0.y, kq0.z, kq0.w, kq1.x, kq1.y, kq1.z, kq1.w};
#pragma unroll
          for (int c = 0; c < 16; ++c) { const int d = d0 + c; const float kv = (c & 1) ? bfhi(kw[c >> 1]) : bflo(kw[c >> 1]);
              const float bl = BF[63 * GL_BSTR + d], b0 = BB[d];
              KET[(0 * 128 + d) * GL_TSTR + j] = (bf16)f2bf(kv * __expf(bl - BF[j * GL_BSTR + d]));
              KET[(1 * 128 + d) * GL_TSTR + j] = (bf16)f2bf(kv * __expf(b0 - BB[j * GL_BSTR + d]));
              if (j == 0) { WSP(F, float, WS_DEC)[((size_t)(0 * NCH + g) * 4 + hh) * 128 + d] = __expf(bl); WSP(F, float, WS_DEC)[((size_t)(1 * NCH + g) * 4 + hh) * 128 + d] = __expf(b0); } } }
        const int ti = wave >> 1, tjb = wave & 1, fr = lane & 15, fq = lane >> 4;
        f32x4 asum[2]; asum[0] = (f32x4){0.f, 0.f, 0.f, 0.f}; asum[1] = asum[0];
#pragma unroll 1
        for (int dir = 0; dir < 2; ++dir) {
            LAS float* BX = dir ? BB : BF; bf16* QTg = WSP(F, bf16, dir ? WS_QTB : WS_QTF);
            __syncthreads();
#pragma unroll
            for (int it = 0; it < 8; ++it) { const int i = it * 8 + wave, d = 2 * lane;
                const unsigned qw = qw8[it], kw = kw8[it];
                const f32x2 b = *(LAS f32x2*)(BX + i * GL_BSTR + d);
                const unsigned qt = pk2(bflo(qw) * 0.08838834764831845f * __expf(b.x), bfhi(qw) * 0.08838834764831845f * __expf(b.y)), kt = pk2(bflo(kw) * __expf(-b.x), bfhi(kw) * __expf(-b.y));
                *(LAS unsigned*)(QX + i * GL_QSTR + d) = qt; *(LAS unsigned*)(KX + i * GL_QSTR + d) = kt;
                *(unsigned*)(QTg + ((((size_t)((r0 + i) >> 5) * 4 + hh) * 8 + (lane >> 3)) * 64 + ((r0 + i) & 31) + 32 * ((lane >> 2) & 1)) * 8 + 2 * (lane & 3)) = qt; }
            __syncthreads();
            f32x4 acc[2]; acc[0] = (f32x4){0.f, 0.f, 0.f, 0.f}; acc[1] = acc[0];
#pragma unroll
            for (int ks = 0; ks < 4; ++ks) { const bf16x8v a = *(const LAS bf16x8v*)(QX + (16 * ti + fr) * GL_QSTR + 32 * ks + 8 * fq);
#pragma unroll
                for (int t = 0; t < 2; ++t) { const bf16x8v b = *(const LAS bf16x8v*)(KX + (16 * (2 * tjb + t) + fr) * GL_QSTR + 32 * ks + 8 * fq);
                    acc[t] = __builtin_amdgcn_mfma_f32_16x16x32_bf16(a, b, acc[t], 0, 0, 0); } }
#pragma unroll
            for (int t = 0; t < 2; ++t)
#pragma unroll
                for (int r = 0; r < 4; ++r) { const int i = 16 * ti + 4 * fq + r, j = 16 * (2 * tjb + t) + fr; const bool keep = dir ? (j >= i) : (j <= i); asum[t][r] += keep ? acc[t][r] : 0.f; }
        }
        __syncthreads();
#pragma unroll
        for (int t = 0; t < 2; ++t)
#pragma unroll
            for (int r = 0; r < 4; ++r) AC[(16 * ti + 4 * fq + r) * GL_TSTR + 16 * (2 * tjb + t) + fr] = (bf16)f2bf(asum[t][r]);
        { const int j = lane, v0 = wave * 32;
#pragma unroll
          for (int c4 = 0; c4 < 4; ++c4) { const v4u w = vw4[c4]; const unsigned ww[4] = {w.x, w.y, w.z, w.w};
#pragma unroll
              for (int c = 0; c < 8; ++c) VT[(v0 + 8 * c4 + c) * GL_TSTR + j] = (bf16)((c & 1) ? (ww[c >> 1] >> 16) : (ww[c >> 1] & 0xffffu)); } }
        __syncthreads();
        { const int r32 = lane & 31, hi = lane >> 5; bf16x8v vt[4];
#pragma unroll
          for (int ks = 0; ks < 4; ++ks) vt[ks] = *(const LAS bf16x8v*)(VT + (32 * wave + r32) * GL_TSTR + 16 * ks + 8 * hi);
#pragma unroll
          for (int t = 0; t < 2; ++t) { f32x16v o;
#pragma unroll
              for (int r = 0; r < 16; ++r) o[r] = 0.f;
#pragma unroll
              for (int ks = 0; ks < 4; ++ks) { const bf16x8v a = *(const LAS bf16x8v*)(AC + (32 * t + r32) * GL_TSTR + 16 * ks + 8 * hi); o = __builtin_amdgcn_mfma_f32_32x32x16_bf16(a, vt[ks], o, 0, 0, 0); }
              unsigned* oi = WSP(F, unsigned, WS_OI) + ((((size_t)(g * 4 + hh) * 2 + t) * 8 + wave) * 8) * 64 + lane;
#pragma unroll
              for (int i = 0; i < 8; ++i) oi[i * 64] = pk2(o[2 * i], o[2 * i + 1]); }
#pragma unroll 1
          for (int dir = 0; dir < 2; ++dir)
#pragma unroll
              for (int td = 0; td < 4; ++td) { f32x16v o;
#pragma unroll
                  for (int r = 0; r < 16; ++r) o[r] = 0.f;
#pragma unroll
                  for (int ks = 0; ks < 4; ++ks) { const bf16x8v b = *(const LAS bf16x8v*)(KET + (dir * 128 + 32 * td + r32) * GL_TSTR + 16 * ks + 8 * hi); o = __builtin_amdgcn_mfma_f32_32x32x16_bf16(b, vt[ks], o, 0, 0, 0); }
                  bf16* up = WSP(F, bf16, WS_UPD) + ((size_t)(dir * NCH + g) * 4 + hh) * 32768 + (size_t)((2 * wave + (r32 >> 4)) * 16 + 4 * td) * 128 + (r32 & 15) * 8 + 4 * hi;
#pragma unroll
                  for (int rq = 0; rq < 4; ++rq) *(v2u*)(up + rq * 128) = (v2u){pk2(o[4 * rq], o[4 * rq + 1]), pk2(o[4 * rq + 2], o[4 * rq + 3])}; } }
        __syncthreads();
    }
}

__device__ __forceinline__ void phase_attn(Frame& F, int l) {
    launder(F);
    const int tid = F.tid;
    for (int rp = 0; rp < RP(5); ++rp) {
        const int gt = F.vcu * NT + tid, NGT = F.G * NT;
        for (int e = gt; e < 2 * 4 * 256 * 64; e += NGT) {
            const int d2 = 8 * ((e >> 6) & 15) + 2 * (e & 3), v = 16 * ((e >> 10) & 15) + ((e >> 2) & 15), hh = (e >> 14) & 3, dir = e >> 16;
            f32x2 S = (f32x2){0.f, 0.f};
            const size_t frag = ((size_t)((v >> 5) * 8 + (d2 >> 4)) * 64 + (v & 31) + 32 * ((d2 >> 3) & 1)) * 8 + (d2 & 7);
            f32x2 dcA[12], dcB[12]; unsigned upA[12], upB[12];
            const size_t uoff = (size_t)((v >> 4) * 16 + (d2 >> 3)) * 128 + (v & 15) * 8 + (d2 & 7);
#define SCAN_G(s_) (dir == 0 ? (s_) : ((s_) < 4 ? 3 - (s_) : NCH + 3 - (s_)))
#define SCAN_LOAD(DC, UP, b_) do { _Pragma("unroll") for (int i = 0; i < 12; ++i) { const int s_ = 12 * (b_) + i; const size_t hb = (size_t)(dir * NCH + SCAN_G(s_)) * 4 + hh; \
            DC[i] = *(const f32x2*)(WSP(F, float, WS_DEC) + hb * 128 + d2); UP[i] = *(const unsigned*)(WSP(F, bf16, WS_UPD) + hb * 32768 + uoff); } } while (0)
#define SCAN_STEP(DC, UP, b_) do { _Pragma("unroll") for (int i = 0; i < 12; ++i) { const int s_ = 12 * (b_) + i; const size_t hb = (size_t)(dir * NCH + SCAN_G(s_)) * 4 + hh; \
            *(unsigned*)(WSP(F, bf16, WS_SPREV) + hb * 32768 + frag) = pk2(S.x, S.y); S = S * DC[i] + (f32x2){bflo(UP[i]), bfhi(UP[i])}; } } while (0)
            static_assert(NCH == 132, "11 batches of 12");
            SCAN_LOAD(dcA, upA, 0);
#pragma unroll 1
            for (int b = 0; b < 11; b += 2) {
                { const int bn = (b + 1 < 11) ? b + 1 : b; SCAN_LOAD(dcB, upB, bn); }
                SCAN_STEP(dcA, upA, b);
                if (b + 1 < 11) { const int bn = b + 2; SCAN_LOAD(dcA, upA, bn); SCAN_STEP(dcB, upB, b + 1); }
            }
#undef SCAN_G
#undef SCAN_LOAD
#undef SCAN_STEP
        }
    }
    typedef attn_body::bf16 abf;
    const bf16* P = WSP(F, bf16, WS_P); bf16* MIX = WSP(F, bf16, WS_MIX);
    for (int rp = 0; rp < RP(12); ++rp) {
        for (int u = F.vcu; u < 256; u += F.G) {
            const int h = u >> 5, qb = u & 31; const size_t r0 = (size_t)LC + (size_t)qb * 256;
            attn_body::attn_unit<8, 0>((const abf*)(WSP(F, bf16, WS_QC) + r0 * 512 + h * 64), 512, (const abf*)(WSP(F, bf16, WS_KC) + (h >> 2) * 64), 128, (const abf*)(WSP(F, bf16, WS_VC) + (h >> 2) * 64), 128,
                                       (abf*)(MIX + r0 * D + 1536 + h * 64), D, NCH, F.ldsg, 0, (const LAS float*)F.lds);
        }
    }
    for (int rp = 0; rp < RP(13); ++rp) {
        for (int u = F.vcu; u < 256; u += F.G) {
            const int h = u >> 5, ir0 = (u & 31) * 4; const size_t r0 = (size_t)LC + (size_t)ir0 * 64;
            { LAS float* tab = (LAS float*)(F.lds + 98304); const float* rpb = IN_RPB(F) + ((size_t)l * 8 + h) * 465; for (int i = F.tid; i < 465; i += NT) tab[i] = rpb[i]; }
            const int band0 = min(max(ir0 - 4, 0), 120), nb = min(max(ir0 - 1, 0), 120) + 8 - band0, ntile = 4 + nb + (nb & 1);
            attn_body::attn_unit<8, 1>((const abf*)(P + r0 * INWP + C_NAQ + h * 64), INWP, (const abf*)(P + C_NAK + h * 64), INWP, (const abf*)(P + C_NAV + h * 64), INWP,
                                       (abf*)(MIX + r0 * D + h * 64), D, ntile, F.ldsg, ir0, (const LAS float*)(F.lds + 98304));
        }
    }
    if (l < DEPTH - 1) for (int rp = 0; rp < RP(14); ++rp) {
        for (int u = F.vcu; u < 16; u += F.G) {
            const int h = u & 7;
            if (u < 8) attn_body::attn_unit<8, 2>((const abf*)(P + C_NAQ + h * 64), INWP, (const abf*)(P + C_NAK + h * 64), INWP, (const abf*)(P + C_NAV + h * 64), INWP, (abf*)(MIX + h * 64), D, 4, F.ldsg, 0, (const LAS float*)F.lds);
            else attn_body::attn_unit<8, 0>((const abf*)(WSP(F, bf16, WS_QC) + h * 64), 512, (const abf*)(WSP(F, bf16, WS_KC) + (h >> 2) * 64), 128, (const abf*)(WSP(F, bf16, WS_VC) + (h >> 2) * 64), 128, (abf*)(MIX + 1536 + h * 64), D, 4, F.ldsg, 0, (const LAS float*)F.lds);
        }
    }
    __syncthreads();
}

__device__ __forceinline__ void phase_gla_out(Frame& F, int l) {
    launder(F);
    const int lane = F.lane, wave = F.wave, r32 = lane & 31, hi = lane >> 5;
    LAS float* PART = (LAS float*)F.lds;
    const int g_lo = (l < DEPTH - 1) ? 0 : 4;
    for (int u = F.vcu + g_lo * 4; u < NCH * 4; u += F.G) {
        const int g = u >> 2, hh = u & 3, r0 = g * 64, v = 32 * wave + r32;
        f32x16v o[2];
#pragma unroll
        for (int t = 0; t < 2; ++t) { const unsigned* oi = WSP(F, unsigned, WS_OI) + ((((size_t)(g * 4 + hh) * 2 + t) * 8 + wave) * 8) * 64 + lane;
#pragma unroll
            for (int i = 0; i < 8; ++i) { const unsigned w = oi[i * 64]; o[t][2 * i] = bflo(w); o[t][2 * i + 1] = bfhi(w); } }
        bf16x8v b[2][8], a[2][8];
#pragma unroll
        for (int dir = 0; dir < 2; ++dir) { const bf16* sp = WSP(F, bf16, WS_SPREV) + ((size_t)(dir * NCH + g) * 4 + hh) * 32768 + (size_t)wave * 4096 + lane * 8;
#pragma unroll
            for (int ks = 0; ks < 8; ++ks) b[dir][ks] = *(const bf16x8v*)(sp + 512 * ks); }
#pragma unroll
        for (int dir = 0; dir < 2; ++dir) {
            const bf16* qt = WSP(F, bf16, dir ? WS_QTB : WS_QTF) + ((size_t)(r0 >> 5) * 4 + hh) * 4096 + lane * 8;
#pragma unroll
            for (int t = 0; t < 2; ++t)
#pragma unroll
                for (int ks = 0; ks < 8; ++ks) a[t][ks] = *(const bf16x8v*)(qt + (size_t)t * 16384 + 512 * ks);
#pragma unroll
            for (int t = 0; t < 2; ++t)
#pragma unroll
                for (int ks = 0; ks < 8; ++ks) o[t] = __builtin_amdgcn_mfma_f32_32x32x16_bf16(a[t][ks], b[dir][ks], o[t], 0, 0, 0);
        }
        __builtin_amdgcn_sched_barrier(0);
        bf16 gtw[2][16];
#pragma unroll
        for (int t = 0; t < 2; ++t)
#pragma unroll
            for (int r = 0; r < 16; ++r) gtw[t][r] = WSP(F, bf16, WS_P)[(size_t)(r0 + 32 * t + crow32(r, hi)) * INWP + C_GG + hh * 256 + v];
        {
          const bool c4 = (r32 & 16) != 0, c3 = (r32 & 8) != 0, c2 = (r32 & 4) != 0, c1 = (r32 & 2) != 0, c0 = (r32 & 1) != 0;
          float e1[16], e2[8], e3[4], e4[2];
#pragma unroll
          for (int j = 0; j < 16; ++j) { const float q0 = o[0][j] * o[0][j], q1 = o[1][j] * o[1][j]; e1[j] = (c4 ? q1 : q0) + __shfl_xor(c4 ? q0 : q1, 16); }
#pragma unroll
          for (int j = 0; j < 8; ++j) e2[j] = (c3 ? e1[8 + j] : e1[j]) + dpp_f<0x128>(c3 ? e1[j] : e1[8 + j]);
#pragma unroll
          for (int j = 0; j < 4; ++j) e3[j] = (c2 ? e2[4 + j] : e2[j]) + dpp_f<0x141>(c2 ? e2[j] : e2[4 + j]);
#pragma unroll
          for (int j = 0; j < 2; ++j) e4[j] = (c1 ? e3[2 + j] : e3[j]) + dpp_f<0x4E>(c1 ? e3[j] : e3[2 + j]);
          const float e5 = (c0 ? e4[1] : e4[0]) + dpp_f<0xB1>(c0 ? e4[0] : e4[1]);
          PART[(32 * (r32 >> 4) + crow32(r32 & 15, hi)) * 12 + wave] = e5; }
        __syncthreads();
        const float nw = IN_GNW(F)[l * 256 + v];
#pragma unroll
        for (int t = 0; t < 2; ++t)
#pragma unroll
            for (int r = 0; r < 16; ++r) { const int row = 32 * t + crow32(r, hi); const f32x4 p0 = *(const LAS f32x4*)(PART + row * 12), p1 = *(const LAS f32x4*)(PART + row * 12 + 4);
                const float ss = (p0[0] + p0[1]) + (p0[2] + p0[3]) + (p1[0] + p1[1]) + (p1[2] + p1[3]);
                const float rstd = rsqrtf(ss * (1.f / 256.f) + LN_EPS); const float gt = bf1(gtw[t][r]);
                WSP(F, bf16, WS_MIX)[(size_t)(r0 + row) * D + 512 + hh * 256 + v] = (bf16)f2bf(o[t][r] * rstd * nw * silu_f(gt)); }
        __syncthreads();
    }
}

__device__ __forceinline__ void phase_ln1(Frame& F, int l) {
    launder(F);
    const int gw = F.vcu * NWAVES + F.wave, NGW = F.G * NWAVES, lane = F.lane;
    const int m_lo = (l < DEPTH - 1) ? 0 : LC;
    v4u nz[4];
    { const int m = (m_lo + gw < MT) ? m_lo + gw : MT - 1; row_fetch_bf16(WSP(F, bf16, WS_Z) + (size_t)m * D, lane, nz); }
    for (int m = m_lo + gw; m < MT; m += NGW) {
        const float* mod = WSP(F, float, WS_MOD) + (size_t)l * 2 * 12288 + (m < LC ? 12288 : 0);
        float v[32]; row_expand_bf16(nz, v);
        { const int mn = (m + NGW < MT) ? m + NGW : m; row_fetch_bf16(WSP(F, bf16, WS_Z) + (size_t)mn * D, lane, nz); }
        row_norm(v); row_affine(v, IN_LN1G(F) + l * D, IN_LN1B(F) + l * D, lane, 0.f);
        row_store_bf16(WSP(F, bf16, WS_X) + (size_t)m * D, lane, v);
        row_norm(v); row_affine(v, mod + 4 * D, mod + 3 * D, lane, 1.f);
        row_store_bf16(WSP(F, bf16, WS_H) + (size_t)m * D, lane, v);
    }
}

__device__ __forceinline__ void tk_merge16(float (&a)[16]) {
#pragma unroll
    for (int j = 8; j > 0; j >>= 1)
#pragma unroll
        for (int i = 0; i < 16; ++i) { const int p = i ^ j; if (p > i) { const float hi = fmaxf(a[i], a[p]), lo = fminf(a[i], a[p]); a[i] = hi; a[p] = lo; } }
}
__device__ __forceinline__ void tk_sort16(float (&a)[16]) {
#pragma unroll
    for (int k = 2; k <= 16; k <<= 1)
#pragma unroll
        for (int j = k >> 1; j > 0; j >>= 1)
#pragma unroll
            for (int i = 0; i < 16; ++i) { const int p = i ^ j; if (p > i) { const float hi = fmaxf(a[i], a[p]), lo = fminf(a[i], a[p]); const bool dsc = ((i & k) == 0); a[i] = dsc ? hi : lo; a[p] = dsc ? lo : hi; } }
}
__device__ __forceinline__ void tk_top16of128(const float* sp, float (&run)[16]) {
    float nx[16];
#pragma unroll
    for (int i = 0; i < 16; ++i) nx[i] = sp[(size_t)i * MT];
#pragma unroll 1
    for (int c = 0; c < 8; ++c) {
        float ch[16];
#pragma unroll
        for (int i = 0; i < 16; ++i) ch[i] = __builtin_bit_cast(float, (__builtin_bit_cast(unsigned, nx[i]) & ~127u) | (unsigned)(c * 16 + i));
        if (c < 7) {
#pragma unroll
            for (int i = 0; i < 16; ++i) nx[i] = sp[(size_t)((c + 1) * 16 + i) * MT]; }
        tk_sort16(ch);
        if (c == 0) {
#pragma unroll
            for (int i = 0; i < 16; ++i) run[i] = ch[i];
        } else {
#pragma unroll
            for (int i = 0; i < 16; ++i) run[i] = fmaxf(run[i], ch[15 - i]);
            tk_merge16(run);
        }
    }
}
__device__ __forceinline__ void phase_topk(Frame& F, int l) {
    launder(F);
    const int lane = F.lane, h = F.wave, tid = F.tid;
    LAS float* TS = (LAS float*)F.lds;
    const int u_lo = (l < DEPTH - 1) ? 0 : 4;
    for (int u = F.vcu + u_lo; u < NCH; u += F.G) {
        const int tok = u * 64 + lane;
        float t1[16], t2[16];
        tk_top16of128(WSP(F, float, WS_ST) + (size_t)((h * 2 + 0) * 128) * MT + tok, t1);
        tk_top16of128(WSP(F, float, WS_ST) + (size_t)((h * 2 + 1) * 128) * MT + tok, t2);
#pragma unroll
        for (int i = 0; i < 16; ++i) { TS[i * NT + tid] = t1[i]; TS[(16 + i) * NT + tid] = t2[i]; }
        float tv[16];
#define TK_CAND(i_, j_) __builtin_bit_cast(float, (__builtin_bit_cast(unsigned, t1[i_] + t2[j_]) & ~255u) | (unsigned)((i_) * 16 + (j_)))
#pragma unroll
        for (int j = 0; j < 16; ++j) tv[j] = TK_CAND(0, j);
#pragma unroll
        for (int i = 1; i < 16; ++i) {
            const int len = 16 / (i + 1);
            if (len >= 3) {
#pragma unroll
                for (int k = 0; k < 16; ++k) if (15 - k < len) tv[k] = fmaxf(tv[k], TK_CAND(i, 15 - k));
                tk_merge16(tv);
            } else {
#pragma unroll
                for (int j = 0; j < len; ++j) { float v = TK_CAND(i, j);
#pragma unroll
                    for (int s2 = 0; s2 < 16; ++s2) { const float hi = fmaxf(tv[s2], v); v = fminf(tv[s2], v); tv[s2] = hi; } }
            }
        }
#undef TK_CAND
        LDS_WAIT();
        float sv[16]; int ti[16];
#pragma unroll
        for (int s2 = 0; s2 < 16; ++s2) { const unsigned code = __builtin_bit_cast(unsigned, tv[s2]) & 255u; const float a = TS[(code >> 4) * NT + tid], b = TS[(16 + (code & 15u)) * NT + tid];
            sv[s2] = a + b; ti[s2] = (int)((__builtin_bit_cast(unsigned, a) & 127u) * 128u + (__builtin_bit_cast(unsigned, b) & 127u)); }
        float mx = sv[0];
#pragma unroll
        for (int s2 = 1; s2 < 16; ++s2) mx = fmaxf(mx, sv[s2]);
        float e[16], sum = 0.f;
#pragma unroll
        for (int s2 = 0; s2 < 16; ++s2) { e[s2] = __expf(sv[s2] - mx); sum += e[s2]; }
        const float inv = 1.f / sum;
        int* ip = WSP(F, int, WS_IDX) + (size_t)tok * 128 + h * 16; float* gp = WSP(F, float, WS_GATE) + (size_t)tok * 128 + h * 16;
#pragma unroll
        for (int s4 = 0; s4 < 4; ++s4) { *(v4u*)(ip + 4 * s4) = (v4u){(unsigned)ti[4 * s4], (unsigned)ti[4 * s4 + 1], (unsigned)ti[4 * s4 + 2], (unsigned)ti[4 * s4 + 3]};
            *(f32x4*)(gp + 4 * s4) = (f32x4){e[4 * s4] * inv, e[4 * s4 + 1] * inv, e[4 * s4 + 2] * inv, e[4 * s4 + 3] * inv}; }
        LDS_WAIT();
    }
}

__device__ __forceinline__ void phase_peer(Frame& F, int l) {
    launder(F);
    const int lane = F.lane, r8 = lane >> 3, l8 = lane & 7;
    const int gsz = F.G >> 3, grp = F.vcu / gsz, gwv = (F.vcu % gsz) * NWAVES + F.wave, gnw = gsz * NWAVES;
    const unsigned char* U = WSP(F, unsigned char, WS_PU) + (size_t)l * NEXP * D;
    const int* IDX = WSP(F, int, WS_IDX); const bf16* H = WSP(F, bf16, WS_H);
    LAS int* ET = (LAS int*)(F.lds + F.wave * 1024);
    const int m_lo = (l < DEPTH - 1) ? 0 : LC;
    const int wpos = ((lane & 7) * 16 + (lane >> 3));
#pragma unroll 1
    for (int sub = 0; sub < 2; ++sub) {
        const int s = 8 * sub + grp;
        const unsigned coff = 128u * (unsigned)s + 16u * (unsigned)l8;
        const int o0 = 8 * (8 * (s & 7) + l8) + 1024 * (s >> 3);
        unsigned* part = WSP(F, unsigned, WS_PART) + (size_t)s * MT * 64;
        int m = m_lo + gwv;
        int e16[16];
        { const int eL0 = IDX[(size_t)m * 128 + lane], eH0 = IDX[(size_t)m * 128 + 64 + lane]; ET[wpos] = eL0; ET[wpos + 8] = eH0; LDS_WAIT();
#pragma unroll
          for (int q = 0; q < 16; ++q) e16[q] = ET[r8 * 16 + q];
          LDS_WAIT(); }
        int eL, eH; { const int mn = (m + gnw < MT) ? m + gnw : m; eL = IDX[(size_t)mn * 128 + lane]; eH = IDX[(size_t)mn * 128 + 64 + lane]; }
#pragma unroll 1
        for (; m < MT; m += gnw) {
            v4u r[16];
#pragma unroll
            for (int j = 0; j < 16; ++j) r[j] = *(const v4u*)(U + ((unsigned)e16[j] * 2048u + coff));
            const v4u hw0 = *(const v4u*)(H + (size_t)m * D + o0), hw1 = *(const v4u*)(H + (size_t)m * D + o0 + 512);
            ET[wpos] = eL; ET[wpos + 8] = eH;
            { const int mn = (m + 2 * gnw < MT) ? m + 2 * gnw : m; eL = IDX[(size_t)mn * 128 + lane]; eH = IDX[(size_t)mn * 128 + 64 + lane]; }
            LDS_WAIT();
#pragma unroll
            for (int q = 0; q < 16; ++q) e16[q] = ET[r8 * 16 + q];
            f32x2 h[8];
            h[0] = (f32x2){bflo(hw0.x), bfhi(hw0.x)}; h[1] = (f32x2){bflo(hw0.y), bfhi(hw0.y)}; h[2] = (f32x2){bflo(hw0.z), bfhi(hw0.z)}; h[3] = (f32x2){bflo(hw0.w), bfhi(hw0.w)};
            h[4] = (f32x2){bflo(hw1.x), bfhi(hw1.x)}; h[5] = (f32x2){bflo(hw1.y), bfhi(hw1.y)}; h[6] = (f32x2){bflo(hw1.z), bfhi(hw1.z)}; h[7] = (f32x2){bflo(hw1.w), bfhi(hw1.w)};
            float d[16];
#pragma unroll
            for (int j = 0; j < 16; j += 2) { f32x2 p = (f32x2){0.f, 0.f}, q = (f32x2){0.f, 0.f};
#pragma unroll
                for (int w = 0; w < 4; ++w) { const f32x2 lo = __builtin_amdgcn_cvt_pk_f32_fp8((int)r[j][w], false), lo2 = __builtin_amdgcn_cvt_pk_f32_fp8((int)r[j + 1][w], false);
                    const f32x2 hi = __builtin_amdgcn_cvt_pk_f32_fp8((int)r[j][w], true), hi2 = __builtin_amdgcn_cvt_pk_f32_fp8((int)r[j + 1][w], true);
                    p += lo * h[2 * w]; q += lo2 * h[2 * w]; p += hi * h[2 * w + 1]; q += hi2 * h[2 * w + 1]; }
                d[j] = p.x + p.y; d[j + 1] = q.x + q.y; }
            const bool c2 = (l8 & 4) != 0, c1 = (l8 & 2) != 0, c0 = (l8 & 1) != 0;
            float e1[8], e2[4];
#pragma unroll
            for (int jj = 0; jj < 8; ++jj) { const int ja = (jj & 3) | ((jj >> 2) << 3); const float kp = c2 ? d[ja | 4] : d[ja], sd = c2 ? d[ja] : d[ja | 4]; e1[jj] = kp + dpp_f<0x141>(sd); }
#pragma unroll
            for (int y = 0; y < 4; ++y) { const int x = (y & 1) | ((y >> 1) << 2); const float kp = c1 ? e1[x | 2] : e1[x], sd = c1 ? e1[x] : e1[x | 2]; e2[y] = kp + dpp_f<0x4E>(sd); }
            const float v0 = (c0 ? e2[1] : e2[0]) + dpp_f<0xB1>(c0 ? e2[0] : e2[1]), v1 = (c0 ? e2[3] : e2[2]) + dpp_f<0xB1>(c0 ? e2[2] : e2[3]);
            part[(size_t)m * 64 + 8 * l8 + r8] = pk2(v0, v1);
            LDS_WAIT();
        }
    }
}

__device__ __forceinline__ void phase_peer_act(Frame& F, int l) {
    launder(F);
    const int gw = F.vcu * NWAVES + F.wave, NGW = F.G * NWAVES, lane = F.lane;
    const f32x2* SUV = WSP(F, f32x2, WS_SCU) + l * NEXP;
    const int m_lo = (l < DEPTH - 1) ? 0 : LC;
    for (int m0 = m_lo + gw; m0 < MT; m0 += 2 * NGW) {
        const int m1 = m0 + NGW; const bool two = m1 < MT; const int mm[2] = {m0, two ? m1 : m0};
        float dsum[2][2]; int e[2][2]; float gt[2][2];
#pragma unroll
        for (int t = 0; t < 2; ++t)
#pragma unroll
            for (int hlf = 0; hlf < 2; ++hlf) { const int k = 64 * hlf + lane; e[t][hlf] = WSP(F, int, WS_IDX)[(size_t)mm[t] * 128 + k]; gt[t][hlf] = WSP(F, float, WS_GATE)[(size_t)mm[t] * 128 + k]; }
#pragma unroll
        for (int t = 0; t < 2; ++t) { float d0 = 0.f, d1 = 0.f;
#pragma unroll
            for (int s = 0; s < 16; ++s) { const unsigned w = WSP(F, unsigned, WS_PART)[((size_t)s * MT + mm[t]) * 64 + lane]; d0 += bflo(w); d1 += bfhi(w); }
            dsum[t][0] = d0; dsum[t][1] = d1; }
#pragma unroll
        for (int t = 0; t < 2; ++t)
#pragma unroll
            for (int hlf = 0; hlf < 2; ++hlf) { const int k = 64 * hlf + lane;
                const f32x2 sc = SUV[e[t][hlf]];
                const float a = gelu_tanh(dsum[t][hlf] * sc.x) * gt[t][hlf] * sc.y;
                if (t == 0 || two) WSP(F, float, WS_ACT)[(size_t)mm[t] * 128 + k] = a; }
    }
}

__device__ __forceinline__ void phase_peer_v(Frame& F, int l) {
    launder(F);
    const int lane = F.lane, r8 = lane >> 3, l8 = lane & 7;
    const int gsz = F.G >> 3, grp = F.vcu / gsz, gwv = (F.vcu % gsz) * NWAVES + F.wave, gnw = gsz * NWAVES;
    const unsigned char* V = WSP(F, unsigned char, WS_PV) + (size_t)l * NEXP * D;
    const int* IDX = WSP(F, int, WS_IDX); const float* ACT = WSP(F, float, WS_ACT);
    LAS int* ET = (LAS int*)(F.lds + F.wave * 1024); LAS float* AT = (LAS float*)(F.lds + F.wave * 1024 + 512);
    const int m_lo = (l < DEPTH - 1) ? 0 : LC;
    const int wpos = ((lane & 7) * 16 + (lane >> 3));
    const bool b5 = (lane & 32) != 0, b4 = (lane & 16) != 0, b3 = (lane & 8) != 0;
#pragma unroll 1
    for (int sub = 0; sub < 2; ++sub) {
        const int s = 8 * sub + grp;
        const unsigned coff = 128u * (unsigned)s + 16u * (unsigned)l8;
        const int o0 = 8 * (8 * (s & 7) + l8) + 1024 * (s >> 3);
        int m = m_lo + gwv;
        int e16[16];
        { const int eL0 = IDX[(size_t)m * 128 + lane], eH0 = IDX[(size_t)m * 128 + 64 + lane]; ET[wpos] = eL0; ET[wpos + 8] = eH0; LDS_WAIT();
#pragma unroll
          for (int q = 0; q < 16; ++q) e16[q] = ET[r8 * 16 + q];
          LDS_WAIT(); }
        int eL, eH; { const int mn = (m + gnw < MT) ? m + gnw : m; eL = IDX[(size_t)mn * 128 + lane]; eH = IDX[(size_t)mn * 128 + 64 + lane]; }
        float aL = ACT[(size_t)m * 128 + lane], aH = ACT[(size_t)m * 128 + 64 + lane];
#pragma unroll 1
        for (; m < MT; m += gnw) {
            v4u r[16];
#pragma unroll
            for (int j = 0; j < 16; ++j) r[j] = *(const v4u*)(V + ((unsigned)e16[j] * 2048u + coff));
            AT[wpos] = aL; AT[wpos + 8] = aH; ET[wpos] = eL; ET[wpos + 8] = eH;
            { const int mn = (m + gnw < MT) ? m + gnw : m, mn2 = (m + 2 * gnw < MT) ? m + 2 * gnw : m;
              eL = IDX[(size_t)mn2 * 128 + lane]; eH = IDX[(size_t)mn2 * 128 + 64 + lane]; aL = ACT[(size_t)mn * 128 + lane]; aH = ACT[(size_t)mn * 128 + 64 + lane]; }
            LDS_WAIT();
            float a[16];
#pragma unroll
            for (int q = 0; q < 16; ++q) { e16[q] = ET[r8 * 16 + q]; a[q] = AT[r8 * 16 + q]; }
            f32x2 acc[8];
#pragma unroll
            for (int i = 0; i < 8; ++i) acc[i] = (f32x2){0.f, 0.f};
#pragma unroll
            for (int j = 0; j < 16; ++j)
#pragma unroll
                for (int w = 0; w < 4; ++w) { const f32x2 lo = __builtin_amdgcn_cvt_pk_f32_fp8((int)r[j][w], false), hi = __builtin_amdgcn_cvt_pk_f32_fp8((int)r[j][w], true);
                    acc[2 * w] += lo * a[j]; acc[2 * w + 1] += hi * a[j]; }
            f32x2 g1[4], g2[2];
#pragma unroll
            for (int i = 0; i < 4; ++i) { const f32x2 kp = b5 ? acc[i + 4] : acc[i], sd = b5 ? acc[i] : acc[i + 4]; g1[i] = (f32x2){kp.x + __shfl_xor(sd.x, 32), kp.y + __shfl_xor(sd.y, 32)}; }
#pragma unroll
            for (int i = 0; i < 2; ++i) { const f32x2 kp = b4 ? g1[i + 2] : g1[i], sd = b4 ? g1[i] : g1[i + 2]; g2[i] = (f32x2){kp.x + __shfl_xor(sd.x, 16), kp.y + __shfl_xor(sd.y, 16)}; }
            { const f32x2 kp = b3 ? g2[1] : g2[0], sd = b3 ? g2[0] : g2[1]; const f32x2 res = (f32x2){kp.x + dpp_f<0x128>(sd.x), kp.y + dpp_f<0x128>(sd.y)};
              *(unsigned*)(WSP(F, bf16, WS_Z) + (size_t)m * D + o0 + (r8 < 4 ? 2 * r8 : 512 + 2 * (r8 - 4))) = pk2(res.x, res.y); }
            LDS_WAIT();
        }
    }
}

__device__ __forceinline__ void phase_peer_tail(Frame& F, int l) {
    launder(F);
    const int gw = F.vcu * NWAVES + F.wave, NGW = F.G * NWAVES, lane = F.lane;
    const int m_lo = (l < DEPTH - 1) ? 0 : LC;
    v4u nx[4], no[4];
    { const int m = (m_lo + gw < MT) ? m_lo + gw : MT - 1; row_fetch_bf16(WSP(F, bf16, WS_X) + (size_t)m * D, lane, nx); row_fetch_bf16(WSP(F, bf16, WS_Z) + (size_t)m * D, lane, no); }
    for (int m = m_lo + gw; m < MT; m += NGW) {
        const float* mod = WSP(F, float, WS_MOD) + (size_t)l * 2 * 12288 + (m < LC ? 12288 : 0);
        float x[32], o[32]; row_expand_bf16(nx, x); row_expand_bf16(no, o);
        { const int mn = (m + NGW < MT) ? m + NGW : m; row_fetch_bf16(WSP(F, bf16, WS_X) + (size_t)mn * D, lane, nx); row_fetch_bf16(WSP(F, bf16, WS_Z) + (size_t)mn * D, lane, no); }
#pragma unroll
        for (int j = 0; j < 4; ++j)
#pragma unroll
            for (int hf = 0; hf < 2; ++hf) { const f32x4 gv = *(const f32x4*)(mod + 5 * D + 8 * lane + 512 * j + 4 * hf);
#pragma unroll
                for (int c = 0; c < 4; ++c) x[8 * j + 4 * hf + c] = ALPHA * x[8 * j + 4 * hf + c] + gv[c] * o[8 * j + 4 * hf + c]; }
        row_norm(x); row_affine(x, IN_LN2G(F) + l * D, IN_LN2B(F) + l * D, lane, 0.f);
        if (l < DEPTH - 1) {
            row_store_bf16(WSP(F, bf16, WS_X) + (size_t)m * D, lane, x);
            const float* modn = WSP(F, float, WS_MOD) + (size_t)(l + 1) * 2 * 12288 + (m < LC ? 12288 : 0);
            row_norm(x); row_affine(x, modn + D, modn, lane, 1.f);
            row_store_bf16(WSP(F, bf16, WS_H) + (size_t)m * D, lane, x);
        } else {
            row_store_f32(F.ap->out + (size_t)(m - LC) * D, lane, x);
        }
    }
}

template <int MODE> __device__ __forceinline__ void ctx_gemm(Frame& F, const bf16* A, const bf16* Bt, const bf16* X, bf16* Z, const float* g, float* ST) {
    launder(F);
    const int lane = F.lane, fr = lane & 15, fq = lane >> 4, w = F.wave;
    LAS f32x4* red = (LAS f32x4*)F.lds;
#pragma unroll 1
    for (int wt = F.vcu; wt < 256; wt += F.G) {
        const int rg = wt & 7, cg = wt >> 3;
        const bf16* ap = A + (size_t)(32 * rg + fr) * D + 8 * fq + 256 * w; const bf16* bp = Bt + (size_t)(64 * cg + fr) * D + 8 * fq + 256 * w;
        f32x4 acc[2][4];
#pragma unroll
        for (int m = 0; m < 2; ++m)
#pragma unroll
            for (int n = 0; n < 4; ++n) acc[m][n] = (f32x4){0.f, 0.f, 0.f, 0.f};
#pragma unroll 1
        for (int kb = 0; kb < 8; kb += 4) {
            bf16x8v a[4][2], b[4][4];
#pragma unroll
            for (int i = 0; i < 4; ++i) {
#pragma unroll
                for (int m = 0; m < 2; ++m) a[i][m] = *(const bf16x8v*)(ap + (size_t)(16 * m) * D + 32 * (kb + i));
#pragma unroll
                for (int n = 0; n < 4; ++n) b[i][n] = *(const bf16x8v*)(bp + (size_t)(16 * n) * D + 32 * (kb + i)); }
            __builtin_amdgcn_sched_barrier(0);
#pragma unroll
            for (int i = 0; i < 4; ++i)
#pragma unroll
                for (int m = 0; m < 2; ++m)
#pragma unroll
                    for (int n = 0; n < 4; ++n) acc[m][n] = __builtin_amdgcn_mfma_f32_16x16x32_bf16(a[i][m], b[i][n], acc[m][n], 0, 0, 0);
        }
        asm volatile("s_waitcnt vmcnt(0)" ::: "memory");
        __syncthreads();
#pragma unroll
        for (int m = 0; m < 2; ++m)
#pragma unroll
            for (int n = 0; n < 4; ++n) red[(w * 8 + m * 4 + n) * 64 + lane] = acc[m][n];
        __syncthreads();
        f32x4 sum = red[w * 64 + lane];
#pragma unroll
        for (int ww = 1; ww < 8; ++ww) sum += red[(ww * 8 + w) * 64 + lane];
        { const int m = w >> 2, n = w & 3; const int col = 64 * cg + 16 * n + fr, row0 = 32 * rg + 16 * m + 4 * fq;
          if (MODE == 0) { const float gv = g[col];
#pragma unroll
              for (int r = 0; r < 4; ++r) Z[(size_t)(row0 + r) * D + col] = (bf16)f2bf(ALPHA * bflo((unsigned)X[(size_t)(row0 + r) * D + col]) + gv * sum[r]); }
          else *(f32x4*)(ST + (size_t)col * MT + row0) = sum; }
        __syncthreads();
    }
}

#ifndef MK_MULTI
#define MK_MULTI 0
#endif
constexpr int NPL = 12, NPHASE = 2 + DEPTH * NPL;
__global__ void __launch_bounds__(NT, 2) trunk_fwd(Args args) {
    extern __shared__ __attribute__((aligned(16))) unsigned char lds[];
    Frame F;
    F.lds = (LAS unsigned char*)lds; F.ldsg = (char*)lds;
    F.tid = threadIdx.x; F.lane = F.tid & 63; F.wave = __builtin_amdgcn_readfirstlane(F.tid >> 6);
    F.G = gridDim.x; { const int bx = blockIdx.x; F.vcu = (F.G % 8 == 0) ? (bx % 8) * (F.G / 8) + bx / 8 : bx; }
    F.ap = (const __attribute__((address_space(4))) Args*)__builtin_amdgcn_kernarg_segment_ptr();
    volatile LAS unsigned* MISC = (volatile LAS unsigned*)(F.lds + MISC_OFF);
    for (int u = F.tid; u < (LDS_BYTES - LDSCTL_OFF) / 4; u += NT) ((LAS unsigned*)(F.lds + LDSCTL_OFF))[u] = 0u;
    __syncthreads();
    XcdBarrier bar; bar.bar = WSP(F, unsigned, WS_CTL) + CW_BAR; bar.x = 0; bar.st = nullptr;
    if (!MK_MULTI) bar = xcd_barrier_post(WSP(F, unsigned, WS_CTL) + CW_BAR, MISC + 8);
    const int lo = args.ph_lo, hi = args.ph_hi;
#ifndef PH_MASK
#define PH_MASK 0xFFFFFF
#endif
#define IN(k) (lo <= (k) && (k) < hi)
#define PM(b) ((PH_MASK >> (b)) & 1)
#define SEAM(k) do { if (!MK_MULTI && IN(k) && IN((k) + 1)) xcd_barrier(bar); } while (0)

    if (PM(0) && IN(0)) { for (int rp = 0; rp < RP(0); ++rp) phase_prologue_a(F); } SEAM(0);
    if (PM(1) && IN(1)) { for (int rp = 0; rp < RP(1); ++rp) phase_ln0(F); } SEAM(1);
#pragma unroll 1
    for (int l = 0; l < DEPTH; ++l) {
        const int pb = 2 + l * NPL;
        const bool ctxu = l < DEPTH - 1;
        if (PM(2) && IN(pb + 0)) for (int rp = 0; rp < RP(2); ++rp) {
            pg8::Gemm g{WSP(F, bf16, WS_H), WSP(F, bf16, WS_WIN) + (size_t)l * INWP * D, MT, INWP, D}; pg8::StaticOrder S; S.init(MT, INWP, F.G, (int)blockIdx.x);
            pg8::EpiBf16P E{WSP(F, bf16, WS_P), INWP};
            pg8::gemm_phase<pg8::EpiBf16P, pg8::StaticOrder, true, true>(F.lds, g, S, E);
        }
        SEAM(pb + 0);
        if (IN(pb + 1)) { if (PM(3)) for (int rp = 0; rp < RP(3); ++rp) phase_qknorm(F, l); if (PM(4)) for (int rp = 0; rp < RP(4); ++rp) phase_gla_chunk(F, l); }
        SEAM(pb + 1);
        if (PM(5) && IN(pb + 2)) { phase_attn(F, l); }
        SEAM(pb + 2);
        if (PM(6) && IN(pb + 3)) { for (int rp = 0; rp < RP(6); ++rp) phase_gla_out(F, l); }
        SEAM(pb + 3);
        if (PM(7) && IN(pb + 4)) for (int rp = 0; rp < RP(7); ++rp) {
            const float* modl = WSP(F, float, WS_MOD) + (size_t)l * 2 * 12288;
            pg8::Gemm g{WSP(F, bf16, WS_MIX) + (size_t)LC * D, WSP(F, bf16, WS_WOUT) + (size_t)l * D * D, T, D, D}; pg8::StaticOrder S; S.init(T, D, F.G, (int)blockIdx.x);
            pg8::EpiResid E{WSP(F, bf16, WS_X) + (size_t)LC * D, WSP(F, bf16, WS_Z) + (size_t)LC * D, modl + 2 * D, ALPHA};
            pg8::gemm_phase<pg8::EpiResid, pg8::StaticOrder, true, true>(F.lds, g, S, E);
            if (ctxu) ctx_gemm<0>(F, WSP(F, bf16, WS_MIX), WSP(F, bf16, WS_WOUT) + (size_t)l * D * D, WSP(F, bf16, WS_X), WSP(F, bf16, WS_Z), modl + 12288 + 2 * D, nullptr);
        }
        SEAM(pb + 4);
        if (PM(8) && IN(pb + 5)) { for (int rp = 0; rp < RP(8); ++rp) phase_ln1(F, l); }
        SEAM(pb + 5);
        if (PM(9) && IN(pb + 6)) for (int rp = 0; rp < RP(9); ++rp) {
            pg8::Gemm g{WSP(F, bf16, WS_WP) + (size_t)l * D * D, WSP(F, bf16, WS_H) + (size_t)LC * D, D, T, D}; pg8::StaticOrder S; S.init(D, T, F.G, (int)blockIdx.x);
            pg8::EpiStoreF32 E{WSP(F, float, WS_ST) + LC, MT};
            pg8::gemm_phase<pg8::EpiStoreF32, pg8::StaticOrder, true, true>(F.lds, g, S, E);
            if (ctxu) ctx_gemm<1>(F, WSP(F, bf16, WS_H), WSP(F, bf16, WS_WP) + (size_t)l * D * D, nullptr, nullptr, nullptr, WSP(F, float, WS_ST));
        }
        SEAM(pb + 6);
        if (PM(10) && IN(pb + 7)) { for (int rp = 0; rp < RP(10); ++rp) phase_topk(F, l); }
        SEAM(pb + 7);
        if (PM(11) && IN(pb + 8)) { for (int rp = 0; rp < RP(11); ++rp) phase_peer(F, l); }
        SEAM(pb + 8);
        if (PM(22) && IN(pb + 9)) { for (int rp = 0; rp < RP(22); ++rp) phase_peer_act(F, l); }
        SEAM(pb + 9);
        if (PM(20) && IN(pb + 10)) { for (int rp = 0; rp < RP(20); ++rp) phase_peer_v(F, l); }
        SEAM(pb + 10);
        if (PM(21) && IN(pb + 11)) { phase_peer_tail(F, l); }
        SEAM(pb + 11);
    }
#undef IN
#undef SEAM
}

extern "C" void kernel_launch(void* const* d_in, const int* in_sizes, int n_in, void* d_out, int out_size, void* d_ws, size_t ws_size, hipStream_t stream) {
    static int grid = 0;
    if (grid == 0) {
        if (n_in != 22 || out_size != T * D || ws_size < WS_END) { fprintf(stderr, "kernel_launch: unexpected shapes (n_in %d, out %d, ws %zu); nothing launched\n", n_in, out_size, ws_size); grid = -1; return; }
        int dev = 0, cus = 0, per_cu = 0;
        if (hipGetDevice(&dev) != hipSuccess || hipDeviceGetAttribute(&cus, hipDeviceAttributeMultiprocessorCount, dev) != hipSuccess) { grid = -1; return; }
        if (hipFuncSetAttribute((const void*)trunk_fwd, hipFuncAttributeMaxDynamicSharedMemorySize, LDS_BYTES) != hipSuccess) { fprintf(stderr, "kernel_launch: hipFuncSetAttribute failed\n"); grid = -1; return; }
        if (hipOccupancyMaxActiveBlocksPerMultiprocessor(&per_cu, (const void*)trunk_fwd, NT, LDS_BYTES) != hipSuccess || per_cu < 1)
            fprintf(stderr, "kernel_launch: note: occupancy query reports %d workgroups per CU\n", per_cu);
        (void)hipGetLastError();
        grid = cus;
    }
    if (grid < 0) return;
    if (hipMemsetAsync((char*)d_ws + WS_CTL, 0, CTL_ZERO_BYTES, stream) != hipSuccess) return;
    Args a{};
    for (int i = 0; i < 22; ++i) a.in[i] = (const float*)d_in[i];
    a.out = (float*)d_out; a.ws = (unsigned char*)d_ws;
#if MK_MULTI
    for (int p = 0; p < NPHASE; ++p) { a.ph_lo = p; a.ph_hi = p + 1; hipLaunchKernelGGL(trunk_fwd, dim3(grid), dim3(NT), LDS_BYTES, stream, a); }
#else
    a.ph_lo = 0; a.ph_hi = NPHASE; hipLaunchKernelGGL(trunk_fwd, dim3(grid), dim3(NT), LDS_BYTES, stream, a);
#endif
}
```
